# Optimizing an MI355X kernel written in HIP

```python
import math
import jax, jax.numpy as jnp
from jax import lax
import numpy as np

D_MODEL = 1024
BATCH = 4
SEQ = 4096
DEPTH = 1
DEC_BATCH = 128
DEC_SEQ = 1
PAST_LEN = 2048
PAGE_SIZE = 128

D_MIX = D_MODEL
H_A = 4
DH_A = 64
D_A = H_A * 2 * DH_A
ROT_DIM = DH_A // 4
ROPE_THETA = 500000.0
H_B = 8
DH_B = 64
D_B = H_B * DH_B
LORA_W = 64
LORA_A = 64
LORA_G = 128
SHIFT_DIM = 3 * D_B + LORA_W + LORA_A + LORA_G
D_IN = 3 * D_A + SHIFT_DIM
D_FF = 2816
Q_BLOCK = 128
NORM_EPS = 1e-6
GN_EPS = 64e-5
B_SPLITS = [D_B, 2 * D_B, 3 * D_B, 3 * D_B + LORA_W, 3 * D_B + LORA_W + LORA_A]

kernel_name = 'hymba_diffattn_rwkv7_macaron_step'


def rmsnorm(x, g):
    xf = x.astype(jnp.float32)
    y = xf * lax.rsqrt(jnp.mean(xf * xf, axis=-1, keepdims=True) + NORM_EPS)
    return (y * g.astype(jnp.float32)).astype(x.dtype)


def swiglu(x, w_gate, w_up, w_down):
    return (jax.nn.silu(x @ w_gate) * (x @ w_up)) @ w_down


def partial_rope(x, pos):
    half = ROT_DIM // 2
    inv_freq = ROPE_THETA ** (-jnp.arange(half, dtype=jnp.float32) / half)
    ang = pos.astype(jnp.float32)[:, None] * inv_freq[None, :]
    cos = jnp.cos(ang)[:, None, None, :].astype(x.dtype)
    sin = jnp.sin(ang)[:, None, None, :].astype(x.dtype)
    x1, x2, rest = x[..., :half], x[..., half:ROT_DIM], x[..., ROT_DIM:]
    return jnp.concatenate([x1 * cos - x2 * sin, x2 * cos + x1 * sin, rest], axis=-1)


def diff_softmax_attend(q, k, v, q_pos, k_pos, lam):
    s = jnp.einsum('nqhjd,nkhjd->nhjqk', q, k, preferred_element_type=jnp.float32) * (DH_A ** -0.5)
    mask = k_pos[None, :] <= q_pos[:, None]
    p = jax.nn.softmax(jnp.where(mask, s, -jnp.inf), axis=-1)
    p = p[:, :, 0] - lam * p[:, :, 1]
    return jnp.einsum('nhqk,nkhe->nqhe', p.astype(v.dtype), v)


def attend(q, k, v, q_pos, k_pos, lam):
    n, t = q.shape[0], q.shape[1]
    if t > Q_BLOCK and t % Q_BLOCK == 0:
        nb = t // Q_BLOCK
        qb = jnp.moveaxis(q.reshape(n, nb, Q_BLOCK, H_A, 2, DH_A), 1, 0)
        pb = q_pos.reshape(nb, Q_BLOCK)
        out = lax.map(lambda blk: diff_softmax_attend(blk[0], k, v, blk[1], k_pos, lam), (qb, pb))
        return jnp.moveaxis(out, 0, 1).reshape(n, t, H_A, 2 * DH_A)
    return diff_softmax_attend(q, k, v, q_pos, k_pos, lam)


def wkv_scan(s0, r, decay, k, v, kk, a):
    def step(s, inp):
        r_t, w_t, k_t, v_t, kk_t, a_t = inp
        sa = jnp.einsum('nhvk,nhk->nhv', s, -kk_t)
        s = (s * w_t[:, :, None, :] + sa[..., None] * (kk_t * a_t)[:, :, None, :]
             + v_t[..., None] * k_t[:, :, None, :])
        return s, jnp.einsum('nhvk,nhk->nhv', s, r_t)
    xs = tuple(jnp.moveaxis(z, 1, 0) for z in (r, decay, k, v, kk, a))
    s, ys = lax.scan(step, s0, xs)
    return s, jnp.moveaxis(ys, 0, 1)


def rwkv7_time_mix(pb, prev, s0, lp):
    n, t, _ = pb.shape
    f32 = jnp.float32
    shifted = jnp.concatenate([prev[:, None, :].astype(pb.dtype), pb[:, :-1]], axis=1)
    xs = pb + (shifted - pb) * lp['mu_shift']
    r, k, v, xw, xa, xg = jnp.split(xs, B_SPLITS, axis=-1)
    w = -jax.nn.softplus(-(lp['w0'] + jnp.tanh(xw) @ lp['w2']).astype(f32)) - 0.5
    decay = jnp.exp(-jnp.exp(w))
    a = jax.nn.sigmoid((lp['a0'] + xa @ lp['a2']).astype(f32))
    g = jax.nn.sigmoid(xg) @ lp['g2']
    heads = lambda z: z.reshape(n, t, H_B, DH_B).astype(f32)
    r, k, v, decay, a = heads(r), heads(k), heads(v), heads(decay), heads(a)
    kk = k * lp['k_k'].astype(f32).reshape(H_B, DH_B)
    kk = kk / jnp.maximum(jnp.sqrt(jnp.sum(kk * kk, axis=-1, keepdims=True)), 1e-12)
    k = k * (1.0 + (a - 1.0) * lp['k_a'].astype(f32).reshape(H_B, DH_B))
    s, y = wkv_scan(s0.astype(f32), r, decay, k, v, kk, a)
    mean = jnp.mean(y, axis=-1, keepdims=True)
    var = jnp.mean(jnp.square(y - mean), axis=-1, keepdims=True)
    y = ((y - mean) * lax.rsqrt(var + GN_EPS) * lp['ln_x_w'].astype(f32).reshape(H_B, DH_B)
         + lp['ln_x_b'].astype(f32).reshape(H_B, DH_B))
    y = y + jnp.sum(r * k * lp['r_k'].astype(f32), axis=-1, keepdims=True) * v
    y = y.reshape(n, t, D_B).astype(pb.dtype) * g
    return y, s.astype(s0.dtype), pb[:, -1]


def decoder_layer(x, pos, past_k, past_v, past_pos, prev_shift, s0, lp, lam_init):
    n, t, _ = x.shape
    f32 = jnp.float32
    h = x + 0.5 * rmsnorm(swiglu(rmsnorm(x, lp['n_ffn1_pre']), lp['ffn1_gate'], lp['ffn1_up'],
                                 lp['ffn1_down']), lp['n_ffn1_post'])
    u = rmsnorm(h, lp['n_mix_pre'])
    proj = u @ lp['w_in']
    q, k, v = jnp.split(proj[..., :3 * D_A], 3, axis=-1)
    pb = proj[..., 3 * D_A:]
    q = partial_rope(q.reshape(n, t, H_A, 2, DH_A), pos)
    k = partial_rope(k.reshape(n, t, H_A, 2, DH_A), pos)
    v = v.reshape(n, t, H_A, 2 * DH_A)
    if past_k is None:
        k_all, v_all, k_pos = k, v, pos
    else:
        k_all = jnp.concatenate([past_k.astype(k.dtype), k], axis=1)
        v_all = jnp.concatenate([past_v.astype(v.dtype), v], axis=1)
        k_pos = jnp.concatenate([past_pos, pos])
    lam = (jnp.exp(jnp.sum(lp['lambda_q1'].astype(f32) * lp['lambda_k1'].astype(f32)))
           - jnp.exp(jnp.sum(lp['lambda_q2'].astype(f32) * lp['lambda_k2'].astype(f32))) + lam_init)
    ya = attend(q, k_all, v_all, pos, k_pos, lam)
    ya = (rmsnorm(ya, lp['subln']) * (1.0 - lam_init)).reshape(n, t, D_A)
    yb, s_new, shift_new = rwkv7_time_mix(pb, prev_shift, s0, lp)
    mix = jnp.concatenate([ya, yb], axis=-1) @ lp['w_out']
    h = h + rmsnorm(mix, lp['n_mix_post'])
    h = h + 0.5 * rmsnorm(swiglu(rmsnorm(h, lp['n_ffn2_pre']), lp['ffn2_gate'], lp['ffn2_up'],
                                 lp['ffn2_down']), lp['n_ffn2_post'])
    return h, k.reshape(n, t, H_A, 2 * DH_A), v, s_new, shift_new


def setup_inputs(seed: int = 0) -> dict:
    key = jax.random.key(seed)
    ks = iter(jax.random.split(key, 64))
    f32 = jnp.float32
    nrm = lambda shape, scale: scale * jax.random.normal(next(ks), shape, f32)
    gain = lambda shape: 1.0 + nrm(shape, 0.05)
    n_pages = PAST_LEN // PAGE_SIZE
    n_used = DEC_BATCH * n_pages
    n_pool = n_used + (n_used + 3) // 4
    x_prompt = nrm((BATCH, SEQ, D_MODEL), 1.0)
    x_sample = nrm((DEC_BATCH, DEC_SEQ, D_MODEL), 1.0)
    cache_k = nrm((DEPTH, n_pool, PAGE_SIZE, H_A, 2 * DH_A), 1.0)
    cache_v = nrm((DEPTH, n_pool, PAGE_SIZE, H_A, 2 * DH_A), 1.0)
    state_wkv = nrm((DEPTH, DEC_BATCH, H_B, DH_B, DH_B), 0.3)
    state_shift = nrm((DEPTH, DEC_BATCH, SHIFT_DIM), 1.0)
    page_table = jax.random.permutation(next(ks), n_pool)[:n_used].reshape(DEC_BATCH, n_pages).astype(jnp.int32)
    return {
        'x_prompt': x_prompt, 'x_sample': x_sample,
        'cache_k': cache_k, 'cache_v': cache_v,
        'state_wkv': state_wkv, 'state_shift': state_shift,
        'page_table': page_table,
        'n_ffn1_pre': gain((DEPTH, D_MODEL)), 'n_ffn1_post': gain((DEPTH, D_MODEL)),
        'ffn1_gate': nrm((DEPTH, D_MODEL, D_FF), D_MODEL ** -0.5),
        'ffn1_up': nrm((DEPTH, D_MODEL, D_FF), D_MODEL ** -0.5),
        'ffn1_down': nrm((DEPTH, D_FF, D_MODEL), D_FF ** -0.5),
        'n_mix_pre': gain((DEPTH, D_MODEL)), 'n_mix_post': gain((DEPTH, D_MODEL)),
        'w_in': nrm((DEPTH, D_MODEL, D_IN), D_MODEL ** -0.5),
        'w_out': nrm((DEPTH, D_MIX, D_MODEL), D_MIX ** -0.5),
        'lambda_q1': nrm((DEPTH, DH_A), 0.1), 'lambda_k1': nrm((DEPTH, DH_A), 0.1),
        'lambda_q2': nrm((DEPTH, DH_A), 0.1), 'lambda_k2': nrm((DEPTH, DH_A), 0.1),
        'subln': gain((DEPTH, 2 * DH_A)),
        'mu_shift': jax.random.uniform(next(ks), (DEPTH, SHIFT_DIM), f32),
        'w0': nrm((DEPTH, D_B), 0.5),
        'w2': nrm((DEPTH, LORA_W, D_B), 0.1),
        'a0': nrm((DEPTH, D_B), 0.5),
        'a2': nrm((DEPTH, LORA_A, D_B), 0.5 * LORA_A ** -0.5),
        'g2': nrm((DEPTH, LORA_G, D_B), LORA_G ** -0.5),
        'k_k': 0.85 + nrm((DEPTH, D_B), 0.05),
        'k_a': 1.0 + nrm((DEPTH, D_B), 0.05),
        'r_k': nrm((DEPTH, H_B, DH_B), 0.1),
        'ln_x_w': gain((DEPTH, D_B)), 'ln_x_b': nrm((DEPTH, D_B), 0.02),
        'n_ffn2_pre': gain((DEPTH, D_MODEL)), 'n_ffn2_post': gain((DEPTH, D_MODEL)),
        'ffn2_gate': nrm((DEPTH, D_MODEL, D_FF), D_MODEL ** -0.5),
        'ffn2_up': nrm((DEPTH, D_MODEL, D_FF), D_MODEL ** -0.5),
        'ffn2_down': nrm((DEPTH, D_FF, D_MODEL), D_FF ** -0.5),
    }


def reference(x_prompt, x_sample, cache_k, cache_v, state_wkv, state_shift, page_table,
              n_ffn1_pre, n_ffn1_post, ffn1_gate, ffn1_up, ffn1_down,
              n_mix_pre, n_mix_post, w_in, w_out,
              lambda_q1, lambda_k1, lambda_q2, lambda_k2, subln,
              mu_shift, w0, w2, a0, a2, g2, k_k, k_a, r_k, ln_x_w, ln_x_b,
              n_ffn2_pre, n_ffn2_post, ffn2_gate, ffn2_up, ffn2_down):
    n_p, t_p = x_prompt.shape[0], x_prompt.shape[1]
    n_s, t_s = x_sample.shape[0], x_sample.shape[1]
    n_pages = page_table.shape[1]
    past_len = n_pages * PAGE_SIZE
    pos_p = jnp.arange(t_p, dtype=jnp.int32)
    pos_s = past_len + jnp.arange(t_s, dtype=jnp.int32)
    pos_past = jnp.arange(past_len, dtype=jnp.int32)
    yp, ys = x_prompt, x_sample
    kp_l, vp_l, sp_l, hp_l, ks_l, vs_l, ss_l, hs_l = [], [], [], [], [], [], [], []
    for l in range(DEPTH):
        lp = {
            'n_ffn1_pre': n_ffn1_pre[l], 'n_ffn1_post': n_ffn1_post[l],
            'ffn1_gate': ffn1_gate[l], 'ffn1_up': ffn1_up[l], 'ffn1_down': ffn1_down[l],
            'n_mix_pre': n_mix_pre[l], 'n_mix_post': n_mix_post[l],
            'w_in': w_in[l], 'w_out': w_out[l],
            'lambda_q1': lambda_q1[l], 'lambda_k1': lambda_k1[l],
            'lambda_q2': lambda_q2[l], 'lambda_k2': lambda_k2[l], 'subln': subln[l],
            'mu_shift': mu_shift[l], 'w0': w0[l], 'w2': w2[l], 'a0': a0[l], 'a2': a2[l],
            'g2': g2[l], 'k_k': k_k[l], 'k_a': k_a[l], 'r_k': r_k[l],
            'ln_x_w': ln_x_w[l], 'ln_x_b': ln_x_b[l],
            'n_ffn2_pre': n_ffn2_pre[l], 'n_ffn2_post': n_ffn2_post[l],
            'ffn2_gate': ffn2_gate[l], 'ffn2_up': ffn2_up[l], 'ffn2_down': ffn2_down[l],
        }
        lam_init = 0.8 - 0.6 * math.exp(-0.3 * l)
        prev0 = jnp.zeros((n_p, SHIFT_DIM), x_prompt.dtype)
        s0 = jnp.zeros((n_p, H_B, DH_B, DH_B), state_wkv.dtype)
        yp, kp, vp, sp, hp = decoder_layer(yp, pos_p, None, None, None, prev0, s0, lp, lam_init)
        past_k = cache_k[l][page_table].reshape(n_s, past_len, H_A, 2, DH_A)
        past_v = cache_v[l][page_table].reshape(n_s, past_len, H_A, 2 * DH_A)
        ys, kq, vq, sq, hq = decoder_layer(ys, pos_s, past_k, past_v, pos_past,
                                           state_shift[l], state_wkv[l], lp, lam_init)
        kp_l.append(kp); vp_l.append(vp); sp_l.append(sp); hp_l.append(hp)
        ks_l.append(kq); vs_l.append(vq); ss_l.append(sq); hs_l.append(hq)
    return (yp, ys,
            jnp.stack(kp_l), jnp.stack(vp_l), jnp.stack(sp_l), jnp.stack(hp_l),
            jnp.stack(ks_l), jnp.stack(vs_l), jnp.stack(ss_l), jnp.stack(hs_l))
```

```cpp
#include <hip/hip_runtime.h>
#include <cstdio>
#include <cstdint>
namespace pg8 {
#define PG8_LAS __attribute__((address_space(3)))
typedef unsigned short bf16_t;
typedef short bf16x8 __attribute__((ext_vector_type(8)));
typedef float f32x4 __attribute__((ext_vector_type(4)));
typedef unsigned u32x4 __attribute__((ext_vector_type(4)));
constexpr int BM = 256, BK = 64, HALF = 128, HTB = HALF * BK * 2  , STAGE_BYTES = 8 * HTB, NXCD = 8, WGM = 8;

__host__ __device__ __forceinline__ int lds_byte(int r, int c) { const int st = (r >> 4) * 2 + (c >> 5), rr = r & 15, cc = c & 31, ob = rr * 64 + cc * 2; return st * 1024 + (ob ^ (((ob >> 9) & 1) << 5)); }
__host__ __device__ __forceinline__ void stage_rc(int b, int& R, int& C) { const int st = b / 1024, sb = b % 1024, swz = sb ^ (((sb >> 9) & 1) << 5); R = (st >> 1) * 16 + swz / 64; C = (st & 1) * 32 + (swz % 64) / 2; }
__host__ __device__ __forceinline__ int perm32(int rho) { const int n = rho >> 4, i = rho & 15; return 8 * (i >> 2) + 4 * n + (i & 3); }

struct Unit { int pm, pn; };
struct Gemm { const bf16_t* A; const bf16_t* Bt; int M, N, K; };

struct StaticOrder {
    int nM, nN, nwg, G, c;
    __host__ __device__ void init(int M, int N, int G_, int c_) { nM = M / BM; nN = N / BM; nwg = nM * nN; G = G_; c = c_; }
    __host__ __device__ bool next(int i, Unit& u) const {
        const long L = (long)i * G + c; if (L >= nwg) return false;
        int wgid = (int)L; { const int q = nwg / NXCD, r = nwg % NXCD, xcd = wgid % NXCD, off = wgid / NXCD; wgid = (xcd < r ? xcd * (q + 1) : r * (q + 1) + (xcd - r) * q) + off; }
        const int nig = WGM * nN, gid = wgid / nig, fm = gid * WGM, gsz = (nM - fm) < WGM ? (nM - fm) : WGM;
        u.pm = fm + ((wgid % nig) % gsz); u.pn = (wgid % nig) / gsz; return true;
    }
    __device__ __forceinline__ void a_ready(const Unit&) const {}
    __device__ __forceinline__ void done(const Unit&) const {}
};

__device__ __forceinline__ unsigned cvt_pk_bf16(float lo, float hi) { unsigned r; asm volatile("v_cvt_pk_bf16_f32 %0, %1, %2" : "=v"(r) : "v"(lo), "v"(hi)); return r; }
typedef float f32x2 __attribute__((ext_vector_type(2)));
struct EpiF32 {
    static constexpr bool PERM = false, AFTER_DRAIN = false;
    float* C; int ldc; const float* bias;
    __device__ __forceinline__ void operator()(const f32x4 (&acc)[2][2][4][2], const Unit& u, int wr, int wc, int fr, int fq) const {
        const int row0 = u.pm * BM + wr * 64 + fr, col0 = u.pn * BM + wc * 32 + 4 * fq;
#pragma unroll
        for (int ai = 0; ai < 2; ++ai)
#pragma unroll
            for (int m = 0; m < 4; ++m) { float* rowp = C + (size_t)(row0 + ai * HALF + m * 16) * ldc + col0;
#pragma unroll
                for (int bj = 0; bj < 2; ++bj)
#pragma unroll
                    for (int n = 0; n < 2; ++n) *(f32x4*)(rowp + bj * HALF + n * 16) = acc[ai][bj][m][n]; }
    }
};
struct EpiSwiGLU {
    static constexpr bool PERM = true, AFTER_DRAIN = false;
    bf16_t* O; int ldc;
    __device__ __forceinline__ void operator()(const f32x4 (&acc)[2][2][4][2], const Unit& u, int wr, int wc, int fr, int fq) const {
        const int row0 = u.pm * BM + wr * 64 + fr, col0 = u.pn * HALF + wc * 32 + 8 * fq;
#pragma unroll
        for (int ai = 0; ai < 2; ++ai)
#pragma unroll
            for (int m = 0; m < 4; ++m) { bf16_t* rowp = O + (size_t)(row0 + ai * HALF + m * 16) * ldc + col0;
                float h[8];
#pragma unroll
                for (int n = 0; n < 2; ++n)
#pragma unroll
                    for (int j = 0; j < 4; ++j) { const float g = acc[ai][0][m][n][j], up = acc[ai][1][m][n][j];
                        h[4 * n + j] = g * __builtin_amdgcn_rcpf(1.0f + __builtin_amdgcn_exp2f(-1.4426950408889634f * g)) * up; }
                u32x4 w; w.x = cvt_pk_bf16(h[0], h[1]); w.y = cvt_pk_bf16(h[2], h[3]); w.z = cvt_pk_bf16(h[4], h[5]); w.w = cvt_pk_bf16(h[6], h[7]);
                *(u32x4*)rowp = w; }
    }
};
template <class Epi, class Sched, bool ALIGN_EPI = false, bool SP2 = false>
__device__ __forceinline__ void gemm_phase(PG8_LAS unsigned char* lds, const Gemm g, const Sched& S, const Epi& E) {
    int tid = threadIdx.x; asm volatile("" : "+v"(tid));
    const int wid = __builtin_amdgcn_readfirstlane(tid >> 6), lane = tid & 63, wr = wid >> 2, wc = wid & 3, fr = lane & 15, fq = lane >> 4;
    const int K = g.K, nt = K / BK;
    unsigned voffA[2], voffB[2];
#pragma unroll
    for (int i = 0; i < 2; ++i) { int R, C; stage_rc(tid * 16 + i * 8192, R, C); const int Rb = Epi::PERM ? ((R & ~31) + perm32(R & 31)) : R;
        voffA[i] = (unsigned)(R * K + C) * 2u; voffB[i] = (unsigned)(Rb * K + C) * 2u; }
    const size_t kstep = (size_t)(BK * 2);
    const size_t hstep = (size_t)HALF * K * 2;
    const size_t tstep = 2 * hstep;
    const unsigned ldsw = (unsigned)wid * 1024u;
    const int aoff = lds_byte(wr * 64 + fr, fq * 8), boff = lds_byte(wc * 32 + fr, fq * 8);
#define PG8_SA(b, h) (((b) * 2 + (h)) * HTB)
#define PG8_SB(b, h) ((4 + (b) * 2 + (h)) * HTB)
#define PG8_STAGE(bufoff, gbase, voff) do { _Pragma("unroll") for (int _i = 0; _i < 2; ++_i) \
        __builtin_amdgcn_global_load_lds((const unsigned*)((const char*)(gbase) + (voff)[_i]), (PG8_LAS unsigned*)(lds + (bufoff) + ldsw + _i * 8192), 16, 0, 0); } while (0)
#define PG8_LDA(dst, b, h) do { _Pragma("unroll") for (int m = 0; m < 4; ++m) _Pragma("unroll") for (int k = 0; k < 2; ++k) dst[m][k] = *(const PG8_LAS bf16x8*)(lds + PG8_SA(b, h) + aoff + m * 2048 + k * 1024); } while (0)
#define PG8_LDB(dst, b, h) do { _Pragma("unroll") for (int n = 0; n < 2; ++n) _Pragma("unroll") for (int k = 0; k < 2; ++k) dst[n][k] = *(const PG8_LAS bf16x8*)(lds + PG8_SB(b, h) + boff + n * 2048 + k * 1024); } while (0)
#define PG8_MMA(ai, bj, At, Bt) do { __builtin_amdgcn_s_setprio(1); _Pragma("unroll") for (int m = 0; m < 4; ++m) _Pragma("unroll") for (int n = 0; n < 2; ++n) _Pragma("unroll") for (int k = 0; k < 2; ++k) \
        acc[ai][bj][m][n] = __builtin_amdgcn_mfma_f32_16x16x32_bf16(Bt[n][k], At[m][k], acc[ai][bj][m][n], 0, 0, 0); __builtin_amdgcn_s_setprio(0); } while (0)
#define PG8_WAIT_V(n) asm volatile("s_waitcnt vmcnt(" #n ")" ::: "memory")
#define PG8_WAIT_L(n) asm volatile("s_waitcnt lgkmcnt(" #n ")" ::: "memory")
#define PG8_BAR __builtin_amdgcn_s_barrier()
#define PG8_SCHED __builtin_amdgcn_sched_barrier(0)
    Unit cur, nxt; int ui = 0;
    if (!S.next(0, cur)) return;
    f32x4 acc[2][2][4][2];
#pragma unroll
    for (int a = 0; a < 2; ++a)
#pragma unroll
        for (int b = 0; b < 2; ++b)
#pragma unroll
            for (int m = 0; m < 4; ++m)
#pragma unroll
                for (int n = 0; n < 2; ++n) acc[a][b][m][n] = (f32x4){0.f, 0.f, 0.f, 0.f};
    bf16x8 At[4][2], B0[2][2], B1[2][2];
    const char* cA = (const char*)g.A + (size_t)cur.pm * tstep; const char* cB = (const char*)g.Bt + (size_t)cur.pn * tstep;
    S.a_ready(cur);
    if constexpr (SP2) {
        PG8_STAGE(PG8_SB(0, 0), cB, voffB); PG8_STAGE(PG8_SB(0, 1), cB + hstep, voffB); PG8_STAGE(PG8_SA(0, 0), cA, voffA); PG8_STAGE(PG8_SA(0, 1), cA + hstep, voffA);
        if (wr == 1) PG8_BAR;
        PG8_WAIT_V(2); PG8_BAR;
        PG8_STAGE(PG8_SB(1, 0), cB + kstep, voffB); PG8_STAGE(PG8_SA(1, 0), cA + kstep, voffA); PG8_STAGE(PG8_SB(1, 1), cB + hstep + kstep, voffB);
        PG8_WAIT_V(6); PG8_BAR;
    } else {
        PG8_STAGE(PG8_SB(0, 0), cB, voffB); PG8_STAGE(PG8_SA(0, 0), cA, voffA); PG8_STAGE(PG8_SB(0, 1), cB + hstep, voffB); PG8_STAGE(PG8_SA(0, 1), cA + hstep, voffA);
        if (wr == 1) PG8_BAR;
        PG8_WAIT_V(4); PG8_BAR;
        PG8_STAGE(PG8_SB(1, 0), cB + kstep, voffB); PG8_STAGE(PG8_SA(1, 0), cA + kstep, voffA); PG8_STAGE(PG8_SB(1, 1), cB + hstep + kstep, voffB);
        PG8_WAIT_V(6); PG8_BAR;
    }
    for (;;) {
        const bool has_next = S.next(ui + 1, nxt);
        const char* nA = has_next ? (const char*)g.A + (size_t)nxt.pm * tstep : cA; const char* nB = has_next ? (const char*)g.Bt + (size_t)nxt.pn * tstep : cB;
        for (int t = 0; t < nt; t += 2) {
            const bool last = (t == nt - 2);
            const char* a1 = cA + (size_t)(t + 1) * kstep;
            const char* a2 = last ? nA : cA + (size_t)(t + 2) * kstep; const char* b2 = last ? nB : cB + (size_t)(t + 2) * kstep;
            const char* a3 = a2 + kstep; const char* b3 = b2 + kstep;
            if (last && has_next) S.a_ready(nxt);
            if constexpr (SP2) {
            PG8_LDB(B0, 0, 0); PG8_LDB(B1, 0, 1); PG8_SCHED; PG8_LDA(At, 0, 0); PG8_STAGE(PG8_SA(1, 1), a1 + hstep, voffA);
            PG8_WAIT_V(8); PG8_WAIT_L(0); PG8_BAR; PG8_MMA(0, 0, At, B0); PG8_MMA(0, 1, At, B1); PG8_BAR; PG8_SCHED;
            PG8_LDA(At, 0, 1); PG8_STAGE(PG8_SB(0, 0), b2, voffB); PG8_STAGE(PG8_SB(0, 1), b2 + hstep, voffB); PG8_STAGE(PG8_SA(0, 0), a2, voffA);
            PG8_WAIT_V(8); PG8_WAIT_L(0); PG8_BAR; PG8_MMA(1, 0, At, B0); PG8_MMA(1, 1, At, B1); PG8_BAR; PG8_SCHED;
            PG8_LDB(B0, 1, 0); PG8_LDB(B1, 1, 1); PG8_SCHED; PG8_LDA(At, 1, 0); PG8_STAGE(PG8_SA(0, 1), a2 + hstep, voffA);
            PG8_WAIT_V(8); PG8_WAIT_L(0); PG8_BAR; PG8_MMA(0, 0, At, B0); PG8_MMA(0, 1, At, B1); PG8_BAR; PG8_SCHED;
            PG8_LDA(At, 1, 1); PG8_STAGE(PG8_SB(1, 0), b3, voffB); PG8_STAGE(PG8_SB(1, 1), b3 + hstep, voffB); PG8_STAGE(PG8_SA(1, 0), a3, voffA);
            PG8_WAIT_V(8); PG8_WAIT_L(0); PG8_BAR; PG8_MMA(1, 0, At, B0); PG8_MMA(1, 1, At, B1); PG8_BAR; PG8_SCHED;
            } else {
            PG8_LDB(B0, 0, 0); PG8_SCHED; PG8_LDA(At, 0, 0); PG8_STAGE(PG8_SA(1, 1), a1 + hstep, voffA);
            PG8_WAIT_L(8); PG8_BAR; PG8_WAIT_L(0); PG8_MMA(0, 0, At, B0); PG8_BAR; PG8_SCHED;
            PG8_LDB(B1, 0, 1); PG8_STAGE(PG8_SB(0, 0), b2, voffB);
            PG8_BAR; PG8_WAIT_L(0); PG8_MMA(0, 1, At, B1); PG8_BAR;
            PG8_LDA(At, 0, 1); PG8_STAGE(PG8_SA(0, 0), a2, voffA);
            PG8_BAR; PG8_WAIT_L(0); PG8_MMA(1, 0, At, B0); PG8_BAR; PG8_SCHED;
            PG8_STAGE(PG8_SB(0, 1), b2 + hstep, voffB);
            PG8_WAIT_V(6); PG8_BAR; PG8_MMA(1, 1, At, B1); PG8_BAR;
            PG8_LDB(B0, 1, 0); PG8_SCHED; PG8_LDA(At, 1, 0); PG8_STAGE(PG8_SA(0, 1), a2 + hstep, voffA);
            PG8_WAIT_L(8); PG8_BAR; PG8_WAIT_L(0); PG8_MMA(0, 0, At, B0); PG8_BAR; PG8_SCHED;
            PG8_LDB(B1, 1, 1); PG8_STAGE(PG8_SB(1, 0), b3, voffB);
            PG8_BAR; PG8_WAIT_L(0); PG8_MMA(0, 1, At, B1); PG8_BAR;
            PG8_LDA(At, 1, 1); PG8_STAGE(PG8_SA(1, 0), a3, voffA);
            PG8_BAR; PG8_WAIT_L(0); PG8_MMA(1, 0, At, B0); PG8_BAR; PG8_SCHED;
            PG8_STAGE(PG8_SB(1, 1), b3 + hstep, voffB);
            PG8_WAIT_V(6); PG8_BAR; PG8_MMA(1, 1, At, B1); PG8_BAR;
            }
        }
        if constexpr (ALIGN_EPI) { if (wr == 0) PG8_BAR; }
        if constexpr (!Epi::AFTER_DRAIN) { E(acc, cur, wr, wc, fr, fq); S.done(cur); }
        if (!has_next) break;
#pragma unroll
        for (int a = 0; a < 2; ++a)
#pragma unroll
            for (int b = 0; b < 2; ++b)
#pragma unroll
                for (int m = 0; m < 4; ++m)
#pragma unroll
                    for (int n = 0; n < 2; ++n) acc[a][b][m][n] = (f32x4){0.f, 0.f, 0.f, 0.f};
        cur = nxt; cA = nA; cB = nB; ++ui;
        if constexpr (ALIGN_EPI) { if (wr == 1) PG8_BAR; }
    }
    PG8_WAIT_V(0);
    if constexpr (!ALIGN_EPI) { if (wr == 0) PG8_BAR; }
    PG8_BAR;
    if constexpr (Epi::AFTER_DRAIN) { E.fused(acc, cur, wr, wc, fr, fq, lds, wid, lane); S.done(cur); }
#undef PG8_SA
#undef PG8_SB
#undef PG8_STAGE
#undef PG8_LDA
#undef PG8_LDB
#undef PG8_MMA
#undef PG8_WAIT_V
#undef PG8_WAIT_L
#undef PG8_BAR
#undef PG8_SCHED
}
}

#define PG8_SP2 true
#define PG8_ALIGN true
#include <hip/hip_bf16.h>
#include <cmath>
namespace attn_body {
using bf16=__hip_bfloat16;
using bf16x8=__attribute__((ext_vector_type(8)))short;
using s16x4=__attribute__((ext_vector_type(4)))short;
using f32x16=__attribute__((ext_vector_type(16)))float;
using u32x4=__attribute__((ext_vector_type(4)))unsigned;
constexpr int BATCH=4,NHEAD=16,SEQ=4096,D=64,DM=NHEAD*D,DMI=512;
constexpr int NW=8,QBLK=32,QB=QBLK*NW,KVBLK=64,NQB=SEQ/QB;
constexpr int ATTN_PITCH=DM, ATTN_UNIT_ROWS=QB;
__device__ __forceinline__ int crow(int r,int hi){return (r&3)+8*(r>>2)+4*hi;}
#define SBAR() __builtin_amdgcn_sched_barrier(0)
__device__ __forceinline__ void cmask(f32x16&p0,f32x16&p1,int jb,int qrel,int hi){
  const float NEG=-INFINITY; int kb=64*jb+4*hi;
  #pragma unroll
  for(int r=0;r<16;++r){int kv=kb+(r&3)+8*(r>>2); if(kv>qrel)p0[r]=NEG; if(kv+32>qrel)p1[r]=NEG;}
}

constexpr int NSLOT=3, SLOTB=8192;
constexpr int LDS_K=0, LDS_V=NSLOT*SLOTB, LDS_WS=2*NSLOT*SLOTB, LDS_OST=LDS_WS+NW*64*4, LDS_BYTES=LDS_OST+NW*4096;
constexpr float C2=0.125f*1.4426950408889634f;
__device__ __forceinline__ void glds16(const void*gsrc,unsigned lds_dst){unsigned keep;
  asm volatile("s_mov_b32 %0, m0\n\ts_mov_b32 m0, %2\n\ts_nop 0\n\tglobal_load_lds_dwordx4 %1, off\n\ts_mov_b32 m0, %0":"=&s"(keep):"v"(gsrc),"s"(lds_dst):"memory");}
__device__ __forceinline__ float max3f(float a,float b,float c){float r;asm("v_max3_f32 %0, %1, %2, %3":"=v"(r):"v"(a),"v"(b),"v"(c));return r;}
__device__ __forceinline__ float max2f(float a,float b){float r;asm("v_max_f32_e32 %0, %1, %2":"=v"(r):"v"(a),"v"(b));return r;}
__device__ __forceinline__ float fadd_s(float a,float b){float r;asm("v_add_f32_e32 %0, %1, %2":"=v"(r):"v"(a),"v"(b));return r;}
__device__ __forceinline__ float fsub_s(float a,float b){float r;asm("v_sub_f32_e32 %0, %1, %2":"=v"(r):"v"(a),"v"(b));return r;}
typedef float f32x2_t __attribute__((ext_vector_type(2))); typedef __bf16 bf16x2_t __attribute__((ext_vector_type(2)));
__device__ __forceinline__ unsigned cvtpk_s(float lo,float hi){f32x2_t v={lo,hi};bf16x2_t b=__builtin_convertvector(v,bf16x2_t);return __builtin_bit_cast(unsigned,b);}
#define WAIT_BAR(N) asm volatile("s_waitcnt vmcnt(" #N ") lgkmcnt(0)\n\ts_barrier":::"memory")

__device__ __forceinline__ void qkt(f32x16&p0,f32x16&p1,const char*Kslot,const bf16x8*qr,const f32x16&negm,int r32,int hi){
  const char*kb=Kslot+hi*1024+r32*16;
  #pragma unroll
  for(int d0=0;d0<4;++d0){
    const bf16x8 b0=*reinterpret_cast<const bf16x8*>(kb+d0*2048);
    const bf16x8 b1=*reinterpret_cast<const bf16x8*>(kb+d0*2048+512);
    if(d0==0){p0=__builtin_amdgcn_mfma_f32_32x32x16_bf16(b0,qr[0],negm,0,0,0);p1=__builtin_amdgcn_mfma_f32_32x32x16_bf16(b1,qr[0],negm,0,0,0);}
    else{p0=__builtin_amdgcn_mfma_f32_32x32x16_bf16(b0,qr[d0],p0,0,0,0);p1=__builtin_amdgcn_mfma_f32_32x32x16_bf16(b1,qr[d0],p1,0,0,0);}}
}
typedef __attribute__((address_space(3))) const char* lds_cptr;
typedef short v4i16_t __attribute__((ext_vector_type(4)));
__device__ __forceinline__ void kload8(bf16x8*kf,lds_cptr kp){
  kf[0]=*(const __attribute__((address_space(3))) bf16x8*)(kp);      kf[1]=*(const __attribute__((address_space(3))) bf16x8*)(kp+512);
  kf[2]=*(const __attribute__((address_space(3))) bf16x8*)(kp+2048); kf[3]=*(const __attribute__((address_space(3))) bf16x8*)(kp+2560);
  kf[4]=*(const __attribute__((address_space(3))) bf16x8*)(kp+4096); kf[5]=*(const __attribute__((address_space(3))) bf16x8*)(kp+4608);
  kf[6]=*(const __attribute__((address_space(3))) bf16x8*)(kp+6144); kf[7]=*(const __attribute__((address_space(3))) bf16x8*)(kp+6656);
}
__device__ __forceinline__ void kload2(bf16x8*kf,lds_cptr kp,int j){ kf[2*j]=*(const __attribute__((address_space(3))) bf16x8*)(kp+j*2048); kf[2*j+1]=*(const __attribute__((address_space(3))) bf16x8*)(kp+j*2048+512); }
__device__ __forceinline__ s16x4 vtr(lds_cptr p){ return __builtin_bit_cast(s16x4,__builtin_amdgcn_ds_read_tr16_b64_v4i16((__attribute__((address_space(3))) v4i16_t*)p)); }
__device__ __forceinline__ float rowmax(const f32x16&p0,const f32x16&p1){
  float a=max3f(p0[0],p0[1],p1[0]),b=max3f(p0[2],p0[3],p1[1]);a=max3f(a,p1[2],p1[3]);
  #pragma unroll
  for(int r=4;r<16;r+=4){a=max3f(a,p0[r],p0[r+1]);b=max3f(b,p0[r+2],p0[r+3]);a=max3f(a,p1[r],p1[r+1]);b=max3f(b,p1[r+2],p1[r+3]);}
  const float m=max2f(a,b);
  auto rr=__builtin_amdgcn_permlane32_swap(__float_as_uint(m),__float_as_uint(m),false,false);
  return max2f(__uint_as_float(rr[0]),__uint_as_float(rr[1]));
}
__device__ __forceinline__ void pv(f32x16*o,int vb,bf16x8 pa0,bf16x8 pa1,bf16x8 pa2,bf16x8 pa3){
  #pragma unroll
  for(int d0=0;d0<2;++d0){s16x4 lo[4],hi[4];
    #pragma unroll
    for(int ks=0;ks<4;++ks){
      asm volatile("ds_read_b64_tr_b16 %0,%1 offset:%c2":"=&v"(lo[ks]):"v"(vb),"i"(d0*4096+ks*1024):"memory");
      asm volatile("ds_read_b64_tr_b16 %0,%1 offset:%c2":"=&v"(hi[ks]):"v"(vb),"i"(d0*4096+ks*1024+512):"memory");}
    asm volatile("s_waitcnt lgkmcnt(0)":::"memory");SBAR();
    #define PK(k) (bf16x8){lo[k][0],lo[k][1],lo[k][2],lo[k][3],hi[k][0],hi[k][1],hi[k][2],hi[k][3]}
    o[d0]=__builtin_amdgcn_mfma_f32_32x32x16_bf16(pa0,PK(0),o[d0],0,0,0);
    o[d0]=__builtin_amdgcn_mfma_f32_32x32x16_bf16(pa1,PK(1),o[d0],0,0,0);
    o[d0]=__builtin_amdgcn_mfma_f32_32x32x16_bf16(pa2,PK(2),o[d0],0,0,0);
    o[d0]=__builtin_amdgcn_mfma_f32_32x32x16_bf16(pa3,PK(3),o[d0],0,0,0);
    #undef PK
  }
}

#ifndef ATTN_STORE16
#define ATTN_STORE16(p,v) (*(u32x4*)(p)=(v))
#endif
template<int THRL> __device__ __forceinline__ void attn_unit(int b,int h,int qb,const bf16*Q,const bf16*__restrict__ K,const bf16*__restrict__ V,bf16*O,char*shm){
  int tid=threadIdx.x; asm volatile("":"+v"(tid)); const int lane=tid&63,r32=lane&31,hi=lane>>5; const int wid=__builtin_amdgcn_readfirstlane(tid>>6);
  const long rowbase=(long)b*SEQ; const int q0=qb*QB;
  const int hq=h>>1, hv=((h>>2)<<1)|(h&1);
  const bf16*Qw=Q+(rowbase+q0+wid*QBLK)*DMI+hq*D;
  const bf16*Kh=K+rowbase*DMI+hq*D,*Vh=V+rowbase*DMI+hv*D;
  const unsigned lds0=(unsigned)(uintptr_t)shm;
  float*wsf=(float*)(shm+LDS_WS)+wid*64;
  const bf16*ksrc=Kh+(long)lane*DMI+wid*8;
  const bf16*vsrc=Vh+(long)(16*(wid&3)+(lane>>2))*DMI+(wid>>2)*32+(lane&3)*8;
  const unsigned kdst=lds0+LDS_K+wid*1024, vdst=lds0+LDS_V+wid*1024;
  #define DMA_K(t,slot) glds16(ksrc+(long)(t)*KVBLK*DMI,(unsigned)__builtin_amdgcn_readfirstlane(kdst+(slot)))
  #define DMA_V(t,slot) glds16(vsrc+(long)(t)*KVBLK*DMI,(unsigned)__builtin_amdgcn_readfirstlane(vdst+(slot)))
  const int vb0=(int)(lds0+LDS_V)+((lane>>4)&1)*32+(lane&3)*8+(4*hi+((lane&15)>>2))*64;
  const char*Kbase=shm+LDS_K; bf16x8 kf[8];
  const lds_cptr shm3=(lds_cptr)shm; const lds_cptr kp0=shm3+LDS_K+hi*1024+r32*16; const lds_cptr vp0=shm3+LDS_V+((lane>>4)&1)*32+(lane&3)*8+(4*hi+((lane&15)>>2))*64;
  const int NT=(q0+QB)/KVBLK;
  DMA_K(0,0);DMA_V(0,0);DMA_K(1,SLOTB);
  bf16x8 qr[4];
  #pragma unroll
  for(int d0=0;d0<4;++d0)qr[d0]=*reinterpret_cast<const bf16x8*>(&Qw[(long)r32*DMI+d0*16+hi*8]);
  float mhat=0.f,l_reg=0.f;f32x16 o[2];o[0]=f32x16{};o[1]=f32x16{};f32x16 negm=f32x16{};asm volatile("":"+v"(negm));
  const int qrel=wid*QBLK+r32;
  #define CMASK(P0,P1,t) do{int jb_=(t)-(NT-4); if(jb_>=0)cmask(P0,P1,jb_,qrel,hi);}while(0)
  bool resc=false;
  #define START(P0,P1) do{ const float rm=rowmax(P0,P1); resc=false; \
    { const float dl=rm; mhat=fadd_s(mhat,dl); \
      _Pragma("unroll") for(int r=0;r<16;++r){P0[r]=fsub_s(P0[r],dl);P1[r]=fsub_s(P1[r],dl);} \
      _Pragma("unroll") for(int r=0;r<16;++r)negm[r]=-mhat; asm volatile("":"+v"(negm)); } \
    _Pragma("unroll") for(int r=0;r<16;++r)P0[r]=__builtin_amdgcn_exp2f(P0[r]); }while(0)
  #define RESC() do{ if(resc){ asm volatile("s_waitcnt lgkmcnt(0)":::"memory"); \
      _Pragma("unroll") for(int d_=0;d_<2;++d_) _Pragma("unroll") for(int r=0;r<16;++r)o[d_][r]*=wsf[crow(r,hi)]; } }while(0)
  f32x16 pA0,pA1,pB0,pB1;
  int sl_prev=0,sl_cur=0,sl_next=SLOTB;
  #define ROT() do{sl_prev=sl_cur;sl_cur=sl_next;sl_next=(sl_next==(NSLOT-1)*SLOTB)?0:sl_next+SLOTB;}while(0)
  DMA_K(2,2*SLOTB);
  WAIT_BAR(3);
  qkt(pA0,pA1,Kbase,qr,negm,r32,hi);asm volatile("s_nop 15\n\ts_nop 7":"+v"(pA0),"+v"(pA1));CMASK(pA0,pA1,0);
  START(pA0,pA1);
  _Pragma("unroll") for(int r=0;r<16;++r)pA1[r]=__builtin_amdgcn_exp2f(pA1[r]);
  WAIT_BAR(0);
  DMA_K(3,0);DMA_V(1,SLOTB);
  ROT();
  kload8(kf,kp0+sl_cur);
  WAIT_BAR(2);
  s16x4 vlo[8],vhi[8]; u32x4 pw0,pw1,pw2,pw3;
  #define PKW(P,B) cvtpk_s(P[B],P[B+1])
  #define PAF(k) __builtin_bit_cast(bf16x8,pw##k)
  #define VFR(i) (bf16x8){vlo[i][0],vlo[i][1],vlo[i][2],vlo[i][3],vhi[i][0],vhi[i][1],vhi[i][2],vhi[i][3]}
  #define PIN(x) asm volatile("":"+v"(x))
  #define MX3(a,b,c) __builtin_fmaxf(__builtin_fmaxf((a),(b)),(c))
  #define GAPA(MF,A0,A1,A2,A3,W0,W1,PW) do{ MF; sacc+=A0; sacc+=A1; sacc+=A2; sacc+=A3; PIN(sacc); W0; W1; PIN(PW); SBAR(); }while(0)
  #define EX(v) __builtin_amdgcn_exp2f(v)
  #define GAPB(MF,X,B) do{ MF; X[B]=EX(X[B]); X[B+1]=EX(X[B+1]); X[B+2]=EX(X[B+2]); X[B+3]=EX(X[B+3]); PIN(X); SBAR(); }while(0)
  #define VRD(i) do{ vlo[i]=vtr(vp_+(((i)>>2)*4096+((i)&3)*1024)); vhi[i]=vtr(vp_+(((i)>>2)*4096+((i)&3)*1024+512)); }while(0)
  #define KRD(G,j) do{ if(G){ kload2(kf,kp0+sl_next,j); SBAR(); } }while(0)
  #define STEP(C0,C1,P0,P1,t,GK,GV,GL) do{ SBAR(); \
    const lds_cptr vp_=vp0+sl_prev; \
    VRD(0); SBAR(); float sacc=(P0[0]+P0[1]); \
    GAPA(C0=__builtin_amdgcn_mfma_f32_32x32x16_bf16(kf[0],qr[0],negm,0,0,0), P0[2],P0[3],P0[4],P0[5],     pw0[0]=PKW(P0,0), pw0[1]=PKW(P0,2), pw0); \
    VRD(4); SBAR(); GAPA(C1=__builtin_amdgcn_mfma_f32_32x32x16_bf16(kf[1],qr[0],negm,0,0,0), P0[6],P0[7],P0[8],P0[9],     pw0[2]=PKW(P0,4), pw0[3]=PKW(P0,6), pw0); \
    VRD(1); SBAR(); GAPA(C0=__builtin_amdgcn_mfma_f32_32x32x16_bf16(kf[2],qr[1],C0,0,0,0),   P0[10],P0[11],P0[12],P0[13], pw1[0]=PKW(P0,8), pw1[1]=PKW(P0,10), pw1); \
    VRD(5); SBAR(); GAPA(C1=__builtin_amdgcn_mfma_f32_32x32x16_bf16(kf[3],qr[1],C1,0,0,0),   P0[14],P0[15],P1[0],P1[1],   pw1[2]=PKW(P0,12),pw1[3]=PKW(P0,14), pw1); \
    VRD(2); SBAR(); GAPA(C0=__builtin_amdgcn_mfma_f32_32x32x16_bf16(kf[4],qr[2],C0,0,0,0),   P1[2],P1[3],P1[4],P1[5],     pw2[0]=PKW(P1,0), pw2[1]=PKW(P1,2), pw2); \
    VRD(6); SBAR(); GAPA(C1=__builtin_amdgcn_mfma_f32_32x32x16_bf16(kf[5],qr[2],C1,0,0,0),   P1[6],P1[7],P1[8],P1[9],     pw2[2]=PKW(P1,4), pw2[3]=PKW(P1,6), pw2); \
    VRD(3); SBAR(); GAPA(C0=__builtin_amdgcn_mfma_f32_32x32x16_bf16(kf[6],qr[3],C0,0,0,0),   P1[10],P1[11],P1[12],P1[13], pw3[0]=PKW(P1,8), pw3[1]=PKW(P1,10), pw3); \
    VRD(7); SBAR(); GAPA(C1=__builtin_amdgcn_mfma_f32_32x32x16_bf16(kf[7],qr[3],C1,0,0,0),   P1[14],P1[15],0.f,0.f,       pw3[2]=PKW(P1,12),pw3[3]=PKW(P1,14), pw3); \
    l_reg+=sacc; \
    if(GK){DMA_K((t)+3,sl_cur);} if(GV){DMA_V((t)+1,sl_next);} \
    CMASK(C0,C1,t); \
    { float a=MX3(C0[0],C0[1],C1[0]),b=MX3(C0[2],C0[3],C1[1]); a=MX3(a,C1[2],C1[3]); \
      _Pragma("unroll") for(int r=4;r<16;r+=4){a=MX3(a,C0[r],C0[r+1]);b=MX3(b,C0[r+2],C0[r+3]);a=MX3(a,C1[r],C1[r+1]);b=MX3(b,C1[r+2],C1[r+3]);} \
      float rm=__builtin_fmaxf(a,b); { auto rr=__builtin_amdgcn_permlane32_swap(__float_as_uint(rm),__float_as_uint(rm),false,false); rm=__builtin_fmaxf(__uint_as_float(rr[0]),__uint_as_float(rr[1])); } \
      resc=false; \
      if(__builtin_expect(__any(rm>(float)THRL),0)){ const float dl=__builtin_fmaxf(rm,0.f); mhat+=dl; \
        _Pragma("unroll") for(int r=0;r<16;++r){C0[r]-=dl;C1[r]-=dl;} \
        _Pragma("unroll") for(int r=0;r<16;++r)negm[r]=-mhat; asm volatile("":"+v"(negm)); \
        const float f=__builtin_amdgcn_exp2f(-dl); l_reg*=f; if(hi==0)wsf[r32]=f; resc=true; } } \
    SBAR(); \
    GAPB(o[0]=__builtin_amdgcn_mfma_f32_32x32x16_bf16(PAF(0),VFR(0),o[0],0,0,0), C0,0); \
    GAPB(o[1]=__builtin_amdgcn_mfma_f32_32x32x16_bf16(PAF(0),VFR(4),o[1],0,0,0), C0,4); \
    KRD(GL,0); GAPB(o[0]=__builtin_amdgcn_mfma_f32_32x32x16_bf16(PAF(1),VFR(1),o[0],0,0,0), C0,8); \
    KRD(GL,1); GAPB(o[1]=__builtin_amdgcn_mfma_f32_32x32x16_bf16(PAF(1),VFR(5),o[1],0,0,0), C0,12); \
    KRD(GL,2); GAPB(o[0]=__builtin_amdgcn_mfma_f32_32x32x16_bf16(PAF(2),VFR(2),o[0],0,0,0), C1,0); \
    KRD(GL,3); GAPB(o[1]=__builtin_amdgcn_mfma_f32_32x32x16_bf16(PAF(2),VFR(6),o[1],0,0,0), C1,4); \
    GAPB(o[0]=__builtin_amdgcn_mfma_f32_32x32x16_bf16(PAF(3),VFR(3),o[0],0,0,0), C1,8); \
    GAPB(o[1]=__builtin_amdgcn_mfma_f32_32x32x16_bf16(PAF(3),VFR(7),o[1],0,0,0), C1,12); \
    }while(0)
  int t=1;
  #undef CMASK
  #define CMASK(P0,P1,t) do{}while(0)
  for(;t+5<NT;t+=2){
    STEP(pB0,pB1,pA0,pA1,t,true,true,true);     WAIT_BAR(2); RESC(); ROT();
    STEP(pA0,pA1,pB0,pB1,t+1,true,true,true);   WAIT_BAR(2); RESC(); ROT();
  }
  #undef CMASK
  #define CMASK(P0,P1,t) do{int jb_=(t)-(NT-4); if(jb_>=0)cmask(P0,P1,jb_,qrel,hi);}while(0)
  #define ENDW(tt) do{ if((tt)+3<NT){WAIT_BAR(2);} else if((tt)+2<NT){WAIT_BAR(1);} else {WAIT_BAR(0);} }while(0)
  for(;t+1<NT;t+=2){
    STEP(pB0,pB1,pA0,pA1,t,(t+3<NT),(t+1<NT),(t+1<NT));       ENDW(t);   RESC(); ROT();
    STEP(pA0,pA1,pB0,pB1,t+1,(t+4<NT),(t+2<NT),(t+2<NT));     ENDW(t+1); RESC(); ROT();
  }
  STEP(pB0,pB1,pA0,pA1,NT-1,false,false,false); RESC();
  { float sacc=pB0[0]+pB0[1]; _Pragma("unroll") for(int r=2;r<16;++r)sacc+=pB0[r]; _Pragma("unroll") for(int r=0;r<16;++r)sacc+=pB1[r]; l_reg+=sacc;
    pw0=(u32x4){PKW(pB0,0),PKW(pB0,2),PKW(pB0,4),PKW(pB0,6)};pw1=(u32x4){PKW(pB0,8),PKW(pB0,10),PKW(pB0,12),PKW(pB0,14)};pw2=(u32x4){PKW(pB1,0),PKW(pB1,2),PKW(pB1,4),PKW(pB1,6)};pw3=(u32x4){PKW(pB1,8),PKW(pB1,10),PKW(pB1,12),PKW(pB1,14)};
    SBAR(); pv(o,vb0+sl_cur,PAF(0),PAF(1),PAF(2),PAF(3)); }
  #undef PKW
  #undef PAF
  #undef VFR
  #undef PIN
  #undef MX3
  #undef GAPA
  #undef GAPB
  #undef EX
  #undef VRD
  #undef KRD
  #undef STEP
  #undef ENDW
  {auto rr=__builtin_amdgcn_permlane32_swap(__float_as_uint(l_reg),__float_as_uint(l_reg),false,false);l_reg=__uint_as_float(rr[0])+__uint_as_float(rr[1]);}
  if(hi==0)wsf[32+r32]=l_reg;asm volatile("s_waitcnt lgkmcnt(0)":::"memory");
  float rli[16];
  #pragma unroll
  for(int r=0;r<16;++r)rli[r]=__builtin_amdgcn_rcpf(wsf[32+crow(r,hi)]);
  bf16*Ow=O+(rowbase+q0+wid*QBLK)*DM+h*D;
  { bf16*stg=(bf16*)(shm+LDS_OST)+wid*2048;
    #pragma unroll
    for(int r=0;r<16;++r){const int orow=crow(r,hi);
      #pragma unroll
      for(int d0=0;d0<2;++d0)stg[orow*64+d0*32+r32]=__float2bfloat16(o[d0][r]*rli[r]);}
    asm volatile("s_waitcnt lgkmcnt(0)":::"memory");
    #pragma unroll
    for(int i=0;i<4;++i){const int row=i*8+(lane>>3),ch=lane&7; const u32x4 v=*(const u32x4*)(stg+row*64+ch*8); ATTN_STORE16(Ow+(long)row*DM+ch*8,v);} }
  asm volatile("s_waitcnt lgkmcnt(0)\n\ts_barrier":::"memory");
  #undef DMA_K
  #undef DMA_V
  #undef CMASK
  #undef START
  #undef RESC
  #undef ROT
}
constexpr int ATTN_LDS_BYTES=LDS_BYTES;
struct AttnTensors { const bf16* Q; const bf16* K; const bf16* V; bf16* O; };
struct AttnUnit { int bh; int qb; };
struct StaticOrder {
  int vcu;
  __device__ __forceinline__ explicit StaticOrder(int grid,int block):vcu((block%8)*(grid/8)+block/8){}
  __device__ __forceinline__ bool next(int i,AttnUnit&u)const{ if(i>=4||vcu>=256)return false; const int s=vcu&3; u.bh=vcu>>2; u.qb=(i==0)?s:(i==1)?7-s:(i==2)?8+s:15-s; return true; }
  __device__ __forceinline__ void a_ready(const AttnUnit&)const{}
  __device__ __forceinline__ void done(const AttnUnit&)const{}
};
template<class Sched,int THRL=8> __device__ __forceinline__ void attn_phase(char*lds,const AttnTensors&T,const Sched&S){
  AttnUnit u;
  for(int i=0;S.next(i,u);++i){ S.a_ready(u); attn_unit<THRL>(u.bh/NHEAD,u.bh%NHEAD,u.qb,T.Q,T.K,T.V,T.O,lds); S.done(u); }
}
#undef SBAR
#undef WAIT_BAR
}

#ifndef EMU
#define DEV __device__ __forceinline__
typedef unsigned short bf16_t;
typedef short bf16x8 __attribute__((ext_vector_type(8)));
typedef float f32x4 __attribute__((ext_vector_type(4)));
DEV void wave_sync() { __builtin_amdgcn_wave_barrier(); }
DEV f32x4 mfma16(bf16x8 a, bf16x8 b, f32x4 c) { return __builtin_amdgcn_mfma_f32_16x16x32_bf16(a, b, c, 0, 0, 0); }
#endif
#ifdef EMU
#define RW_LAS
#else
#define RW_LAS __attribute__((address_space(3)))
#endif
typedef unsigned u32x2 __attribute__((ext_vector_type(2)));
typedef unsigned u32x4v __attribute__((ext_vector_type(4)));

DEV unsigned f2bf(float f) { unsigned u = __builtin_bit_cast(unsigned, f); return (u + 0x7fffu + ((u >> 16) & 1u)) >> 16; }
DEV float bf2f(unsigned h) { return __builtin_bit_cast(float, h << 16); }
DEV unsigned pk2bf(float lo, float hi) { return f2bf(lo) | (f2bf(hi) << 16); }

constexpr int RW_NPROJ = 3328, RW_PB0 = 1536, RW_T = 4096, RW_MP = 16384;
constexpr int RW_LD = 72;
constexpr int RW_SLOT = 64 * RW_LD * 2;
constexpr int RW_LDF = 68;

struct RwkvP {
    const float* proj;
    const float* mu;
    const float *w0, *a0, *k_k, *k_a, *r_k, *ln_w, *ln_b;
    const float *w2, *a2, *g2;
    const bf16_t *w2t, *a2t, *g2t;
    const float* state_wkv; const float* state_shift;
    bf16_t* MT; float* NN; bf16_t* QQ; float* Y0; bf16_t* SC;
    bf16_t* VG; bf16_t* GG; float* BON;
    bf16_t* mixin;
    float* wkv_p; float* wkv_s;
};

DEV bf16x8 ld8(const bf16_t* p) { return *(const bf16x8*)p; }
DEV u32x2 ld4(const bf16_t* p) { return *(const u32x2*)p; }
DEV void st4(bf16_t* p, u32x2 w) { *(u32x2*)p = w; }
DEV void st1(bf16_t* p, unsigned h) { *p = (bf16_t)h; }
#ifndef EMU
DEV bf16x8 ld8(const RW_LAS bf16_t* p) { return *(const RW_LAS bf16x8*)p; }
DEV u32x2 ld4(const RW_LAS bf16_t* p) { return *(const RW_LAS u32x2*)p; }
DEV void st4(RW_LAS bf16_t* p, u32x2 w) { *(RW_LAS u32x2*)p = w; }
DEV void st1(RW_LAS bf16_t* p, unsigned h) { *p = (bf16_t)h; }
#endif
template <class XP, class YP>
DEV f32x4 mm_tile(XP X, int ldx, int m0, YP Y, int ldy, int n0, int K, f32x4 acc, int lane) {
    XP xp = X + (m0 + (lane & 15)) * ldx + 8 * (lane >> 4);
    YP yp = Y + (n0 + (lane & 15)) * ldy + 8 * (lane >> 4);
    for (int k0 = 0; k0 < K; k0 += 32) {
        const bf16x8 xf = ld8(xp + k0), yf = ld8(yp + k0);
        acc = mfma16(yf, xf, acc);
    }
    return acc;
}
template <class DP> DEV void st_rm(DP D, int ld, int m0, int n0, f32x4 v, int lane) {
    u32x2 w; w.x = pk2bf(v[0], v[1]); w.y = pk2bf(v[2], v[3]);
    st4(D + (m0 + (lane & 15)) * ld + n0 + 4 * (lane >> 4), w);
}
template <class DP> DEV void st_tr(DP D, int ld, int m0, int n0, f32x4 v, int lane) {
#pragma unroll
    for (int r = 0; r < 4; ++r) st1(D + (n0 + 4 * (lane >> 4) + r) * ld + m0 + (lane & 15), f2bf(v[r]));
}
template <class SP> DEV f32x4 ld_rm(SP S, int ld, int m0, int n0, int lane) {
    const u32x2 w = ld4(S + (m0 + (lane & 15)) * ld + n0 + 4 * (lane >> 4));
    return (f32x4){bf2f(w.x & 0xffffu), bf2f(w.x >> 16), bf2f(w.y & 0xffffu), bf2f(w.y >> 16)};
}
DEV float sigmoidf_(float x) { return 1.f / (1.f + __expf(-x)); }
DEV float tanhf_(float x) { const float e = __expf(-2.f * fabsf(x)); const float t = (1.f - e) / (1.f + e); return x < 0.f ? -t : t; }
DEV float softplusf_(float x) { return fmaxf(x, 0.f) + log1pf(__expf(-fabsf(x))); }

DEV void rwkv_passA(const RwkvP& p, int b, int h, int c, RW_LAS unsigned char* lds) {
    const int tid = threadIdx.x, lane = tid & 63, wid = tid >> 6;
    const int r0 = b * RW_T + c * 64;
    const int ch = (b * 8 + h) * 64 + c;
#define SL(i) ((RW_LAS bf16_t*)(lds + (i) * RW_SLOT))
    RW_LAS bf16_t *AT = SL(0), *ATT = SL(1), *KH = SL(2), *BH = SL(3), *RT = SL(4), *VT = SL(5), *KTT = SL(6), *BTT = SL(7);
    RW_LAS bf16_t *TW = SL(0), *XA = SL(1), *SG = SL(2);
    RW_LAS float* LW = (RW_LAS float*)(lds + 8 * RW_SLOT); RW_LAS float* LA = LW + 64 * RW_LDF; RW_LAS float* LC = LA + 64 * RW_LDF;
    RW_LAS bf16_t *AAK = SL(8), *P0 = SL(9), *P0T = SL(10), *ARK = SL(11), *ARB = SL(12), *T1 = SL(13), *P1 = SL(14), *P1T = SL(15), *T0 = SL(2), *GT = SL(3);
    RW_LAS float* PCV = (RW_LAS float*)(lds + 16 * RW_SLOT + 512);
    {
        const int t = tid >> 3, cg = tid & 7;
        const float* cur = p.proj + (size_t)(r0 + t) * RW_NPROJ + RW_PB0 + 1536 + cg * 32;
        const bool hasprev = (c * 64 + t) > 0;
        const float* prv = cur - RW_NPROJ;
        const float* mu = p.mu + 1536 + cg * 32;
#pragma unroll
        for (int q = 0; q < 8; ++q) {
            const f32x4 x = *(const f32x4*)(cur + 4 * q); const f32x4 pv = hasprev ? *(const f32x4*)(prv + 4 * q) : (f32x4){0.f, 0.f, 0.f, 0.f}; const f32x4 m = *(const f32x4*)(mu + 4 * q);
            float y[4];
#pragma unroll
            for (int e = 0; e < 4; ++e) { const float xs = x[e] + (pv[e] - x[e]) * m[e]; y[e] = cg < 2 ? tanhf_(xs) : (cg < 4 ? xs : sigmoidf_(xs)); }
            u32x2 w; w.x = pk2bf(y[0], y[1]); w.y = pk2bf(y[2], y[3]);
            const int cc = cg * 32 + 4 * q;
            RW_LAS bf16_t* dst = cg < 2 ? TW + t * RW_LD + cc : (cg < 4 ? XA + t * RW_LD + (cc - 64) : SG + t * 136 + (cc - 128));
            st4(dst, w);
        }
    }
    __syncthreads();
    {
        const int mi = wid >> 1;
#pragma unroll
        for (int q = 0; q < 2; ++q) {
            const int ni = 2 * (wid & 1) + q; const f32x4 z = {0.f, 0.f, 0.f, 0.f};
            const f32x4 aw = mm_tile(TW, RW_LD, 16 * mi, p.w2t + (size_t)(h * 64) * 64, 64, 16 * ni, 64, z, lane);
            const f32x4 aa = mm_tile(XA, RW_LD, 16 * mi, p.a2t + (size_t)(h * 64) * 64, 64, 16 * ni, 64, z, lane);
            const f32x4 ag = mm_tile(SG, 136, 16 * mi, p.g2t + (size_t)(h * 64) * 128, 128, 16 * ni, 128, z, lane);
            const int t = 16 * mi + (lane & 15), d0 = 16 * ni + 4 * (lane >> 4);
            f32x4 lw, la;
#pragma unroll
            for (int r = 0; r < 4; ++r) { const int hd = h * 64 + d0 + r;
                const float wraw = -softplusf_(-(p.w0[hd] + aw[r])) - 0.5f; lw[r] = -__expf(wraw);
                la[r] = sigmoidf_(p.a0[hd] + aa[r]); }
            *(RW_LAS f32x4*)(LW + t * RW_LDF + d0) = lw; *(RW_LAS f32x4*)(LA + t * RW_LDF + d0) = la;
            u32x2 gw; gw.x = pk2bf(ag[0], ag[1]); gw.y = pk2bf(ag[2], ag[3]);
            *(u32x2*)(p.GG + (size_t)(r0 + t) * 512 + h * 64 + d0) = gw;
        }
    }
    __syncthreads();
    if (tid < 64) { float run = 0.f;
#pragma unroll 8
        for (int t = 0; t < 64; ++t) { run += LW[t * RW_LDF + tid]; LC[t * RW_LDF + tid] = run; } }
    __syncthreads();
    {
        const int t = tid >> 3, dg = tid & 7, d0 = dg * 8, hd0 = h * 64 + d0;
        const float* cur = p.proj + (size_t)(r0 + t) * RW_NPROJ + RW_PB0 + hd0;
        const bool hasprev = (c * 64 + t) > 0; const float* prv = cur - RW_NPROJ;
        float r[8], k[8], v[8], kk[8], a[8], lw[8], L[8], L63[8];
#pragma unroll
        for (int q = 0; q < 2; ++q) {
#pragma unroll
            for (int s = 0; s < 3; ++s) {
                const f32x4 x = *(const f32x4*)(cur + s * 512 + 4 * q); const f32x4 pv = hasprev ? *(const f32x4*)(prv + s * 512 + 4 * q) : (f32x4){0.f, 0.f, 0.f, 0.f};
                const f32x4 m = *(const f32x4*)(p.mu + s * 512 + hd0 + 4 * q);
#pragma unroll
                for (int e = 0; e < 4; ++e) { const float xs = x[e] + (pv[e] - x[e]) * m[e]; if (s == 0) r[4 * q + e] = xs; else if (s == 1) k[4 * q + e] = xs; else v[4 * q + e] = xs; }
            }
            const f32x4 x1 = *(const RW_LAS f32x4*)(LW + t * RW_LDF + d0 + 4 * q), x2 = *(const RW_LAS f32x4*)(LC + t * RW_LDF + d0 + 4 * q), x3 = *(const RW_LAS f32x4*)(LA + t * RW_LDF + d0 + 4 * q), x4 = *(const RW_LAS f32x4*)(LC + 63 * RW_LDF + d0 + 4 * q);
#pragma unroll
            for (int e = 0; e < 4; ++e) { lw[4 * q + e] = x1[e]; L[4 * q + e] = x2[e]; a[4 * q + e] = x3[e]; L63[4 * q + e] = x4[e]; }
        }
        float n2 = 0.f, bon = 0.f; float k2[8];
#pragma unroll
        for (int e = 0; e < 8; ++e) { kk[e] = k[e] * p.k_k[hd0 + e]; n2 += kk[e] * kk[e]; k2[e] = k[e] * (1.f + (a[e] - 1.f) * p.k_a[hd0 + e]); bon += r[e] * k2[e] * p.r_k[hd0 + e]; }
        n2 += __shfl_xor(n2, 1); n2 += __shfl_xor(n2, 2); n2 += __shfl_xor(n2, 4);
        bon += __shfl_xor(bon, 1); bon += __shfl_xor(bon, 2); bon += __shfl_xor(bon, 4);
        const float inv = 1.f / fmaxf(sqrtf(n2), 1e-12f);
        if (dg == 0) p.BON[(size_t)(r0 + t) * 8 + h] = bon;
        { u32x4v w; w.x = pk2bf(v[0], v[1]); w.y = pk2bf(v[2], v[3]); w.z = pk2bf(v[4], v[5]); w.w = pk2bf(v[6], v[7]); *(u32x4v*)(p.VG + (size_t)(r0 + t) * 512 + hd0) = w; }
        float at[8], kh[8], bh[8], rt[8], kt[8], bt[8];
#pragma unroll
        for (int e = 0; e < 8; ++e) { kk[e] *= inv; const float P = __expf(L[e]), Pi = __expf(-L[e]), Pm1 = __expf(L[e] - lw[e]), Pc = __expf(L63[e] - L[e]); const float bb = kk[e] * a[e];
            at[e] = -kk[e] * Pm1; kh[e] = k2[e] * Pi; bh[e] = bb * Pi; rt[e] = r[e] * P; kt[e] = k2[e] * Pc; bt[e] = bb * Pc; }
#define RW_ST8(D, ARR_) { u32x4v w_; w_.x = pk2bf(ARR_[0], ARR_[1]); w_.y = pk2bf(ARR_[2], ARR_[3]); w_.z = pk2bf(ARR_[4], ARR_[5]); w_.w = pk2bf(ARR_[6], ARR_[7]); *(RW_LAS u32x4v*)(D + t * RW_LD + d0) = w_; }
        RW_ST8(AT, at) RW_ST8(KH, kh) RW_ST8(BH, bh) RW_ST8(RT, rt)
#undef RW_ST8
#pragma unroll
        for (int e = 0; e < 8; ++e) { ATT[(d0 + e) * RW_LD + t] = (bf16_t)f2bf(at[e]); VT[(d0 + e) * RW_LD + t] = (bf16_t)f2bf(v[e]); KTT[(d0 + e) * RW_LD + t] = (bf16_t)f2bf(kt[e]); BTT[(d0 + e) * RW_LD + t] = (bf16_t)f2bf(bt[e]); }
        if (t == 0) {
#pragma unroll
            for (int e = 0; e < 8; ++e) PCV[d0 + e] = __expf(L63[e]); }
    }
    __syncthreads();
    const int mi = wid >> 1; const f32x4 z4 = {0.f, 0.f, 0.f, 0.f};
    const int mrow = 16 * mi + (lane & 15);
#pragma unroll
    for (int q = 0; q < 2; ++q) {
        const int ni = 2 * (wid & 1) + q, nc0 = 16 * ni + 4 * (lane >> 4);
        f32x4 ak = mm_tile(AT, RW_LD, 16 * mi, KH, RW_LD, 16 * ni, 64, z4, lane);
        f32x4 ab = mm_tile(AT, RW_LD, 16 * mi, BH, RW_LD, 16 * ni, 64, z4, lane);
        f32x4 rk = mm_tile(RT, RW_LD, 16 * mi, KH, RW_LD, 16 * ni, 64, z4, lane);
        f32x4 rb = mm_tile(RT, RW_LD, 16 * mi, BH, RW_LD, 16 * ni, 64, z4, lane);
        f32x4 t1;
#pragma unroll
        for (int r = 0; r < 4; ++r) { const int n = nc0 + r; if (!(n < mrow)) { ak[r] = 0.f; ab[r] = 0.f; } if (!(n <= mrow)) { rk[r] = 0.f; rb[r] = 0.f; } t1[r] = ab[r] + (n == mrow ? 1.f : 0.f); }
        st_rm(AAK, RW_LD, 16 * mi, 16 * ni, ak, lane); st_rm(P0, RW_LD, 16 * mi, 16 * ni, ab, lane); st_tr(P0T, RW_LD, 16 * mi, 16 * ni, ab, lane);
        st_rm(ARK, RW_LD, 16 * mi, 16 * ni, rk, lane); st_rm(ARB, RW_LD, 16 * mi, 16 * ni, rb, lane); st_rm(T1, RW_LD, 16 * mi, 16 * ni, t1, lane);
    }
    __syncthreads();
#pragma unroll
    for (int q = 0; q < 2; ++q) {
        const int ni = 2 * (wid & 1) + q;
        const f32x4 pp = mm_tile(P0, RW_LD, 16 * mi, P0T, RW_LD, 16 * ni, 64, z4, lane);
        st_rm(P1, RW_LD, 16 * mi, 16 * ni, pp, lane); st_tr(P1T, RW_LD, 16 * mi, 16 * ni, pp, lane);
        const f32x4 g = mm_tile(AAK, RW_LD, 16 * mi, VT, RW_LD, 16 * ni, 64, z4, lane);
        st_tr(GT, RW_LD, 16 * mi, 16 * ni, g, lane);
    }
    __syncthreads();
#pragma unroll
    for (int kx = 1; kx <= 5; ++kx) {
        RW_LAS bf16_t* Pc = (kx & 1) ? P1 : P0; RW_LAS bf16_t* PcT = (kx & 1) ? P1T : P0T; RW_LAS bf16_t* Pn = (kx & 1) ? P0 : P1; RW_LAS bf16_t* PnT = (kx & 1) ? P0T : P1T;
        RW_LAS bf16_t* Tc = (kx & 1) ? T1 : T0; RW_LAS bf16_t* Tn = (kx & 1) ? T0 : T1;
#pragma unroll
        for (int q = 0; q < 2; ++q) {
            const int ni = 2 * (wid & 1) + q;
            const f32x4 tt = mm_tile(Tc, RW_LD, 16 * mi, PcT, RW_LD, 16 * ni, 64, ld_rm(Tc, RW_LD, 16 * mi, 16 * ni, lane), lane);
            st_rm(Tn, RW_LD, 16 * mi, 16 * ni, tt, lane);
            if (kx < 5) { const f32x4 pp = mm_tile(Pc, RW_LD, 16 * mi, PcT, RW_LD, 16 * ni, 64, z4, lane); st_rm(Pn, RW_LD, 16 * mi, 16 * ni, pp, lane); st_tr(PnT, RW_LD, 16 * mi, 16 * ni, pp, lane); }
        }
        __syncthreads();
    }
    RW_LAS bf16_t *WT = SL(9), *UT = SL(10);
#pragma unroll
    for (int q = 0; q < 2; ++q) {
        const int ni = 2 * (wid & 1) + q;
        const f32x4 w = mm_tile(T0, RW_LD, 16 * mi, ATT, RW_LD, 16 * ni, 64, z4, lane); st_tr(WT, RW_LD, 16 * mi, 16 * ni, w, lane);
        const f32x4 u = mm_tile(T0, RW_LD, 16 * mi, GT, RW_LD, 16 * ni, 64, z4, lane);  st_tr(UT, RW_LD, 16 * mi, 16 * ni, u, lane);
    }
    __syncthreads();
    {
        bf16_t* gQ = p.QQ + (size_t)ch * 4096; float* gY0 = p.Y0 + (size_t)ch * 4096; bf16_t* gM = p.MT + (size_t)ch * 4096; float* gN = p.NN + (size_t)ch * 4096;
#pragma unroll
        for (int q = 0; q < 2; ++q) {
            const int ni = 2 * (wid & 1) + q, nc0 = 16 * ni + 4 * (lane >> 4);
            const f32x4 qq = mm_tile(ARB, RW_LD, 16 * mi, WT, RW_LD, 16 * ni, 64, ld_rm(RT, RW_LD, 16 * mi, 16 * ni, lane), lane);
            st_rm(gQ, 64, 16 * mi, 16 * ni, qq, lane);
            f32x4 y0 = mm_tile(ARK, RW_LD, 16 * mi, VT, RW_LD, 16 * ni, 64, z4, lane); y0 = mm_tile(ARB, RW_LD, 16 * mi, UT, RW_LD, 16 * ni, 64, y0, lane);
            *(f32x4*)(gY0 + mrow * 64 + nc0) = y0;
            f32x4 mt = mm_tile(BTT, RW_LD, 16 * mi, WT, RW_LD, 16 * ni, 64, z4, lane);
#pragma unroll
            for (int r = 0; r < 4; ++r) if (nc0 + r == mrow) mt[r] += PCV[mrow];
            st_rm(gM, 64, 16 * mi, 16 * ni, mt, lane);
            f32x4 nn = mm_tile(VT, RW_LD, 16 * mi, KTT, RW_LD, 16 * ni, 64, z4, lane); nn = mm_tile(UT, RW_LD, 16 * mi, BTT, RW_LD, 16 * ni, 64, nn, lane);
            *(f32x4*)(gN + mrow * 64 + nc0) = nn;
        }
    }
    __syncthreads();
#undef SL
}

DEV void rwkv_passB(const RwkvP& p, int b, int h, int vb, RW_LAS unsigned char* wlds, int lane, int nchunk = 64) {
    RW_LAS bf16_t* S = (RW_LAS bf16_t*)wlds;
    for (int i = lane; i < 16 * RW_LD / 2; i += 64) ((RW_LAS unsigned*)S)[i] = 0u;
    wave_sync();
    f32x4 acc[4];
#pragma unroll
    for (int ni = 0; ni < 4; ++ni) acc[ni] = (f32x4){0.f, 0.f, 0.f, 0.f};
    const int vrow = vb * 16 + (lane & 15);
    for (int c = 0; c < nchunk; ++c) {
        const size_t ch = (size_t)((b * 8 + h) * 64 + c);
        { const int rr = lane >> 2, cc = (lane & 3) * 16;
          const u32x4v w0 = *(const RW_LAS u32x4v*)(S + rr * RW_LD + cc), w1 = *(const RW_LAS u32x4v*)(S + rr * RW_LD + cc + 8);
          bf16_t* dst = p.SC + ch * 4096 + (size_t)(vb * 16 + rr) * 64 + cc; *(u32x4v*)dst = w0; *(u32x4v*)(dst + 8) = w1; }
        const bf16_t* M = p.MT + ch * 4096; const float* N = p.NN + ch * 4096;
#pragma unroll
        for (int ni = 0; ni < 4; ++ni) {
            const f32x4 n4 = *(const f32x4*)(N + vrow * 64 + 16 * ni + 4 * (lane >> 4));
            acc[ni] = mm_tile(S, RW_LD, 0, M, 64, 16 * ni, 64, n4, lane);
        }
        wave_sync();
#pragma unroll
        for (int ni = 0; ni < 4; ++ni) st_rm(S, RW_LD, 0, 16 * ni, acc[ni], lane);
        wave_sync();
    }
    float* out = p.wkv_p + (size_t)(b * 8 + h) * 4096;
#pragma unroll
    for (int ni = 0; ni < 4; ++ni) *(f32x4*)(out + vrow * 64 + 16 * ni + 4 * (lane >> 4)) = acc[ni];
}

DEV void rwkv_passC(const RwkvP& p, int b, int h, int c, int lane) {
    const size_t ch = (size_t)((b * 8 + h) * 64 + c); const int r0 = b * RW_T + c * 64;
    const bf16_t* Q = p.QQ + ch * 4096; const bf16_t* S = p.SC + ch * 4096; const float* Y0 = p.Y0 + ch * 4096;
#pragma unroll 1
    for (int mi = 0; mi < 4; ++mi) {
        const int t = 16 * mi + (lane & 15); f32x4 y[4];
#pragma unroll
        for (int ni = 0; ni < 4; ++ni) { const f32x4 y0 = *(const f32x4*)(Y0 + t * 64 + 16 * ni + 4 * (lane >> 4)); y[ni] = mm_tile(Q, 64, 16 * mi, S, 64, 16 * ni, 64, y0, lane); }
        float s = 0.f;
#pragma unroll
        for (int ni = 0; ni < 4; ++ni) s += (y[ni][0] + y[ni][1]) + (y[ni][2] + y[ni][3]);
        s += __shfl_xor(s, 16); s += __shfl_xor(s, 32);
        const float mean = s * (1.f / 64.f); float q = 0.f;
#pragma unroll
        for (int ni = 0; ni < 4; ++ni)
#pragma unroll
            for (int r = 0; r < 4; ++r) { const float d = y[ni][r] - mean; q += d * d; }
        q += __shfl_xor(q, 16); q += __shfl_xor(q, 32);
        const float rstd = 1.f / sqrtf(q * (1.f / 64.f) + 64e-5f);
        const float bon = p.BON[(size_t)(r0 + t) * 8 + h];
#pragma unroll
        for (int ni = 0; ni < 4; ++ni) {
            const int v0 = 16 * ni + 4 * (lane >> 4), hv = h * 64 + v0;
            const u32x2 vw = *(const u32x2*)(p.VG + (size_t)(r0 + t) * 512 + hv), gw = *(const u32x2*)(p.GG + (size_t)(r0 + t) * 512 + hv);
            const float vv[4] = {bf2f(vw.x & 0xffffu), bf2f(vw.x >> 16), bf2f(vw.y & 0xffffu), bf2f(vw.y >> 16)};
            const float gg[4] = {bf2f(gw.x & 0xffffu), bf2f(gw.x >> 16), bf2f(gw.y & 0xffffu), bf2f(gw.y >> 16)};
            float o[4];
#pragma unroll
            for (int r = 0; r < 4; ++r) o[r] = ((y[ni][r] - mean) * rstd * p.ln_w[hv + r] + p.ln_b[hv + r] + bon * vv[r]) * gg[r];
            u32x2 w; w.x = pk2bf(o[0], o[1]); w.y = pk2bf(o[2], o[3]);
            *(u32x2*)(p.mixin + (size_t)(r0 + t) * 1024 + 512 + hv) = w;
        }
    }
}

DEV void rwkv_sample(const RwkvP& p, int n, int h, RW_LAS unsigned char* wlds, int lane) {
    RW_LAS float* W = (RW_LAS float*)wlds;
    const int row = RW_MP + n, d = lane, hd = h * 64 + d;
    const float* pb = p.proj + (size_t)row * RW_NPROJ + RW_PB0; const float* pv = p.state_shift + (size_t)n * 1792;
#define XS(col) (pb[col] + (pv[col] - pb[col]) * p.mu[col])
    const float r = XS(hd), k = XS(512 + hd), v = XS(1024 + hd);
    const float tw = tanhf_(XS(1536 + d)), xa = XS(1600 + d), sg0 = sigmoidf_(XS(1664 + d)), sg1 = sigmoidf_(XS(1728 + d));
#undef XS
    float aw = 0.f, aa = 0.f, ag = 0.f;
    for (int j = 0; j < 64; ++j) { const float twj = __shfl(tw, j), xaj = __shfl(xa, j), g0 = __shfl(sg0, j), g1 = __shfl(sg1, j);
        aw += twj * p.w2[j * 512 + hd]; aa += xaj * p.a2[j * 512 + hd]; ag += g0 * p.g2[j * 512 + hd] + g1 * p.g2[(64 + j) * 512 + hd]; }
    const float wraw = -softplusf_(-(p.w0[hd] + aw)) - 0.5f; const float w = __expf(-__expf(wraw));
    const float a = sigmoidf_(p.a0[hd] + aa);
    float kk = k * p.k_k[hd]; float n2 = kk * kk;
#pragma unroll
    for (int o = 1; o < 64; o <<= 1) n2 += __shfl_xor(n2, o);
    kk /= fmaxf(sqrtf(n2), 1e-12f);
    const float k2 = k * (1.f + (a - 1.f) * p.k_a[hd]);
    float bon = r * k2 * p.r_k[hd];
#pragma unroll
    for (int o = 1; o < 64; o <<= 1) bon += __shfl_xor(bon, o);
    W[d] = w; W[64 + d] = kk * a; W[128 + d] = k2; W[192 + d] = r; W[256 + d] = -kk;
    wave_sync();
    const float* S0 = p.state_wkv + ((size_t)(n * 8 + h) * 64 + lane) * 64;
    float* S1 = p.wkv_s + ((size_t)(n * 8 + h) * 64 + lane) * 64;
    float sa = 0.f;
#pragma unroll 4
    for (int q = 0; q < 16; ++q) { const f32x4 s = *(const f32x4*)(S0 + 4 * q);
#pragma unroll
        for (int e = 0; e < 4; ++e) sa += s[e] * W[256 + 4 * q + e]; }
    float y = 0.f;
#pragma unroll 4
    for (int q = 0; q < 16; ++q) { const f32x4 s = *(const f32x4*)(S0 + 4 * q); f32x4 o;
#pragma unroll
        for (int e = 0; e < 4; ++e) { const int kx = 4 * q + e; o[e] = s[e] * W[kx] + sa * W[64 + kx] + v * W[128 + kx]; y += o[e] * W[192 + kx]; }
        *(f32x4*)(S1 + 4 * q) = o; }
    float s = y;
#pragma unroll
    for (int o = 1; o < 64; o <<= 1) s += __shfl_xor(s, o);
    const float mean = s * (1.f / 64.f); float q2 = (y - mean) * (y - mean);
#pragma unroll
    for (int o = 1; o < 64; o <<= 1) q2 += __shfl_xor(q2, o);
    const float rstd = 1.f / sqrtf(q2 * (1.f / 64.f) + 64e-5f);
    const float o = ((y - mean) * rstd * p.ln_w[hd] + p.ln_b[hd] + bon * v) * ag;
    p.mixin[(size_t)row * 1024 + 512 + hd] = (bf16_t)f2bf(o);
    wave_sync();
}

constexpr int MK_MP = 16384, MK_MS = 128, MK_MR = 16512, MK_MPAD = 16640, MK_D = 1024, MK_FF = 2816, MK_NPROJ = 3328;
constexpr float MK_EPS = 1e-6f;
constexpr float MK_C2 = 0.125f * 1.4426950408889634f;
constexpr float MK_LAM_INIT = 0.2f;

DEV float wsum64(float v) {
#pragma unroll
    for (int o = 1; o < 64; o <<= 1) v += __shfl_xor(v, o);
    return v;
}
DEV void ld_row(const float* row, int lane, f32x4 (&v)[4]) {
#pragma unroll
    for (int j = 0; j < 4; ++j) v[j] = *(const f32x4*)(row + 4 * lane + 256 * j);
}
DEV void st_row(float* row, int lane, const f32x4 (&v)[4]) {
#pragma unroll
    for (int j = 0; j < 4; ++j) *(f32x4*)(row + 4 * lane + 256 * j) = v[j];
}
DEV void st_row_bf16(bf16_t* row, int lane, const f32x4 (&v)[4]) {
#pragma unroll
    for (int j = 0; j < 4; ++j) { u32x2 w; w.x = pk2bf(v[j][0], v[j][1]); w.y = pk2bf(v[j][2], v[j][3]); *(u32x2*)(row + 4 * lane + 256 * j) = w; }
}
DEV float row_rstd(const f32x4 (&v)[4]) {
    float s = 0.f;
#pragma unroll
    for (int j = 0; j < 4; ++j) s += (v[j][0] * v[j][0] + v[j][1] * v[j][1]) + (v[j][2] * v[j][2] + v[j][3] * v[j][3]);
    return 1.f / sqrtf(wsum64(s) * (1.f / 1024.f) + MK_EPS);
}
DEV void row_norm(const f32x4 (&v)[4], const float* g, int lane, f32x4 (&o)[4]) {
    const float rs = row_rstd(v);
#pragma unroll
    for (int j = 0; j < 4; ++j) { const f32x4 gg = *(const f32x4*)(g + 4 * lane + 256 * j); o[j] = v[j] * rs * gg; }
}
DEV const float* x_row(const float* xp, const float* xs, int r) { return r < MK_MP ? xp + (size_t)r * MK_D : xs + (size_t)(r - MK_MP) * MK_D; }

DEV void rowpass_A(const float* xp, const float* xs, const float* gpre, bf16_t* XN, int r, int lane) {
    f32x4 v[4], o[4];
    if (r >= MK_MR) {
#pragma unroll
        for (int j = 0; j < 4; ++j) o[j] = (f32x4){0.f, 0.f, 0.f, 0.f};
    } else { ld_row(x_row(xp, xs, r), lane, v); row_norm(v, gpre, lane, o); }
    st_row_bf16(XN + (size_t)r * MK_D, lane, o);
}
DEV void rowpass_B(const float* resrow, const float* F, const float* gpost, float scale, float* HRES, const float* gpre, bf16_t* XN, int r, int lane) {
    f32x4 f[4], x[4], o[4];
    ld_row(F + (size_t)r * MK_D, lane, f); ld_row(resrow, lane, x);
    row_norm(f, gpost, lane, o);
#pragma unroll
    for (int j = 0; j < 4; ++j) x[j] = x[j] + o[j] * scale;
    st_row(HRES + (size_t)r * MK_D, lane, x);
    row_norm(x, gpre, lane, o);
    st_row_bf16(XN + (size_t)r * MK_D, lane, o);
}
DEV void rowpass_D(const float* HRES, const float* F, const float* gpost, float* outrow, int r, int lane) {
    f32x4 f[4], x[4], o[4];
    ld_row(F + (size_t)r * MK_D, lane, f); ld_row(HRES + (size_t)r * MK_D, lane, x);
    row_norm(f, gpost, lane, o);
#pragma unroll
    for (int j = 0; j < 4; ++j) x[j] = x[j] + o[j] * 0.5f;
    st_row(outrow, lane, x);
}

struct PostP {
    const float* proj; bf16_t *QB, *KB, *VB;
    float *k_p, *v_p, *k_s, *v_s, *shift_p, *shift_s;
};
DEV void post_win_row(const PostP& p, int r, int lane) {
    const float* row = p.proj + (size_t)r * MK_NPROJ;
    const int pos = r < MK_MP ? (r & 4095) : 2048;
    const int i8 = lane & 7;
    float cs[8], sn[8];
#pragma unroll
    for (int e = 0; e < 8; ++e) { const float invf = expf(-(float)e * 0.125f * 13.122363377404328f); const float ang = (float)pos * invf; cs[e] = cosf(ang); sn[e] = sinf(ang); }
    float* kout = r < MK_MP ? p.k_p + (size_t)r * 512 : p.k_s + (size_t)(r - MK_MP) * 512;
    float* vout = r < MK_MP ? p.v_p + (size_t)r * 512 : p.v_s + (size_t)(r - MK_MP) * 512;
#pragma unroll
    for (int s = 0; s < 3; ++s) {
        const f32x4 a = *(const f32x4*)(row + s * 512 + lane * 8), b = *(const f32x4*)(row + s * 512 + lane * 8 + 4);
        float x[8] = {a[0], a[1], a[2], a[3], b[0], b[1], b[2], b[3]};
        if (s < 2) {
            float o[8];
#pragma unroll
            for (int e = 0; e < 8; ++e) { const float other = __shfl_xor(x[e], 1); o[e] = i8 == 0 ? x[e] * cs[e] - other * sn[e] : (i8 == 1 ? x[e] * cs[e] + other * sn[e] : x[e]); }
#pragma unroll
            for (int e = 0; e < 8; ++e) x[e] = o[e];
        }
        if (s >= 1) { float* o = s == 1 ? kout : vout; *(f32x4*)(o + lane * 8) = (f32x4){x[0], x[1], x[2], x[3]}; *(f32x4*)(o + lane * 8 + 4) = (f32x4){x[4], x[5], x[6], x[7]}; }
        const float sc = s == 0 ? MK_C2 : 1.f;
        u32x4v w; w.x = pk2bf(x[0] * sc, x[1] * sc); w.y = pk2bf(x[2] * sc, x[3] * sc); w.z = pk2bf(x[4] * sc, x[5] * sc); w.w = pk2bf(x[6] * sc, x[7] * sc);
        bf16_t* dst = (s == 0 ? p.QB : (s == 1 ? p.KB : p.VB)) + (size_t)r * 512 + lane * 8;
        *(u32x4v*)dst = w;
    }
    float* sh = nullptr;
    if (r >= MK_MP) sh = p.shift_s + (size_t)(r - MK_MP) * 1792; else if ((r & 4095) == 4095) sh = p.shift_p + (size_t)(r >> 12) * 1792;
    if (sh) { for (int i = lane; i < 448; i += 64) *(f32x4*)(sh + 4 * i) = *(const f32x4*)(row + 1536 + 4 * i); }
}

DEV void attn_combine_row(const bf16_t* O16, const float* subln, float lam, bf16_t* mixin, int r, int lane) {
    const u32x4v w0 = *(const u32x4v*)(O16 + (size_t)r * 1024 + lane * 16), w1 = *(const u32x4v*)(O16 + (size_t)r * 1024 + lane * 16 + 8);
    const unsigned ww[8] = {w0.x, w0.y, w0.z, w0.w, w1.x, w1.y, w1.z, w1.w};
    float x[16], y[16]; float ss = 0.f;
#pragma unroll
    for (int i = 0; i < 8; ++i) { x[2 * i] = bf2f(ww[i] & 0xffffu); x[2 * i + 1] = bf2f(ww[i] >> 16); }
#pragma unroll
    for (int i = 0; i < 16; ++i) { const float o = __shfl_xor(x[i], 8); y[i] = x[i] - lam * o; ss += y[i] * y[i]; }
    ss += __shfl_xor(ss, 1); ss += __shfl_xor(ss, 2); ss += __shfl_xor(ss, 4);
    const float rs = 1.f / sqrtf(ss * (1.f / 128.f) + MK_EPS) * (1.f - MK_LAM_INIT);
    if ((lane & 8) == 0) {
        const int h = lane >> 4, half = (lane >> 2) & 1, e0 = half * 64 + (lane & 3) * 16;
        unsigned o[8];
#pragma unroll
        for (int i = 0; i < 8; ++i) o[i] = pk2bf(y[2 * i] * rs * subln[e0 + 2 * i], y[2 * i + 1] * rs * subln[e0 + 2 * i + 1]);
        bf16_t* dst = mixin + (size_t)r * 1024 + h * 128 + e0;
        *(u32x4v*)dst = (u32x4v){o[0], o[1], o[2], o[3]}; *(u32x4v*)(dst + 8) = (u32x4v){o[4], o[5], o[6], o[7]};
    }
}

struct DecP {
    const float *cache_k, *cache_v; const int* page_table;
    const bf16_t* QB;
    float *PM, *PL, *PO;
    const float *k_s, *v_s;
    const float* subln; bf16_t* mixin;
};
struct DecState { float m[2], l[2], o[2][8]; };
DEV void dec_token(DecState& S, const float (&q)[8], const f32x4& k0, const f32x4& k1, const f32x4& v0, const f32x4& v1, int lane) {
    float s = (q[0] * k0[0] + q[1] * k0[1]) + (q[2] * k0[2] + q[3] * k0[3]) + (q[4] * k1[0] + q[5] * k1[1]) + (q[6] * k1[2] + q[7] * k1[3]);
    s += __shfl_xor(s, 1); s += __shfl_xor(s, 2); s += __shfl_xor(s, 4);
    const float so = __shfl_xor(s, 8);
    const bool j1 = (lane & 8) != 0; const float sj[2] = {j1 ? so : s, j1 ? s : so};
    const float vv[8] = {v0[0], v0[1], v0[2], v0[3], v1[0], v1[1], v1[2], v1[3]};
#pragma unroll
    for (int j = 0; j < 2; ++j) {
        const float mn = fmaxf(S.m[j], sj[j]); const float al = exp2f(S.m[j] - mn), pp = exp2f(sj[j] - mn);
        S.m[j] = mn; S.l[j] = S.l[j] * al + pp;
#pragma unroll
        for (int e = 0; e < 8; ++e) S.o[j][e] = S.o[j][e] * al + pp * vv[e];
    }
}
DEV void decode_unit(const DecP& p, int n, int half, RW_LAS unsigned char* lds) {
    const int tid = threadIdx.x, lane = tid & 63, wid = tid >> 6;
    RW_LAS float* LM = (RW_LAS float*)lds; RW_LAS float* LL = LM + 64; RW_LAS float* LO = LM + 128;
    const int page = p.page_table[n * 16 + half * 8 + wid];
    const float* kp = p.cache_k + (size_t)page * 65536 + lane * 8; const float* vp = p.cache_v + (size_t)page * 65536 + lane * 8;
    float q[8];
    { const u32x4v w = *(const u32x4v*)(p.QB + (size_t)(MK_MP + n) * 512 + lane * 8); const unsigned ww[4] = {w.x, w.y, w.z, w.w};
#pragma unroll
      for (int i = 0; i < 4; ++i) { q[2 * i] = bf2f(ww[i] & 0xffffu); q[2 * i + 1] = bf2f(ww[i] >> 16); } }
    DecState S;
#pragma unroll
    for (int j = 0; j < 2; ++j) { S.m[j] = -1e30f; S.l[j] = 0.f;
#pragma unroll
        for (int e = 0; e < 8; ++e) S.o[j][e] = 0.f; }
#pragma unroll 1
    for (int t0 = 0; t0 < 128; t0 += 4) {
        f32x4 kk[4][2], vv[4][2];
#pragma unroll
        for (int i = 0; i < 4; ++i) { kk[i][0] = *(const f32x4*)(kp + (size_t)(t0 + i) * 512); kk[i][1] = *(const f32x4*)(kp + (size_t)(t0 + i) * 512 + 4);
                                      vv[i][0] = *(const f32x4*)(vp + (size_t)(t0 + i) * 512); vv[i][1] = *(const f32x4*)(vp + (size_t)(t0 + i) * 512 + 4); }
#pragma unroll
        for (int i = 0; i < 4; ++i) dec_token(S, q, kk[i][0], kk[i][1], vv[i][0], vv[i][1], lane);
    }
    if ((lane & 15) == 0) { const int h = lane >> 4; LM[wid * 8 + h * 2] = S.m[0]; LM[wid * 8 + h * 2 + 1] = S.m[1]; LL[wid * 8 + h * 2] = S.l[0]; LL[wid * 8 + h * 2 + 1] = S.l[1]; }
#pragma unroll
    for (int j = 0; j < 2; ++j) { *(RW_LAS f32x4*)(LO + (wid * 2 + j) * 512 + lane * 8) = (f32x4){S.o[j][0], S.o[j][1], S.o[j][2], S.o[j][3]}; *(RW_LAS f32x4*)(LO + (wid * 2 + j) * 512 + lane * 8 + 4) = (f32x4){S.o[j][4], S.o[j][5], S.o[j][6], S.o[j][7]}; }
    __syncthreads();
    if (tid < 128) {
        const int j = tid >> 6, ll = tid & 63, h = ll >> 4, hj = h * 2 + j;
        float M = -1e30f;
#pragma unroll
        for (int w = 0; w < 8; ++w) M = fmaxf(M, LM[w * 8 + hj]);
        float l = 0.f, o[8] = {0.f, 0.f, 0.f, 0.f, 0.f, 0.f, 0.f, 0.f};
#pragma unroll
        for (int w = 0; w < 8; ++w) { const float f = exp2f(LM[w * 8 + hj] - M); l += LL[w * 8 + hj] * f;
#pragma unroll
            for (int e = 0; e < 8; ++e) o[e] += LO[(w * 2 + j) * 512 + ll * 8 + e] * f; }
        float* po = p.PO + ((size_t)(n * 2 + half) * 2 + j) * 512 + ll * 8;
        *(f32x4*)po = (f32x4){o[0], o[1], o[2], o[3]}; *(f32x4*)(po + 4) = (f32x4){o[4], o[5], o[6], o[7]};
        if ((ll & 15) == 0) { p.PM[(n * 2 + half) * 8 + hj] = M; p.PL[(n * 2 + half) * 8 + hj] = l; }
    }
    __syncthreads();
}
DEV void decode_final(const DecP& p, int n, float lam, int lane) {
    const int h = lane >> 4;
    float q[8];
    { const u32x4v w = *(const u32x4v*)(p.QB + (size_t)(MK_MP + n) * 512 + lane * 8); const unsigned ww[4] = {w.x, w.y, w.z, w.w};
#pragma unroll
      for (int i = 0; i < 4; ++i) { q[2 * i] = bf2f(ww[i] & 0xffffu); q[2 * i + 1] = bf2f(ww[i] >> 16); } }
    DecState S;
#pragma unroll
    for (int j = 0; j < 2; ++j) {
        const int hj = h * 2 + j; const float m0 = p.PM[(n * 2 + 0) * 8 + hj], m1 = p.PM[(n * 2 + 1) * 8 + hj]; const float M = fmaxf(m0, m1), f0 = exp2f(m0 - M), f1 = exp2f(m1 - M);
        S.m[j] = M; S.l[j] = p.PL[(n * 2 + 0) * 8 + hj] * f0 + p.PL[(n * 2 + 1) * 8 + hj] * f1;
        const float* o0 = p.PO + ((size_t)(n * 2 + 0) * 2 + j) * 512 + lane * 8; const float* o1 = p.PO + ((size_t)(n * 2 + 1) * 2 + j) * 512 + lane * 8;
#pragma unroll
        for (int e = 0; e < 8; ++e) S.o[j][e] = o0[e] * f0 + o1[e] * f1;
    }
    const float* kc = p.k_s + (size_t)n * 512 + lane * 8; const float* vc = p.v_s + (size_t)n * 512 + lane * 8;
    dec_token(S, q, *(const f32x4*)kc, *(const f32x4*)(kc + 4), *(const f32x4*)vc, *(const f32x4*)(vc + 4), lane);
    float y[8]; float ss = 0.f;
#pragma unroll
    for (int e = 0; e < 8; ++e) { y[e] = S.o[0][e] / S.l[0] - lam * (S.o[1][e] / S.l[1]); ss += y[e] * y[e]; }
    ss += __shfl_xor(ss, 1); ss += __shfl_xor(ss, 2); ss += __shfl_xor(ss, 4); ss += __shfl_xor(ss, 8);
    const float rs = 1.f / sqrtf(ss * (1.f / 128.f) + MK_EPS) * (1.f - MK_LAM_INIT);
    const int e0 = (lane & 15) * 8;
    u32x4v w; w.x = pk2bf(y[0] * rs * p.subln[e0], y[1] * rs * p.subln[e0 + 1]); w.y = pk2bf(y[2] * rs * p.subln[e0 + 2], y[3] * rs * p.subln[e0 + 3]);
    w.z = pk2bf(y[4] * rs * p.subln[e0 + 4], y[5] * rs * p.subln[e0 + 5]); w.w = pk2bf(y[6] * rs * p.subln[e0 + 6], y[7] * rs * p.subln[e0 + 7]);
    *(u32x4v*)(p.mixin + (size_t)(MK_MP + n) * 1024 + h * 128 + e0) = w;
}
DEV float compute_lam(const float* q1, const float* k1, const float* q2, const float* k2, int lane) {
    const float a = wsum64(q1[lane] * k1[lane]), b = wsum64(q2[lane] * k2[lane]);
    return __expf(a) - __expf(b) + MK_LAM_INIT;
}

#define GAS __attribute__((address_space(1)))
#define LAS __attribute__((address_space(3)))
typedef unsigned short bf16;
typedef unsigned v4u __attribute__((ext_vector_type(4)));
typedef float f32x4 __attribute__((ext_vector_type(4)));
typedef short bf16x8 __attribute__((ext_vector_type(8)));
typedef GAS unsigned gu32;
typedef GAS unsigned long long gu64;
#define RLX_AGENT __ATOMIC_RELAXED, __HIP_MEMORY_SCOPE_AGENT
#define LDS_WAIT() asm volatile("s_waitcnt lgkmcnt(0)" ::: "memory")
#define VM_WAIT() asm volatile("s_waitcnt vmcnt(0)" ::: "memory")
__device__ __forceinline__ unsigned long long rt() { return __builtin_amdgcn_s_memrealtime(); }
__device__ __forceinline__ unsigned pk2(float lo, float hi) { return f2bf(lo) | (f2bf(hi) << 16); }

#define XB_TMO      128
#define XB_XCNT(j)  (256  + 64 * (j))
#define XB_XSUB(j)  (1280 + 64 * (j))
#define XB_XGEN(j)  (2304 + 64 * (j))
#define XB_TOP      3328
#define XB_TOPGEN   3392
#define XCD_BAR_WORDS 3456
#define XB_SPIN_CAP (1u << 18)

__device__ __forceinline__ unsigned xb_ld(unsigned* p)              { return __hip_atomic_load(p, __ATOMIC_RELAXED, __HIP_MEMORY_SCOPE_AGENT); }
__device__ __forceinline__ unsigned xb_add(unsigned* p, unsigned v) { return __hip_atomic_fetch_add(p, v, __ATOMIC_RELAXED, __HIP_MEMORY_SCOPE_AGENT); }
__device__ __forceinline__ unsigned xb_xcc_id() { return (unsigned)__builtin_amdgcn_s_getreg((3 << 11) | 20) & 0xFu; }
#define XB_SPIN(cond, bar) do { unsigned _sp = 0; while (cond) { __builtin_amdgcn_s_sleep(1); \
    if ((++_sp & 255u) == 0u) { if (xb_ld(&(bar)[XB_TMO])) break; if (_sp > XB_SPIN_CAP) { atomicAdd(&(bar)[XB_TMO], 1u); break; } } } } while (0)

struct XcdBarrier {
    unsigned* bar; unsigned x;
    volatile LAS unsigned* st;
};

__device__ __forceinline__ XcdBarrier xcd_barrier_post(unsigned* bar, volatile LAS unsigned* st) {
    XcdBarrier b; b.bar = bar; b.x = xb_xcc_id(); b.st = st;
    if (threadIdx.x == 0) (void)xb_add(&bar[XB_XCNT(b.x)], 1u);
    return b;
}
__device__ __forceinline__ void xcd_barrier_complete(unsigned* bar, unsigned x, unsigned& nloc, unsigned& nx) {
    const unsigned G = gridDim.x * gridDim.y * gridDim.z;
    unsigned sum, cnt, mine, sp = 0u;
    for (;;) {
        sum = 0u; cnt = 0u; mine = 0u;
#pragma unroll
        for (unsigned j = 0; j < 16; ++j) { const unsigned c = xb_ld(&bar[XB_XCNT(j)]); sum += c; cnt += (c > 0u) ? 1u : 0u; mine = (j == x) ? c : mine; }
        if (sum == G) break;
        __builtin_amdgcn_s_sleep(1);
        if ((++sp & 255u) == 0u) { if (xb_ld(&bar[XB_TMO])) break; if (sp > XB_SPIN_CAP) { atomicAdd(&bar[XB_TMO], 1u); break; } }
    }
    nloc = mine > 0u ? mine : 1u; nx = cnt > 0u ? cnt : 1u;
}

__device__ __forceinline__ void xcd_barrier(const XcdBarrier& b) {
    asm volatile("s_waitcnt vmcnt(0)" ::: "memory");
    __syncthreads();
    if (threadIdx.x == 0) {
        unsigned* bar = b.bar;
        __builtin_amdgcn_s_waitcnt(0);
        unsigned nloc = b.st[0], nx = b.st[1];
        if (nloc == 0u) { xcd_barrier_complete(bar, b.x, nloc, nx); b.st[0] = nloc; b.st[1] = nx; }
        const unsigned old = xb_add(&bar[XB_XSUB(b.x)], 1u);
        const unsigned gen = old / nloc;
        if (old + 1u == (gen + 1u) * nloc) {
            __builtin_amdgcn_fence(__ATOMIC_RELEASE, "agent");
            asm volatile("s_waitcnt vmcnt(0)" ::: "memory");
            const unsigned og = xb_add(&bar[XB_TOP], 1u);
            const unsigned tg = og / nx;
            if (og + 1u == (tg + 1u) * nx) xb_add(&bar[XB_TOPGEN], 1u);
            else XB_SPIN(xb_ld(&bar[XB_TOPGEN]) == tg, bar);
            __builtin_amdgcn_fence(__ATOMIC_ACQUIRE, "agent");
            xb_add(&bar[XB_XGEN(b.x)], 1u);
            asm volatile("s_waitcnt vmcnt(0)" ::: "memory");
        } else {
            XB_SPIN(xb_ld(&bar[XB_XGEN(b.x)]) == gen, bar);
            __builtin_amdgcn_fence(__ATOMIC_ACQUIRE, "agent");
            asm volatile("s_waitcnt vmcnt(0)" ::: "memory");
        }
    }
    __syncthreads();
}

constexpr int NWAVES = 8;
#ifndef MK_N_LAUNCHES
#define MK_N_LAUNCHES 1
#endif
constexpr int N_PHASES = 13;
constexpr size_t MiB = 1u << 20;
constexpr size_t WS_CTL = 0, CTL_ZERO_BYTES = 1 * MiB;
constexpr size_t WS_WGU1 = 1 * MiB, WS_WD1 = 13 * MiB, WS_WIN = 19 * MiB, WS_WOUT = 26 * MiB, WS_WGU2 = 28 * MiB, WS_WD2 = 40 * MiB, WS_W2T = 46 * MiB, WS_A2T = WS_W2T + 65536, WS_G2T = WS_A2T + 65536;
constexpr size_t WS_XN = 47 * MiB;
constexpr size_t WS_H = 80 * MiB;
constexpr size_t WS_F = 170 * MiB;
constexpr size_t WS_HRES = 235 * MiB;
constexpr size_t WS_PROJ = 300 * MiB;
constexpr size_t WS_QB = 512 * MiB, WS_KB = 529 * MiB, WS_VB = 546 * MiB;
constexpr size_t WS_O16 = 563 * MiB;
constexpr size_t WS_MIXIN = 595 * MiB;
constexpr size_t WS_MT = 628 * MiB, WS_NN = 644 * MiB, WS_QQ = 676 * MiB, WS_Y0 = 692 * MiB, WS_SC = 724 * MiB, WS_VG = 740 * MiB, WS_GG = 756 * MiB, WS_BON = 772 * MiB;
constexpr size_t WS_PM = 773 * MiB, WS_PL = WS_PM + 65536, WS_PO = 774 * MiB, WS_END = 776 * MiB;
constexpr int CW_TMO = 0, CW_CODE = 1, CW_BAR = 4096;
constexpr int RING_OFF = 0, RING_BYTES = 147456;
constexpr int LDSCTL_OFF = RING_BYTES, MISC_OFF = LDSCTL_OFF + 320;
constexpr int LDS_BYTES = 151552;

struct Args { const float* in[37]; float* out; unsigned char* ws; int ph_lo, ph_hi, li, pad; };

__device__ __forceinline__ void p0_transpose_item(const float* W, int K, int N, bf16* WT, int k0, int n0, int dst_row0, LAS float* scr, int lane) {
#pragma unroll 8
    for (int i = 0; i < 32; ++i) { const int kk = 2 * i + (lane >> 5); scr[kk * 33 + (lane & 31)] = W[(size_t)(k0 + kk) * N + n0 + (lane & 31)]; }
    LDS_WAIT(); asm volatile("" ::: "memory");
    const int c = lane & 7;
#pragma unroll
    for (int j = 0; j < 4; ++j) { const int n = (lane >> 3) + 8 * j; const LAS float* s = scr + (8 * c) * 33 + n;
        v4u o; o.x = pk2(s[0 * 33], s[1 * 33]); o.y = pk2(s[2 * 33], s[3 * 33]); o.z = pk2(s[4 * 33], s[5 * 33]); o.w = pk2(s[6 * 33], s[7 * 33]);
        *(GAS v4u*)(WT + (size_t)(dst_row0 + n) * K + k0 + 8 * c) = o; }
    LDS_WAIT(); asm volatile("" ::: "memory");
}

__global__ void __launch_bounds__(NWAVES * 64, 2) mk_fwd(Args args) {
    extern __shared__ __attribute__((aligned(16))) unsigned char lds[];
    LAS unsigned char* ldsl = (LAS unsigned char*)lds;
    volatile LAS unsigned* MISC = (volatile LAS unsigned*)(ldsl + MISC_OFF);
    constexpr int G = 256, NGW = G * NWAVES;
#define PH_LOCALS int tid = threadIdx.x; asm volatile("" : "+v"(tid)); const int lane = tid & 63; const int wave = __builtin_amdgcn_readfirstlane(tid >> 6); \
    int bx = blockIdx.x; asm volatile("" : "+s"(bx)); const int vcu = (bx & 7) * 32 + (bx >> 3); const int gw = vcu * NWAVES + wave; (void)lane; (void)gw; (void)vcu;
    gu32* ctl = (gu32*)(args.ws + WS_CTL);
    for (int u = threadIdx.x; u < (LDS_BYTES - LDSCTL_OFF) / 4; u += NWAVES * 64) ((LAS unsigned*)(ldsl + LDSCTL_OFF))[u] = 0u;
    __syncthreads();
    XcdBarrier bar = xcd_barrier_post((unsigned*)(ctl + CW_BAR) + args.li * XCD_BAR_WORDS, MISC + 8);
#if MK_N_LAUNCHES == 1
    constexpr int lo = 0, hi = N_PHASES;
#else
    const int lo = args.ph_lo, hi = args.ph_hi;
#endif
#ifndef PH_MASK
#define PH_MASK 0x1fff
#endif
#define IN(k) (((PH_MASK >> (k)) & 1) && lo <= (k) && (k) < hi)
#define SEAM(k) do { if (IN(k) && IN((k) + 1)) xcd_barrier(bar); } while (0)
#define INP(i) (args.in[i])
#define WSB(off) ((bf16*)(args.ws + (off)))
#define WSF(off) ((float*)(args.ws + (off)))
#define x_p INP(0)
#define x_s INP(1)
#define subln INP(20)
#define XN WSB(WS_XN)
#define HB WSB(WS_H)
#define Fb WSF(WS_F)
#define HRES WSF(WS_HRES)
#define PROJ WSF(WS_PROJ)
#define QB WSB(WS_QB)
#define KB WSB(WS_KB)
#define VB WSB(WS_VB)
#define O16 WSB(WS_O16)
#define MIXIN WSB(WS_MIXIN)
#define o_yp (args.out)
#define o_ys (args.out + 16777216)
#define o_kp (args.out + 16908288)
#define o_vp (args.out + 25296896)
#define o_wkvp (args.out + 33685504)
#define o_shp (args.out + 33816576)
#define o_ks (args.out + 33823744)
#define o_vs (args.out + 33889280)
#define o_wkvs (args.out + 33954816)
#define o_shs (args.out + 38149120)
#define MAKE_RP() RwkvP rp; rp.proj = PROJ; rp.mu = INP(21); rp.w0 = INP(22); rp.w2 = INP(23); rp.a0 = INP(24); rp.a2 = INP(25); rp.g2 = INP(26); rp.k_k = INP(27); rp.k_a = INP(28); rp.r_k = INP(29); \
    rp.ln_w = INP(30); rp.ln_b = INP(31); rp.w2t = WSB(WS_W2T); rp.a2t = WSB(WS_A2T); rp.g2t = WSB(WS_G2T); rp.state_wkv = INP(4); rp.state_shift = INP(5); \
    rp.MT = WSB(WS_MT); rp.NN = WSF(WS_NN); rp.QQ = WSB(WS_QQ); rp.Y0 = WSF(WS_Y0); rp.SC = WSB(WS_SC); rp.VG = WSB(WS_VG); rp.GG = WSB(WS_GG); \
    rp.BON = WSF(WS_BON); rp.mixin = MIXIN; rp.wkv_p = o_wkvp; rp.wkv_s = o_wkvs;
#define MAKE_DP() DecP dp{INP(2), INP(3), (const int*)INP(6), QB, WSF(WS_PM), WSF(WS_PL), WSF(WS_PO), o_ks, o_vs, subln, MIXIN};
    if (IN(0)) { PH_LOCALS
        LAS float* scr = (LAS float*)(ldsl + RING_OFF + wave * 16384);
        constexpr int I_G = 16 * 88, I_D = 44 * 32, I_IN = 16 * 104, I_OUT = 16 * 32, I_S = 16, I_G2 = 32;
        constexpr int NITEMS = 6 * I_G + I_IN + I_OUT + 2 * I_S + I_G2;
        static_assert(I_G == I_D, "item counts");
        for (int it = gw; it < NITEMS; it += NGW) {
            int r = it;
            if (r < 4 * I_G) {
                const int which = r / I_G; r -= which * I_G; const int nblk = 88, kb = r / nblk, nb = r % nblk, n0 = 32 * nb;
                const float* W = which == 0 ? INP(9) : (which == 1 ? INP(10) : (which == 2 ? INP(34) : INP(35))); bf16* WT = which < 2 ? WSB(WS_WGU1) : WSB(WS_WGU2);
                p0_transpose_item(W, 1024, 2816, WT, 64 * kb, n0, (n0 >> 7) * 256 + (which & 1) * 128 + (n0 & 127), scr, lane); continue; }
            r -= 4 * I_G;
            if (r < 2 * I_D) { const int which = r / I_D; r -= which * I_D; const int nblk = 32, kb = r / nblk, nb = r % nblk;
                p0_transpose_item(which == 0 ? INP(11) : INP(36), 2816, 1024, which == 0 ? WSB(WS_WD1) : WSB(WS_WD2), 64 * kb, 32 * nb, 32 * nb, scr, lane); continue; }
            r -= 2 * I_D;
            if (r < I_IN) { const int nblk = 104, kb = r / nblk, nb = r % nblk; p0_transpose_item(INP(14), 1024, 3328, WSB(WS_WIN), 64 * kb, 32 * nb, 32 * nb, scr, lane); continue; }
            r -= I_IN;
            if (r < I_OUT) { const int nblk = 32, kb = r / nblk, nb = r % nblk; p0_transpose_item(INP(15), 1024, 1024, WSB(WS_WOUT), 64 * kb, 32 * nb, 32 * nb, scr, lane); continue; }
            r -= I_OUT;
            if (r < I_S) { p0_transpose_item(INP(23), 64, 512, WSB(WS_W2T), 0, 32 * r, 32 * r, scr, lane); continue; }
            r -= I_S;
            if (r < I_S) { p0_transpose_item(INP(25), 64, 512, WSB(WS_A2T), 0, 32 * r, 32 * r, scr, lane); continue; }
            r -= I_S;
            { const int kb = r / 16, nb = r % 16; p0_transpose_item(INP(26), 128, 512, WSB(WS_G2T), 64 * kb, 32 * nb, 32 * nb, scr, lane); }
        }
        for (int r = gw; r < MK_MPAD; r += NGW) rowpass_A(x_p, x_s, INP(7), XN, r, lane);
    }
    SEAM(0);
    if (IN(1)) { PH_LOCALS pg8::Gemm g{XN, WSB(WS_WGU1), MK_MPAD, 5632, 1024}; pg8::StaticOrder S; S.init(MK_MPAD, 5632, G, bx); pg8::EpiSwiGLU E{HB, MK_FF};
        pg8::gemm_phase<pg8::EpiSwiGLU, pg8::StaticOrder, true, true>(ldsl + RING_OFF, g, S, E); }
    SEAM(1);
    if (IN(2)) { PH_LOCALS pg8::Gemm g{HB, WSB(WS_WD1), MK_MPAD, 1024, MK_FF}; pg8::StaticOrder S; S.init(MK_MPAD, 1024, G, bx); pg8::EpiF32 E{Fb, 1024, nullptr};
        pg8::gemm_phase<pg8::EpiF32, pg8::StaticOrder, true, true>(ldsl + RING_OFF, g, S, E); }
    SEAM(2);
    if (IN(3)) { PH_LOCALS for (int r = gw; r < MK_MR; r += NGW) rowpass_B(x_row(x_p, x_s, r), Fb, INP(8), 0.5f, HRES, INP(12), XN, r, lane); }
    SEAM(3);
    if (IN(4)) { PH_LOCALS pg8::Gemm g{XN, WSB(WS_WIN), MK_MPAD, MK_NPROJ, 1024}; pg8::StaticOrder S; S.init(MK_MPAD, MK_NPROJ, G, bx); pg8::EpiF32 E{PROJ, MK_NPROJ, nullptr};
        pg8::gemm_phase<pg8::EpiF32, pg8::StaticOrder, true, true>(ldsl + RING_OFF, g, S, E); }
    SEAM(4);
    if (IN(5)) { PH_LOCALS
        PostP pp{PROJ, QB, KB, VB, o_kp, o_vp, o_ks, o_vs, o_shp, o_shs}; MAKE_RP()
#ifndef T_NOPOST
        for (int r = gw; r < MK_MR; r += NGW) post_win_row(pp, r, lane);
#endif
#ifndef T_NOPASSA
        for (int i = 0; i < 8; ++i) { const int u = vcu * 8 + i; if (u < 2048) rwkv_passA(rp, u >> 9, (u >> 6) & 7, u & 63, ldsl); }
#endif
        __syncthreads();
#ifndef T_NOSAMPLE
        if (wave < 4) { const int su = bx * 4 + wave; if (su < 1024) rwkv_sample(rp, su >> 3, su & 7, ldsl + wave * 4096, lane); }
#endif
    }
    SEAM(5);
    if (IN(6)) { PH_LOCALS
        MAKE_RP()
        if (vcu < 16) { const int id = vcu * 8 + wave; rwkv_passB(rp, (id >> 2) >> 3, (id >> 2) & 7, id & 3, ldsl + wave * 4096, lane); }
        __syncthreads();
        MAKE_DP()
        if (bx < 256) decode_unit(dp, bx >> 1, bx & 1, ldsl);
        __syncthreads();
        const attn_body::AttnTensors AT{(const attn_body::bf16*)QB, (const attn_body::bf16*)KB, (const attn_body::bf16*)VB, (attn_body::bf16*)O16};
        const attn_body::StaticOrder S((int)G, (int)bx);
        attn_body::attn_phase<attn_body::StaticOrder>((char*)lds + RING_OFF, AT, S);
    }
    SEAM(6);
    if (IN(7)) { PH_LOCALS
        MAKE_RP()
        const float lam = compute_lam(INP(16), INP(17), INP(18), INP(19), lane);
        { const int u = vcu * 8 + wave; if (u < 2048) rwkv_passC(rp, u >> 9, (u >> 6) & 7, u & 63, lane); }
        for (int r = gw; r < MK_MP; r += NGW) attn_combine_row(O16, subln, lam, MIXIN, r, lane);
        MAKE_DP()
        if (gw < 128) decode_final(dp, gw, lam, lane);
        else if (gw < 256) { bf16* z = MIXIN + (size_t)(MK_MR + gw - 128) * 1024 + lane * 16; *(v4u*)z = (v4u){0u, 0u, 0u, 0u}; *(v4u*)(z + 8) = (v4u){0u, 0u, 0u, 0u}; }
    }
    SEAM(7);
    if (IN(8)) { PH_LOCALS pg8::Gemm g{MIXIN, WSB(WS_WOUT), MK_MPAD, 1024, 1024}; pg8::StaticOrder S; S.init(MK_MPAD, 1024, G, bx); pg8::EpiF32 E{Fb, 1024, nullptr};
        pg8::gemm_phase<pg8::EpiF32, pg8::StaticOrder, true, true>(ldsl + RING_OFF, g, S, E); }
    SEAM(8);
    if (IN(9)) { PH_LOCALS for (int r = gw; r < MK_MR; r += NGW) rowpass_B(HRES + (size_t)r * MK_D, Fb, INP(13), 1.0f, HRES, INP(32), XN, r, lane); }
    SEAM(9);
    if (IN(10)) { PH_LOCALS pg8::Gemm g{XN, WSB(WS_WGU2), MK_MPAD, 5632, 1024}; pg8::StaticOrder S; S.init(MK_MPAD, 5632, G, bx); pg8::EpiSwiGLU E{HB, MK_FF};
        pg8::gemm_phase<pg8::EpiSwiGLU, pg8::StaticOrder, true, true>(ldsl + RING_OFF, g, S, E); }
    SEAM(10);
    if (IN(11)) { PH_LOCALS pg8::Gemm g{HB, WSB(WS_WD2), MK_MPAD, 1024, MK_FF}; pg8::StaticOrder S; S.init(MK_MPAD, 1024, G, bx); pg8::EpiF32 E{Fb, 1024, nullptr};
        pg8::gemm_phase<pg8::EpiF32, pg8::StaticOrder, true, true>(ldsl + RING_OFF, g, S, E); }
    SEAM(11);
    if (IN(12)) { PH_LOCALS for (int r = gw; r < MK_MR; r += NGW) rowpass_D(HRES, Fb, INP(33), r < MK_MP ? o_yp + (size_t)r * MK_D : o_ys + (size_t)(r - MK_MP) * MK_D, r, lane); }
#undef IN
#undef SEAM
}

extern "C" void kernel_launch(void* const* d_in, const int* in_sizes, int n_in, void* d_out, int out_size, void* d_ws, size_t ws_size, hipStream_t stream) {
    static int grid = 0;
    if (grid == 0) {
        if (n_in != 37 || ws_size < WS_END) { fprintf(stderr, "kernel_launch: unexpected inputs (n_in %d, ws %zu)\n", n_in, ws_size); grid = -1; return; }
        int dev = 0, cus = 0, per_cu = 0;
        if (hipGetDevice(&dev) != hipSuccess || hipDeviceGetAttribute(&cus, hipDeviceAttributeMultiprocessorCount, dev) != hipSuccess) { grid = -1; return; }
        if (hipFuncSetAttribute((const void*)mk_fwd, hipFuncAttributeMaxDynamicSharedMemorySize, LDS_BYTES) != hipSuccess) { fprintf(stderr, "kernel_launch: hipFuncSetAttribute failed\n"); grid = -1; return; }
        if (hipOccupancyMaxActiveBlocksPerMultiprocessor(&per_cu, (const void*)mk_fwd, NWAVES * 64, LDS_BYTES) != hipSuccess || per_cu < 1) fprintf(stderr, "kernel_launch: occupancy query says %d\n", per_cu);
        (void)hipGetLastError();
        if (cus < 256) { fprintf(stderr, "kernel_launch: needs a 256-CU device (got %d)\n", cus); grid = -1; return; }
        grid = 256;
    }
    if (grid < 0) return;
    if (hipMemsetAsync((char*)d_ws + WS_CTL, 0, CTL_ZERO_BYTES, stream) != hipSuccess) return;
    Args a{};
    for (int i = 0; i < 37; ++i) a.in[i] = (const float*)d_in[i];
    a.out = (float*)d_out; a.ws = (unsigned char*)d_ws;
    constexpr int NL = MK_N_LAUNCHES;
    for (int li = 0; li < NL; ++li) {
        a.ph_lo = li * N_PHASES / NL; a.ph_hi = (li + 1) * N_PHASES / NL; a.li = li;
        hipLaunchKernelGGL(mk_fwd, dim3(grid), dim3(NWAVES * 64), LDS_BYTES, stream, a);
    }
}
```

```cpp
#include <hip/hip_runtime.h>
#include <cstdio>
#include <cstdint>
namespace pg8 {
#define PG8_LAS __attribute__((address_space(3)))
typedef unsigned short bf16_t;
typedef short bf16x8 __attribute__((ext_vector_type(8)));
typedef float f32x4 __attribute__((ext_vector_type(4)));
typedef unsigned u32x4 __attribute__((ext_vector_type(4)));
constexpr int BM = 256, BK = 64, HALF = 128, HTB = HALF * BK * 2  , STAGE_BYTES = 8 * HTB, NXCD = 8, WGM = 8;

__host__ __device__ __forceinline__ int lds_byte(int r, int c) { const int st = (r >> 4) * 2 + (c >> 5), rr = r & 15, cc = c & 31, ob = rr * 64 + cc * 2; return st * 1024 + (ob ^ (((ob >> 9) & 1) << 5)); }
__host__ __device__ __forceinline__ void stage_rc(int b, int& R, int& C) { const int st = b / 1024, sb = b % 1024, swz = sb ^ (((sb >> 9) & 1) << 5); R = (st >> 1) * 16 + swz / 64; C = (st & 1) * 32 + (swz % 64) / 2; }
__host__ __device__ __forceinline__ int perm32(int rho) { const int n = rho >> 4, i = rho & 15; return 8 * (i >> 2) + 4 * n + (i & 3); }

struct Unit { int pm, pn; };
struct Gemm { const bf16_t* A; const bf16_t* Bt; int M, N, K; };

struct StaticOrder {
    int nM, nN, nwg, G, c;
    __host__ __device__ void init(int M, int N, int G_, int c_) { nM = M / BM; nN = N / BM; nwg = nM * nN; G = G_; c = c_; }
    __host__ __device__ bool next(int i, Unit& u) const {
        const long L = (long)i * G + c; if (L >= nwg) return false;
        int wgid = (int)L; { const int q = nwg / NXCD, r = nwg % NXCD, xcd = wgid % NXCD, off = wgid / NXCD; wgid = (xcd < r ? xcd * (q + 1) : r * (q + 1) + (xcd - r) * q) + off; }
        const int nig = WGM * nN, gid = wgid / nig, fm = gid * WGM, gsz = (nM - fm) < WGM ? (nM - fm) : WGM;
        u.pm = fm + ((wgid % nig) % gsz); u.pn = (wgid % nig) / gsz; return true;
    }
    __device__ __forceinline__ void a_ready(const Unit&) const {}
    __device__ __forceinline__ void done(const Unit&) const {}
};

__device__ __forceinline__ unsigned cvt_pk_bf16(float lo, float hi) { unsigned r; asm volatile("v_cvt_pk_bf16_f32 %0, %1, %2" : "=v"(r) : "v"(lo), "v"(hi)); return r; }
typedef float f32x2 __attribute__((ext_vector_type(2)));
struct EpiF32 {
    static constexpr bool PERM = false, AFTER_DRAIN = false;
    float* C; int ldc; const float* bias;
    __device__ __forceinline__ void operator()(const f32x4 (&acc)[2][2][4][2], const Unit& u, int wr, int wc, int fr, int fq) const {
        const int row0 = u.pm * BM + wr * 64 + fr, col0 = u.pn * BM + wc * 32 + 4 * fq;
#pragma unroll
        for (int ai = 0; ai < 2; ++ai)
#pragma unroll
            for (int m = 0; m < 4; ++m) { float* rowp = C + (size_t)(row0 + ai * HALF + m * 16) * ldc + col0;
#pragma unroll
                for (int bj = 0; bj < 2; ++bj)
#pragma unroll
                    for (int n = 0; n < 2; ++n) *(f32x4*)(rowp + bj * HALF + n * 16) = acc[ai][bj][m][n]; }
    }
};
struct EpiBf16P {
    static constexpr bool PERM = true, AFTER_DRAIN = false;
    bf16_t* O; int ldc;
    __device__ __forceinline__ void operator()(const f32x4 (&acc)[2][2][4][2], const Unit& u, int wr, int wc, int fr, int fq) const {
        const int row0 = u.pm * BM + wr * 64 + fr, col0 = u.pn * BM + wc * 32 + 8 * fq;
#pragma unroll
        for (int ai = 0; ai < 2; ++ai)
#pragma unroll
            for (int m = 0; m < 4; ++m) { bf16_t* rowp = O + (size_t)(row0 + ai * HALF + m * 16) * ldc + col0;
#pragma unroll
                for (int bj = 0; bj < 2; ++bj) { const f32x4 v0 = acc[ai][bj][m][0], v1 = acc[ai][bj][m][1];
                    u32x4 w; w.x = cvt_pk_bf16(v0[0], v0[1]); w.y = cvt_pk_bf16(v0[2], v0[3]); w.z = cvt_pk_bf16(v1[0], v1[1]); w.w = cvt_pk_bf16(v1[2], v1[3]);
                    *(u32x4*)(rowp + bj * HALF) = w; } }
    }
};
struct EpiSwiGLU {
    static constexpr bool PERM = true, AFTER_DRAIN = false;
    bf16_t* O; int ldc;
    __device__ __forceinline__ void operator()(const f32x4 (&acc)[2][2][4][2], const Unit& u, int wr, int wc, int fr, int fq) const {
        const int row0 = u.pm * BM + wr * 64 + fr, col0 = u.pn * HALF + wc * 32 + 8 * fq;
#pragma unroll
        for (int ai = 0; ai < 2; ++ai)
#pragma unroll
            for (int m = 0; m < 4; ++m) { bf16_t* rowp = O + (size_t)(row0 + ai * HALF + m * 16) * ldc + col0;
                float h[8];
#pragma unroll
                for (int n = 0; n < 2; ++n)
#pragma unroll
                    for (int j = 0; j < 4; ++j) { const float g = acc[ai][0][m][n][j], up = acc[ai][1][m][n][j];
                        h[4 * n + j] = g * __builtin_amdgcn_rcpf(1.0f + __builtin_amdgcn_exp2f(-1.4426950408889634f * g)) * up; }
                u32x4 w; w.x = cvt_pk_bf16(h[0], h[1]); w.y = cvt_pk_bf16(h[2], h[3]); w.z = cvt_pk_bf16(h[4], h[5]); w.w = cvt_pk_bf16(h[6], h[7]);
                *(u32x4*)rowp = w; }
    }
};
struct PanelRms {
    unsigned* xbuf;
    unsigned* cnt;
    unsigned* tmo;
    int ntn; float eps; unsigned code;
    __device__ __forceinline__ bool run(const f32x4 (&v)[2][2][4][2], const Unit& u, int wr, int wc, int fr, int fq, PG8_LAS unsigned char* lds, int wid, int lane) const {
        PG8_LAS float* P = (PG8_LAS float*)lds;
        PG8_LAS float* S = (PG8_LAS float*)(lds + 8192);
        PG8_LAS unsigned* flag = (PG8_LAS unsigned*)(lds + 8192 + 2048);
#pragma unroll
        for (int ai = 0; ai < 2; ++ai)
#pragma unroll
            for (int m = 0; m < 4; ++m) {
                float s = 0.f;
#pragma unroll
                for (int bj = 0; bj < 2; ++bj)
#pragma unroll
                    for (int n = 0; n < 2; ++n) { const f32x4 x = v[ai][bj][m][n]; s += (x[0] * x[0] + x[1] * x[1]) + (x[2] * x[2] + x[3] * x[3]); }
                s += __shfl_xor(s, 16); s += __shfl_xor(s, 32);
                if (fq == 0) P[(ai * HALF + wr * 64 + m * 16 + fr) * 4 + wc] = s;
            }
        asm volatile("s_waitcnt lgkmcnt(0)" ::: "memory"); __builtin_amdgcn_s_barrier(); asm volatile("" ::: "memory");
        const int row = wid * 32 + (lane & 31);
        if (lane < 32) {
            const float t = (P[row * 4 + 0] + P[row * 4 + 1]) + (P[row * 4 + 2] + P[row * 4 + 3]);
            unsigned long long* slot = (unsigned long long*)xbuf + ((size_t)(u.pm * BM + row) * 4 + u.pn);
            __hip_atomic_store(slot, (unsigned long long)__float_as_uint(t), __ATOMIC_RELAXED, __HIP_MEMORY_SCOPE_AGENT);
        }
        asm volatile("s_waitcnt vmcnt(0)" ::: "memory");
        if (lane == 0) __hip_atomic_fetch_add(cnt + 64 * u.pm, 1u, __ATOMIC_RELAXED, __HIP_MEMORY_SCOPE_AGENT);
        if (wid == 0) {
            bool dead = false; const unsigned long long t0 = __builtin_amdgcn_s_memrealtime(); const unsigned want = 8u * (unsigned)ntn;
            for (;;) {
                if ((unsigned)__builtin_amdgcn_readfirstlane(__hip_atomic_load(cnt + 64 * u.pm, __ATOMIC_RELAXED, __HIP_MEMORY_SCOPE_AGENT)) >= want) break;
                if (__builtin_amdgcn_s_memrealtime() - t0 > 2000000ull) {
                    if (lane == 0) { unsigned expect = 0u; __hip_atomic_compare_exchange_strong(tmo + 1, &expect, code | (unsigned)(u.pm & 0xff), __ATOMIC_RELAXED, __ATOMIC_RELAXED, __HIP_MEMORY_SCOPE_AGENT);
                                     __hip_atomic_store(tmo, 1u, __ATOMIC_RELAXED, __HIP_MEMORY_SCOPE_AGENT); }
                    dead = true; break; }
                __builtin_amdgcn_s_sleep(2);
            }
            __builtin_amdgcn_fence(__ATOMIC_ACQUIRE, "agent");
            if (lane == 0) flag[0] = dead ? 1u : 0u;
        }
        asm volatile("s_waitcnt vmcnt(0) lgkmcnt(0)" ::: "memory"); __builtin_amdgcn_s_barrier(); asm volatile("" ::: "memory");
        const bool bad = flag[0] != 0u;
        if (lane < 32) {
            const unsigned long long* slot = (const unsigned long long*)xbuf + (size_t)(u.pm * BM + row) * 4; float q = 0.f;
#pragma unroll
            for (int t = 0; t < 4; ++t) if (t < ntn) q += __uint_as_float((unsigned)__hip_atomic_load(slot + t, __ATOMIC_RELAXED, __HIP_MEMORY_SCOPE_AGENT));
            S[row] = 1.0f / sqrtf(q / (256.0f * (float)ntn) + eps);
        }
        asm volatile("s_waitcnt lgkmcnt(0)" ::: "memory"); __builtin_amdgcn_s_barrier(); asm volatile("" ::: "memory");
        return bad;
    }
};
struct EpiRmsRes {
    static constexpr bool PERM = false, AFTER_DRAIN = true;
    const float* base; float* out; int ldc; const float* g1; float scale; PanelRms st;
    __device__ __forceinline__ void fused(f32x4 (&acc)[2][2][4][2], const Unit& u, int wr, int wc, int fr, int fq, PG8_LAS unsigned char* lds, int wid, int lane) const {
        const PG8_LAS float* S = (const PG8_LAS float*)(lds + 8192);
        const int col0 = u.pn * BM + wc * 32 + 4 * fq;
        const bool bad = st.run(acc, u, wr, wc, fr, fq, lds, wid, lane);
        const float qnan = __builtin_nanf("");
        f32x4 gv[2][2];
#pragma unroll
        for (int bj = 0; bj < 2; ++bj)
#pragma unroll
            for (int n = 0; n < 2; ++n) gv[bj][n] = *(const f32x4*)(g1 + col0 + bj * HALF + n * 16) * scale;
#pragma unroll
        for (int ai = 0; ai < 2; ++ai)
#pragma unroll
            for (int m = 0; m < 4; ++m) { const int r = ai * HALF + wr * 64 + m * 16 + fr; const float rs = S[r]; const size_t off = (size_t)(u.pm * BM + r) * ldc + col0;
#pragma unroll
                for (int bj = 0; bj < 2; ++bj)
#pragma unroll
                    for (int n = 0; n < 2; ++n) { const f32x4 bs = *(const f32x4*)(base + off + bj * HALF + n * 16); f32x4 o = bs + acc[ai][bj][m][n] * rs * gv[bj][n];
                        if (bad) o = (f32x4){qnan, qnan, qnan, qnan}; *(f32x4*)(out + off + bj * HALF + n * 16) = o; }
                if (m & 1) asm volatile("" ::: "memory"); }
    }
};
struct EpiRmsResRms {
    static constexpr bool PERM = false, AFTER_DRAIN = true;
    const float* base; float* out; bf16_t* xn; int ldc; const float* g1; float scale; const float* g2; PanelRms st1, st2;
    __device__ __forceinline__ void fused(f32x4 (&acc)[2][2][4][2], const Unit& u, int wr, int wc, int fr, int fq, PG8_LAS unsigned char* lds, int wid, int lane) const {
        typedef unsigned u32x2v __attribute__((ext_vector_type(2)));
        const PG8_LAS float* S = (const PG8_LAS float*)(lds + 8192);
        const int col0 = u.pn * BM + wc * 32 + 4 * fq;
        bool bad = st1.run(acc, u, wr, wc, fr, fq, lds, wid, lane);
        const float qnan = __builtin_nanf("");
        {
            f32x4 gv[2][2];
#pragma unroll
            for (int bj = 0; bj < 2; ++bj)
#pragma unroll
                for (int n = 0; n < 2; ++n) gv[bj][n] = *(const f32x4*)(g1 + col0 + bj * HALF + n * 16) * scale;
#pragma unroll
            for (int ai = 0; ai < 2; ++ai)
#pragma unroll
                for (int m = 0; m < 4; ++m) { const int r = ai * HALF + wr * 64 + m * 16 + fr; const float rs = S[r]; const size_t off = (size_t)(u.pm * BM + r) * ldc + col0;
#pragma unroll
                    for (int bj = 0; bj < 2; ++bj)
#pragma unroll
                        for (int n = 0; n < 2; ++n) { const f32x4 bs = *(const f32x4*)(base + off + bj * HALF + n * 16); acc[ai][bj][m][n] = bs + acc[ai][bj][m][n] * rs * gv[bj][n]; }
                    asm volatile("" : "+v"(acc[ai][0][m][0]), "+v"(acc[ai][0][m][1]), "+v"(acc[ai][1][m][0]), "+v"(acc[ai][1][m][1]));
                    if (m & 1) asm volatile("" ::: "memory"); }
        }
        const bool bad1 = bad;
        bad = st2.run(acc, u, wr, wc, fr, fq, lds, wid, lane) || bad;
        f32x4 gv2[2][2];
#pragma unroll
        for (int bj = 0; bj < 2; ++bj)
#pragma unroll
            for (int n = 0; n < 2; ++n) gv2[bj][n] = *(const f32x4*)(g2 + col0 + bj * HALF + n * 16);
#pragma unroll
        for (int ai = 0; ai < 2; ++ai)
#pragma unroll
            for (int m = 0; m < 4; ++m) { const int r = ai * HALF + wr * 64 + m * 16 + fr; const float rs = S[r]; const size_t off = (size_t)(u.pm * BM + r) * ldc + col0;
#pragma unroll
                for (int bj = 0; bj < 2; ++bj)
#pragma unroll
                    for (int n = 0; n < 2; ++n) { const f32x4 x1 = acc[ai][bj][m][n]; *(f32x4*)(out + off + bj * HALF + n * 16) = bad1 ? (f32x4){qnan, qnan, qnan, qnan} : x1;
                        const f32x4 o = x1 * rs * gv2[bj][n]; u32x2v w; w.x = cvt_pk_bf16(o[0], o[1]); w.y = cvt_pk_bf16(o[2], o[3]);
                        if (bad) { w.x = 0x7fc07fc0u; w.y = 0x7fc07fc0u; } *(u32x2v*)(xn + off + bj * HALF + n * 16) = w; }
                asm volatile("" ::: "memory"); }
    }
};
template <class Epi, class Sched, bool ALIGN_EPI = false, bool SP2 = false>
__device__ __forceinline__ void gemm_phase(PG8_LAS unsigned char* lds, const Gemm g, const Sched& S, const Epi& E) {
    int tid = threadIdx.x; asm volatile("" : "+v"(tid));
    const int wid = __builtin_amdgcn_readfirstlane(tid >> 6), lane = tid & 63, wr = wid >> 2, wc = wid & 3, fr = lane & 15, fq = lane >> 4;
    const int K = g.K, nt = K / BK;
    unsigned voffA[2], voffB[2];
#pragma unroll
    for (int i = 0; i < 2; ++i) { int R, C; stage_rc(tid * 16 + i * 8192, R, C); const int Rb = Epi::PERM ? ((R & ~31) + perm32(R & 31)) : R;
        voffA[i] = (unsigned)(R * K + C) * 2u; voffB[i] = (unsigned)(Rb * K + C) * 2u; }
    const size_t kstep = (size_t)(BK * 2);
    const size_t hstep = (size_t)HALF * K * 2;
    const size_t tstep = 2 * hstep;
    const unsigned ldsw = (unsigned)wid * 1024u;
    const int aoff = lds_byte(wr * 64 + fr, fq * 8), boff = lds_byte(wc * 32 + fr, fq * 8);
#define PG8_SA(b, h) (((b) * 2 + (h)) * HTB)
#define PG8_SB(b, h) ((4 + (b) * 2 + (h)) * HTB)
#define PG8_STAGE(bufoff, gbase, voff) do { _Pragma("unroll") for (int _i = 0; _i < 2; ++_i) \
        __builtin_amdgcn_global_load_lds((const unsigned*)((const char*)(gbase) + (voff)[_i]), (PG8_LAS unsigned*)(lds + (bufoff) + ldsw + _i * 8192), 16, 0, 0); } while (0)
#define PG8_LDA(dst, b, h) do { _Pragma("unroll") for (int m = 0; m < 4; ++m) _Pragma("unroll") for (int k = 0; k < 2; ++k) dst[m][k] = *(const PG8_LAS bf16x8*)(lds + PG8_SA(b, h) + aoff + m * 2048 + k * 1024); } while (0)
#define PG8_LDB(dst, b, h) do { _Pragma("unroll") for (int n = 0; n < 2; ++n) _Pragma("unroll") for (int k = 0; k < 2; ++k) dst[n][k] = *(const PG8_LAS bf16x8*)(lds + PG8_SB(b, h) + boff + n * 2048 + k * 1024); } while (0)
#define PG8_MMA(ai, bj, At, Bt) do { __builtin_amdgcn_s_setprio(1); _Pragma("unroll") for (int m = 0; m < 4; ++m) _Pragma("unroll") for (int n = 0; n < 2; ++n) _Pragma("unroll") for (int k = 0; k < 2; ++k) \
        acc[ai][bj][m][n] = __builtin_amdgcn_mfma_f32_16x16x32_bf16(Bt[n][k], At[m][k], acc[ai][bj][m][n], 0, 0, 0); __builtin_amdgcn_s_setprio(0); } while (0)
#define PG8_WAIT_V(n) asm volatile("s_waitcnt vmcnt(" #n ")" ::: "memory")
#define PG8_WAIT_L(n) asm volatile("s_waitcnt lgkmcnt(" #n ")" ::: "memory")
#define PG8_BAR __builtin_amdgcn_s_barrier()
#define PG8_SCHED __builtin_amdgcn_sched_barrier(0)
    Unit cur, nxt; int ui = 0;
    if (!S.next(0, cur)) return;
    f32x4 acc[2][2][4][2];
#pragma unroll
    for (int a = 0; a < 2; ++a)
#pragma unroll
        for (int b = 0; b < 2; ++b)
#pragma unroll
            for (int m = 0; m < 4; ++m)
#pragma unroll
                for (int n = 0; n < 2; ++n) acc[a][b][m][n] = (f32x4){0.f, 0.f, 0.f, 0.f};
    bf16x8 At[4][2], B0[2][2], B1[2][2];
    const char* cA = (const char*)g.A + (size_t)cur.pm * tstep; const char* cB = (const char*)g.Bt + (size_t)cur.pn * tstep;
    S.a_ready(cur);
    if constexpr (SP2) {
        PG8_STAGE(PG8_SB(0, 0), cB, voffB); PG8_STAGE(PG8_SB(0, 1), cB + hstep, voffB); PG8_STAGE(PG8_SA(0, 0), cA, voffA); PG8_STAGE(PG8_SA(0, 1), cA + hstep, voffA);
        if (wr == 1) PG8_BAR;
        PG8_WAIT_V(2); PG8_BAR;
        PG8_STAGE(PG8_SB(1, 0), cB + kstep, voffB); PG8_STAGE(PG8_SA(1, 0), cA + kstep, voffA); PG8_STAGE(PG8_SB(1, 1), cB + hstep + kstep, voffB);
        PG8_WAIT_V(6); PG8_BAR;
    } else {
        PG8_STAGE(PG8_SB(0, 0), cB, voffB); PG8_STAGE(PG8_SA(0, 0), cA, voffA); PG8_STAGE(PG8_SB(0, 1), cB + hstep, voffB); PG8_STAGE(PG8_SA(0, 1), cA + hstep, voffA);
        if (wr == 1) PG8_BAR;
        PG8_WAIT_V(4); PG8_BAR;
        PG8_STAGE(PG8_SB(1, 0), cB + kstep, voffB); PG8_STAGE(PG8_SA(1, 0), cA + kstep, voffA); PG8_STAGE(PG8_SB(1, 1), cB + hstep + kstep, voffB);
        PG8_WAIT_V(6); PG8_BAR;
    }
    for (;;) {
        const bool has_next = S.next(ui + 1, nxt);
        const char* nA = has_next ? (const char*)g.A + (size_t)nxt.pm * tstep : cA; const char* nB = has_next ? (const char*)g.Bt + (size_t)nxt.pn * tstep : cB;
        for (int t = 0; t < nt; t += 2) {
            const bool last = (t == nt - 2);
            const char* a1 = cA + (size_t)(t + 1) * kstep;
            const char* a2 = last ? nA : cA + (size_t)(t + 2) * kstep; const char* b2 = last ? nB : cB + (size_t)(t + 2) * kstep;
            const char* a3 = a2 + kstep; const char* b3 = b2 + kstep;
            if (last && has_next) S.a_ready(nxt);
            if constexpr (SP2) {
            PG8_LDB(B0, 0, 0); PG8_LDB(B1, 0, 1); PG8_SCHED; PG8_LDA(At, 0, 0); PG8_STAGE(PG8_SA(1, 1), a1 + hstep, voffA);
            PG8_WAIT_V(8); PG8_WAIT_L(0); PG8_BAR; PG8_MMA(0, 0, At, B0); PG8_MMA(0, 1, At, B1); PG8_BAR; PG8_SCHED;
            PG8_LDA(At, 0, 1); PG8_STAGE(PG8_SB(0, 0), b2, voffB); PG8_STAGE(PG8_SB(0, 1), b2 + hstep, voffB); PG8_STAGE(PG8_SA(0, 0), a2, voffA);
            PG8_WAIT_V(8); PG8_WAIT_L(0); PG8_BAR; PG8_MMA(1, 0, At, B0); PG8_MMA(1, 1, At, B1); PG8_BAR; PG8_SCHED;
            PG8_LDB(B0, 1, 0); PG8_LDB(B1, 1, 1); PG8_SCHED; PG8_LDA(At, 1, 0); PG8_STAGE(PG8_SA(0, 1), a2 + hstep, voffA);
            PG8_WAIT_V(8); PG8_WAIT_L(0); PG8_BAR; PG8_MMA(0, 0, At, B0); PG8_MMA(0, 1, At, B1); PG8_BAR; PG8_SCHED;
            PG8_LDA(At, 1, 1); PG8_STAGE(PG8_SB(1, 0), b3, voffB); PG8_STAGE(PG8_SB(1, 1), b3 + hstep, voffB); PG8_STAGE(PG8_SA(1, 0), a3, voffA);
            PG8_WAIT_V(8); PG8_WAIT_L(0); PG8_BAR; PG8_MMA(1, 0, At, B0); PG8_MMA(1, 1, At, B1); PG8_BAR; PG8_SCHED;
            } else {
            PG8_LDB(B0, 0, 0); PG8_SCHED; PG8_LDA(At, 0, 0); PG8_STAGE(PG8_SA(1, 1), a1 + hstep, voffA);
            PG8_WAIT_L(8); PG8_BAR; PG8_WAIT_L(0); PG8_MMA(0, 0, At, B0); PG8_BAR; PG8_SCHED;
            PG8_LDB(B1, 0, 1); PG8_STAGE(PG8_SB(0, 0), b2, voffB);
            PG8_BAR; PG8_WAIT_L(0); PG8_MMA(0, 1, At, B1); PG8_BAR;
            PG8_LDA(At, 0, 1); PG8_STAGE(PG8_SA(0, 0), a2, voffA);
            PG8_BAR; PG8_WAIT_L(0); PG8_MMA(1, 0, At, B0); PG8_BAR; PG8_SCHED;
            PG8_STAGE(PG8_SB(0, 1), b2 + hstep, voffB);
            PG8_WAIT_V(6); PG8_BAR; PG8_MMA(1, 1, At, B1); PG8_BAR;
            PG8_LDB(B0, 1, 0); PG8_SCHED; PG8_LDA(At, 1, 0); PG8_STAGE(PG8_SA(0, 1), a2 + hstep, voffA);
            PG8_WAIT_L(8); PG8_BAR; PG8_WAIT_L(0); PG8_MMA(0, 0, At, B0); PG8_BAR; PG8_SCHED;
            PG8_LDB(B1, 1, 1); PG8_STAGE(PG8_SB(1, 0), b3, voffB);
            PG8_BAR; PG8_WAIT_L(0); PG8_MMA(0, 1, At, B1); PG8_BAR;
            PG8_LDA(At, 1, 1); PG8_STAGE(PG8_SA(1, 0), a3, voffA);
            PG8_BAR; PG8_WAIT_L(0); PG8_MMA(1, 0, At, B0); PG8_BAR; PG8_SCHED;
            PG8_STAGE(PG8_SB(1, 1), b3 + hstep, voffB);
            PG8_WAIT_V(6); PG8_BAR; PG8_MMA(1, 1, At, B1); PG8_BAR;
            }
        }
        if constexpr (ALIGN_EPI) { if (wr == 0) PG8_BAR; }
        if constexpr (!Epi::AFTER_DRAIN) { E(acc, cur, wr, wc, fr, fq); S.done(cur); }
        if (!has_next) break;
#pragma unroll
        for (int a = 0; a < 2; ++a)
#pragma unroll
            for (int b = 0; b < 2; ++b)
#pragma unroll
                for (int m = 0; m < 4; ++m)
#pragma unroll
                    for (int n = 0; n < 2; ++n) acc[a][b][m][n] = (f32x4){0.f, 0.f, 0.f, 0.f};
        cur = nxt; cA = nA; cB = nB; ++ui;
        if constexpr (ALIGN_EPI) { if (wr == 1) PG8_BAR; }
    }
    PG8_WAIT_V(0);
    if constexpr (!ALIGN_EPI) { if (wr == 0) PG8_BAR; }
    PG8_BAR;
    if constexpr (Epi::AFTER_DRAIN) { E.fused(acc, cur, wr, wc, fr, fq, lds, wid, lane); S.done(cur); }
#undef PG8_SA
#undef PG8_SB
#undef PG8_STAGE
#undef PG8_LDA
#undef PG8_LDB
#undef PG8_MMA
#undef PG8_WAIT_V
#undef PG8_WAIT_L
#undef PG8_BAR
#undef PG8_SCHED
}
}

#define PG8_SP2 true
#define PG8_ALIGN true
#include <hip/hip_bf16.h>
#include <cmath>
namespace attn_body {
using bf16=__hip_bfloat16;
using bf16x8=__attribute__((ext_vector_type(8)))short;
using s16x4=__attribute__((ext_vector_type(4)))short;
using f32x16=__attribute__((ext_vector_type(16)))float;
using u32x4=__attribute__((ext_vector_type(4)))unsigned;
constexpr int BATCH=4,NHEAD=16,SEQ=4096,D=64,DM=NHEAD*D,DMI=512;
constexpr int NW=8,QBLK=32,QB=QBLK*NW,KVBLK=64,NQB=SEQ/QB;
constexpr int ATTN_PITCH=DM, ATTN_UNIT_ROWS=QB;
__device__ __forceinline__ int crow(int r,int hi){return (r&3)+8*(r>>2)+4*hi;}
#define SBAR() __builtin_amdgcn_sched_barrier(0)
__device__ __forceinline__ void cmask(f32x16&p0,f32x16&p1,int jb,int qrel,int hi){
  const float NEG=-INFINITY; int kb=64*jb+4*hi;
  #pragma unroll
  for(int r=0;r<16;++r){int kv=kb+(r&3)+8*(r>>2); if(kv>qrel)p0[r]=NEG; if(kv+32>qrel)p1[r]=NEG;}
}

constexpr int NSLOT=3, SLOTB=8192;
constexpr int LDS_K=0, LDS_V=NSLOT*SLOTB, LDS_WS=2*NSLOT*SLOTB, LDS_OST=LDS_WS+NW*64*4, LDS_BYTES=LDS_OST+NW*4096;
constexpr float C2=0.125f*1.4426950408889634f;
__device__ __forceinline__ void glds16(const void*gsrc,unsigned lds_dst){unsigned keep;
  asm volatile("s_mov_b32 %0, m0\n\ts_mov_b32 m0, %2\n\ts_nop 0\n\tglobal_load_lds_dwordx4 %1, off\n\ts_mov_b32 m0, %0":"=&s"(keep):"v"(gsrc),"s"(lds_dst):"memory");}
__device__ __forceinline__ float max3f(float a,float b,float c){float r;asm("v_max3_f32 %0, %1, %2, %3":"=v"(r):"v"(a),"v"(b),"v"(c));return r;}
__device__ __forceinline__ float max2f(float a,float b){float r;asm("v_max_f32_e32 %0, %1, %2":"=v"(r):"v"(a),"v"(b));return r;}
__device__ __forceinline__ float fadd_s(float a,float b){float r;asm("v_add_f32_e32 %0, %1, %2":"=v"(r):"v"(a),"v"(b));return r;}
__device__ __forceinline__ float fsub_s(float a,float b){float r;asm("v_sub_f32_e32 %0, %1, %2":"=v"(r):"v"(a),"v"(b));return r;}
typedef float f32x2_t __attribute__((ext_vector_type(2))); typedef __bf16 bf16x2_t __attribute__((ext_vector_type(2)));
__device__ __forceinline__ unsigned cvtpk_s(float lo,float hi){f32x2_t v={lo,hi};bf16x2_t b=__builtin_convertvector(v,bf16x2_t);return __builtin_bit_cast(unsigned,b);}
#define WAIT_BAR(N) asm volatile("s_waitcnt vmcnt(" #N ") lgkmcnt(0)\n\ts_barrier":::"memory")

__device__ __forceinline__ void qkt(f32x16&p0,f32x16&p1,const char*Kslot,const bf16x8*qr,const f32x16&negm,int r32,int hi){
  const char*kb=Kslot+hi*1024+r32*16;
  #pragma unroll
  for(int d0=0;d0<4;++d0){
    const bf16x8 b0=*reinterpret_cast<const bf16x8*>(kb+d0*2048);
    const bf16x8 b1=*reinterpret_cast<const bf16x8*>(kb+d0*2048+512);
    if(d0==0){p0=__builtin_amdgcn_mfma_f32_32x32x16_bf16(b0,qr[0],negm,0,0,0);p1=__builtin_amdgcn_mfma_f32_32x32x16_bf16(b1,qr[0],negm,0,0,0);}
    else{p0=__builtin_amdgcn_mfma_f32_32x32x16_bf16(b0,qr[d0],p0,0,0,0);p1=__builtin_amdgcn_mfma_f32_32x32x16_bf16(b1,qr[d0],p1,0,0,0);}}
}
typedef __attribute__((address_space(3))) const char* lds_cptr;
typedef short v4i16_t __attribute__((ext_vector_type(4)));
__device__ __forceinline__ void kload8(bf16x8*kf,lds_cptr kp){
  kf[0]=*(const __attribute__((address_space(3))) bf16x8*)(kp);      kf[1]=*(const __attribute__((address_space(3))) bf16x8*)(kp+512);
  kf[2]=*(const __attribute__((address_space(3))) bf16x8*)(kp+2048); kf[3]=*(const __attribute__((address_space(3))) bf16x8*)(kp+2560);
  kf[4]=*(const __attribute__((address_space(3))) bf16x8*)(kp+4096); kf[5]=*(const __attribute__((address_space(3))) bf16x8*)(kp+4608);
  kf[6]=*(const __attribute__((address_space(3))) bf16x8*)(kp+6144); kf[7]=*(const __attribute__((address_space(3))) bf16x8*)(kp+6656);
}
__device__ __forceinline__ void kload2(bf16x8*kf,lds_cptr kp,int j){ kf[2*j]=*(const __attribute__((address_space(3))) bf16x8*)(kp+j*2048); kf[2*j+1]=*(const __attribute__((address_space(3))) bf16x8*)(kp+j*2048+512); }
__device__ __forceinline__ s16x4 vtr(lds_cptr p){ return __builtin_bit_cast(s16x4,__builtin_amdgcn_ds_read_tr16_b64_v4i16((__attribute__((address_space(3))) v4i16_t*)p)); }
__device__ __forceinline__ float rowmax(const f32x16&p0,const f32x16&p1){
  float a=max3f(p0[0],p0[1],p1[0]),b=max3f(p0[2],p0[3],p1[1]);a=max3f(a,p1[2],p1[3]);
  #pragma unroll
  for(int r=4;r<16;r+=4){a=max3f(a,p0[r],p0[r+1]);b=max3f(b,p0[r+2],p0[r+3]);a=max3f(a,p1[r],p1[r+1]);b=max3f(b,p1[r+2],p1[r+3]);}
  const float m=max2f(a,b);
  auto rr=__builtin_amdgcn_permlane32_swap(__float_as_uint(m),__float_as_uint(m),false,false);
  return max2f(__uint_as_float(rr[0]),__uint_as_float(rr[1]));
}
__device__ __forceinline__ void pv(f32x16*o,int vb,bf16x8 pa0,bf16x8 pa1,bf16x8 pa2,bf16x8 pa3){
  #pragma unroll
  for(int d0=0;d0<2;++d0){s16x4 lo[4],hi[4];
    #pragma unroll
    for(int ks=0;ks<4;++ks){
      asm volatile("ds_read_b64_tr_b16 %0,%1 offset:%c2":"=&v"(lo[ks]):"v"(vb),"i"(d0*4096+ks*1024):"memory");
      asm volatile("ds_read_b64_tr_b16 %0,%1 offset:%c2":"=&v"(hi[ks]):"v"(vb),"i"(d0*4096+ks*1024+512):"memory");}
    asm volatile("s_waitcnt lgkmcnt(0)":::"memory");SBAR();
    #define PK(k) (bf16x8){lo[k][0],lo[k][1],lo[k][2],lo[k][3],hi[k][0],hi[k][1],hi[k][2],hi[k][3]}
    o[d0]=__builtin_amdgcn_mfma_f32_32x32x16_bf16(pa0,PK(0),o[d0],0,0,0);
    o[d0]=__builtin_amdgcn_mfma_f32_32x32x16_bf16(pa1,PK(1),o[d0],0,0,0);
    o[d0]=__builtin_amdgcn_mfma_f32_32x32x16_bf16(pa2,PK(2),o[d0],0,0,0);
    o[d0]=__builtin_amdgcn_mfma_f32_32x32x16_bf16(pa3,PK(3),o[d0],0,0,0);
    #undef PK
  }
}

#ifndef ATTN_STORE16
#define ATTN_STORE16(p,v) (*(u32x4*)(p)=(v))
#endif
template<int THRL> __device__ __forceinline__ void attn_unit(int b,int h,int qb,const bf16*Q,const bf16*__restrict__ K,const bf16*__restrict__ V,bf16*O,char*shm){
  int tid=threadIdx.x; asm volatile("":"+v"(tid)); const int lane=tid&63,r32=lane&31,hi=lane>>5; const int wid=__builtin_amdgcn_readfirstlane(tid>>6);
  const long rowbase=(long)b*SEQ; const int q0=qb*QB;
  const int hq=h>>1, hv=((h>>2)<<1)|(h&1);
  const bf16*Qw=Q+(rowbase+q0+wid*QBLK)*DMI+hq*D;
  const bf16*Kh=K+rowbase*DMI+hq*D,*Vh=V+rowbase*DMI+hv*D;
  const unsigned lds0=(unsigned)(uintptr_t)shm;
  float*wsf=(float*)(shm+LDS_WS)+wid*64;
  const bf16*ksrc=Kh+(long)lane*DMI+wid*8;
  const bf16*vsrc=Vh+(long)(16*(wid&3)+(lane>>2))*DMI+(wid>>2)*32+(lane&3)*8;
  const unsigned kdst=lds0+LDS_K+wid*1024, vdst=lds0+LDS_V+wid*1024;
  #define DMA_K(t,slot) glds16(ksrc+(long)(t)*KVBLK*DMI,(unsigned)__builtin_amdgcn_readfirstlane(kdst+(slot)))
  #define DMA_V(t,slot) glds16(vsrc+(long)(t)*KVBLK*DMI,(unsigned)__builtin_amdgcn_readfirstlane(vdst+(slot)))
  const int vb0=(int)(lds0+LDS_V)+((lane>>4)&1)*32+(lane&3)*8+(4*hi+((lane&15)>>2))*64;
  const char*Kbase=shm+LDS_K; bf16x8 kf[8];
  const lds_cptr shm3=(lds_cptr)shm; const lds_cptr kp0=shm3+LDS_K+hi*1024+r32*16; const lds_cptr vp0=shm3+LDS_V+((lane>>4)&1)*32+(lane&3)*8+(4*hi+((lane&15)>>2))*64;
  const int NT=(q0+QB)/KVBLK;
  DMA_K(0,0);DMA_V(0,0);DMA_K(1,SLOTB);
  bf16x8 qr[4];
  #pragma unroll
  for(int d0=0;d0<4;++d0)qr[d0]=*reinterpret_cast<const bf16x8*>(&Qw[(long)r32*DMI+d0*16+hi*8]);
  float mhat=0.f,l_reg=0.f;f32x16 o[2];o[0]=f32x16{};o[1]=f32x16{};f32x16 negm=f32x16{};asm volatile("":"+v"(negm));
  const int qrel=wid*QBLK+r32;
  #define CMASK(P0,P1,t) do{int jb_=(t)-(NT-4); if(jb_>=0)cmask(P0,P1,jb_,qrel,hi);}while(0)
  bool resc=false;
  #define START(P0,P1) do{ const float rm=rowmax(P0,P1); resc=false; \
    { const float dl=rm; mhat=fadd_s(mhat,dl); \
      _Pragma("unroll") for(int r=0;r<16;++r){P0[r]=fsub_s(P0[r],dl);P1[r]=fsub_s(P1[r],dl);} \
      _Pragma("unroll") for(int r=0;r<16;++r)negm[r]=-mhat; asm volatile("":"+v"(negm)); } \
    _Pragma("unroll") for(int r=0;r<16;++r)P0[r]=__builtin_amdgcn_exp2f(P0[r]); }while(0)
  #define RESC() do{ if(resc){ asm volatile("s_waitcnt lgkmcnt(0)":::"memory"); \
      _Pragma("unroll") for(int d_=0;d_<2;++d_) _Pragma("unroll") for(int r=0;r<16;++r)o[d_][r]*=wsf[crow(r,hi)]; } }while(0)
  f32x16 pA0,pA1,pB0,pB1;
  int sl_prev=0,sl_cur=0,sl_next=SLOTB;
  #define ROT() do{sl_prev=sl_cur;sl_cur=sl_next;sl_next=(sl_next==(NSLOT-1)*SLOTB)?0:sl_next+SLOTB;}while(0)
  DMA_K(2,2*SLOTB);
  WAIT_BAR(3);
  qkt(pA0,pA1,Kbase,qr,negm,r32,hi);asm volatile("s_nop 15\n\ts_nop 7":"+v"(pA0),"+v"(pA1));CMASK(pA0,pA1,0);
  START(pA0,pA1);
  _Pragma("unroll") for(int r=0;r<16;++r)pA1[r]=__builtin_amdgcn_exp2f(pA1[r]);
  WAIT_BAR(0);
  DMA_K(3,0);DMA_V(1,SLOTB);
  ROT();
  kload8(kf,kp0+sl_cur);
  WAIT_BAR(2);
  s16x4 vlo[8],vhi[8]; u32x4 pw0,pw1,pw2,pw3;
  #define PKW(P,B) cvtpk_s(P[B],P[B+1])
  #define PAF(k) __builtin_bit_cast(bf16x8,pw##k)
  #define VFR(i) (bf16x8){vlo[i][0],vlo[i][1],vlo[i][2],vlo[i][3],vhi[i][0],vhi[i][1],vhi[i][2],vhi[i][3]}
  #define PIN(x) asm volatile("":"+v"(x))
  #define MX3(a,b,c) __builtin_fmaxf(__builtin_fmaxf((a),(b)),(c))
  #define GAPA(MF,A0,A1,A2,A3,W0,W1,PW) do{ MF; sacc+=A0; sacc+=A1; sacc+=A2; sacc+=A3; PIN(sacc); W0; W1; PIN(PW); SBAR(); }while(0)
  #define EX(v) __builtin_amdgcn_exp2f(v)
  #define GAPB(MF,X,B) do{ MF; X[B]=EX(X[B]); X[B+1]=EX(X[B+1]); X[B+2]=EX(X[B+2]); X[B+3]=EX(X[B+3]); PIN(X); SBAR(); }while(0)
  #define VRD(i) do{ vlo[i]=vtr(vp_+(((i)>>2)*4096+((i)&3)*1024)); vhi[i]=vtr(vp_+(((i)>>2)*4096+((i)&3)*1024+512)); }while(0)
  #define KRD(G,j) do{ if(G){ kload2(kf,kp0+sl_next,j); SBAR(); } }while(0)
  #define STEP(C0,C1,P0,P1,t,GK,GV,GL) do{ SBAR(); \
    const lds_cptr vp_=vp0+sl_prev; \
    VRD(0); SBAR(); float sacc=(P0[0]+P0[1]); \
    GAPA(C0=__builtin_amdgcn_mfma_f32_32x32x16_bf16(kf[0],qr[0],negm,0,0,0), P0[2],P0[3],P0[4],P0[5],     pw0[0]=PKW(P0,0), pw0[1]=PKW(P0,2), pw0); \
    VRD(4); SBAR(); GAPA(C1=__builtin_amdgcn_mfma_f32_32x32x16_bf16(kf[1],qr[0],negm,0,0,0), P0[6],P0[7],P0[8],P0[9],     pw0[2]=PKW(P0,4), pw0[3]=PKW(P0,6), pw0); \
    VRD(1); SBAR(); GAPA(C0=__builtin_amdgcn_mfma_f32_32x32x16_bf16(kf[2],qr[1],C0,0,0,0),   P0[10],P0[11],P0[12],P0[13], pw1[0]=PKW(P0,8), pw1[1]=PKW(P0,10), pw1); \
    VRD(5); SBAR(); GAPA(C1=__builtin_amdgcn_mfma_f32_32x32x16_bf16(kf[3],qr[1],C1,0,0,0),   P0[14],P0[15],P1[0],P1[1],   pw1[2]=PKW(P0,12),pw1[3]=PKW(P0,14), pw1); \
    VRD(2); SBAR(); GAPA(C0=__builtin_amdgcn_mfma_f32_32x32x16_bf16(kf[4],qr[2],C0,0,0,0),   P1[2],P1[3],P1[4],P1[5],     pw2[0]=PKW(P1,0), pw2[1]=PKW(P1,2), pw2); \
    VRD(6); SBAR(); GAPA(C1=__builtin_amdgcn_mfma_f32_32x32x16_bf16(kf[5],qr[2],C1,0,0,0),   P1[6],P1[7],P1[8],P1[9],     pw2[2]=PKW(P1,4), pw2[3]=PKW(P1,6), pw2); \
    VRD(3); SBAR(); GAPA(C0=__builtin_amdgcn_mfma_f32_32x32x16_bf16(kf[6],qr[3],C0,0,0,0),   P1[10],P1[11],P1[12],P1[13], pw3[0]=PKW(P1,8), pw3[1]=PKW(P1,10), pw3); \
    VRD(7); SBAR(); GAPA(C1=__builtin_amdgcn_mfma_f32_32x32x16_bf16(kf[7],qr[3],C1,0,0,0),   P1[14],P1[15],0.f,0.f,       pw3[2]=PKW(P1,12),pw3[3]=PKW(P1,14), pw3); \
    l_reg+=sacc; \
    if(GK){DMA_K((t)+3,sl_cur);} if(GV){DMA_V((t)+1,sl_next);} \
    CMASK(C0,C1,t); \
    { float a=MX3(C0[0],C0[1],C1[0]),b=MX3(C0[2],C0[3],C1[1]); a=MX3(a,C1[2],C1[3]); \
      _Pragma("unroll") for(int r=4;r<16;r+=4){a=MX3(a,C0[r],C0[r+1]);b=MX3(b,C0[r+2],C0[r+3]);a=MX3(a,C1[r],C1[r+1]);b=MX3(b,C1[r+2],C1[r+3]);} \
      float rm=__builtin_fmaxf(a,b); { auto rr=__builtin_amdgcn_permlane32_swap(__float_as_uint(rm),__float_as_uint(rm),false,false); rm=__builtin_fmaxf(__uint_as_float(rr[0]),__uint_as_float(rr[1])); } \
      resc=false; \
      if(__builtin_expect(__any(rm>(float)THRL),0)){ const float dl=__builtin_fmaxf(rm,0.f); mhat+=dl; \
        _Pragma("unroll") for(int r=0;r<16;++r){C0[r]-=dl;C1[r]-=dl;} \
        _Pragma("unroll") for(int r=0;r<16;++r)negm[r]=-mhat; asm volatile("":"+v"(negm)); \
        const float f=__builtin_amdgcn_exp2f(-dl); l_reg*=f; if(hi==0)wsf[r32]=f; resc=true; } } \
    SBAR(); \
    GAPB(o[0]=__builtin_amdgcn_mfma_f32_32x32x16_bf16(PAF(0),VFR(0),o[0],0,0,0), C0,0); \
    GAPB(o[1]=__builtin_amdgcn_mfma_f32_32x32x16_bf16(PAF(0),VFR(4),o[1],0,0,0), C0,4); \
    KRD(GL,0); GAPB(o[0]=__builtin_amdgcn_mfma_f32_32x32x16_bf16(PAF(1),VFR(1),o[0],0,0,0), C0,8); \
    KRD(GL,1); GAPB(o[1]=__builtin_amdgcn_mfma_f32_32x32x16_bf16(PAF(1),VFR(5),o[1],0,0,0), C0,12); \
    KRD(GL,2); GAPB(o[0]=__builtin_amdgcn_mfma_f32_32x32x16_bf16(PAF(2),VFR(2),o[0],0,0,0), C1,0); \
    KRD(GL,3); GAPB(o[1]=__builtin_amdgcn_mfma_f32_32x32x16_bf16(PAF(2),VFR(6),o[1],0,0,0), C1,4); \
    GAPB(o[0]=__builtin_amdgcn_mfma_f32_32x32x16_bf16(PAF(3),VFR(3),o[0],0,0,0), C1,8); \
    GAPB(o[1]=__builtin_amdgcn_mfma_f32_32x32x16_bf16(PAF(3),VFR(7),o[1],0,0,0), C1,12); \
    }while(0)
  int t=1;
  #undef CMASK
  #define CMASK(P0,P1,t) do{}while(0)
  for(;t+5<NT;t+=2){
    STEP(pB0,pB1,pA0,pA1,t,true,true,true);     WAIT_BAR(2); RESC(); ROT();
    STEP(pA0,pA1,pB0,pB1,t+1,true,true,true);   WAIT_BAR(2); RESC(); ROT();
  }
  #undef CMASK
  #define CMASK(P0,P1,t) do{int jb_=(t)-(NT-4); if(jb_>=0)cmask(P0,P1,jb_,qrel,hi);}while(0)
  #define ENDW(tt) do{ if((tt)+3<NT){WAIT_BAR(2);} else if((tt)+2<NT){WAIT_BAR(1);} else {WAIT_BAR(0);} }while(0)
  for(;t+1<NT;t+=2){
    STEP(pB0,pB1,pA0,pA1,t,(t+3<NT),(t+1<NT),(t+1<NT));       ENDW(t);   RESC(); ROT();
    STEP(pA0,pA1,pB0,pB1,t+1,(t+4<NT),(t+2<NT),(t+2<NT));     ENDW(t+1); RESC(); ROT();
  }
  STEP(pB0,pB1,pA0,pA1,NT-1,false,false,false); RESC();
  { float sacc=pB0[0]+pB0[1]; _Pragma("unroll") for(int r=2;r<16;++r)sacc+=pB0[r]; _Pragma("unroll") for(int r=0;r<16;++r)sacc+=pB1[r]; l_reg+=sacc;
    pw0=(u32x4){PKW(pB0,0),PKW(pB0,2),PKW(pB0,4),PKW(pB0,6)};pw1=(u32x4){PKW(pB0,8),PKW(pB0,10),PKW(pB0,12),PKW(pB0,14)};pw2=(u32x4){PKW(pB1,0),PKW(pB1,2),PKW(pB1,4),PKW(pB1,6)};pw3=(u32x4){PKW(pB1,8),PKW(pB1,10),PKW(pB1,12),PKW(pB1,14)};
    SBAR(); pv(o,vb0+sl_cur,PAF(0),PAF(1),PAF(2),PAF(3)); }
  #undef PKW
  #undef PAF
  #undef VFR
  #undef PIN
  #undef MX3
  #undef GAPA
  #undef GAPB
  #undef EX
  #undef VRD
  #undef KRD
  #undef STEP
  #undef ENDW
  {auto rr=__builtin_amdgcn_permlane32_swap(__float_as_uint(l_reg),__float_as_uint(l_reg),false,false);l_reg=__uint_as_float(rr[0])+__uint_as_float(rr[1]);}
  if(hi==0)wsf[32+r32]=l_reg;asm volatile("s_waitcnt lgkmcnt(0)":::"memory");
  float rli[16];
  #pragma unroll
  for(int r=0;r<16;++r)rli[r]=__builtin_amdgcn_rcpf(wsf[32+crow(r,hi)]);
  bf16*Ow=O+(rowbase+q0+wid*QBLK)*DM+h*D;
  { bf16*stg=(bf16*)(shm+LDS_OST)+wid*2048;
    #pragma unroll
    for(int r=0;r<16;++r){const int orow=crow(r,hi);
      #pragma unroll
      for(int d0=0;d0<2;++d0)stg[orow*64+d0*32+r32]=__float2bfloat16(o[d0][r]*rli[r]);}
    asm volatile("s_waitcnt lgkmcnt(0)":::"memory");
    #pragma unroll
    for(int i=0;i<4;++i){const int row=i*8+(lane>>3),ch=lane&7; const u32x4 v=*(const u32x4*)(stg+row*64+ch*8); ATTN_STORE16(Ow+(long)row*DM+ch*8,v);} }
  asm volatile("s_waitcnt lgkmcnt(0)\n\ts_barrier":::"memory");
  #undef DMA_K
  #undef DMA_V
  #undef CMASK
  #undef START
  #undef RESC
  #undef ROT
}
constexpr int ATTN_LDS_BYTES=LDS_BYTES;
struct AttnTensors { const bf16* Q; const bf16* K; const bf16* V; bf16* O; };
struct AttnUnit { int bh; int qb; };
struct StaticOrder {
  int vcu;
  __device__ __forceinline__ explicit StaticOrder(int grid,int block):vcu((block%8)*(grid/8)+block/8){}
  __device__ __forceinline__ bool next(int i,AttnUnit&u)const{ if(i>=4||vcu>=256)return false; const int s=vcu&3; u.bh=vcu>>2; u.qb=(i==0)?s:(i==1)?7-s:(i==2)?8+s:15-s; return true; }
  __device__ __forceinline__ void a_ready(const AttnUnit&)const{}
  __device__ __forceinline__ void done(const AttnUnit&)const{}
};
template<class Sched,int THRL=8> __device__ __forceinline__ void attn_phase(char*lds,const AttnTensors&T,const Sched&S){
  AttnUnit u;
  for(int i=0;S.next(i,u);++i){ S.a_ready(u); attn_unit<THRL>(u.bh/NHEAD,u.bh%NHEAD,u.qb,T.Q,T.K,T.V,T.O,lds); S.done(u); }
}
#undef SBAR
#undef WAIT_BAR
}

#ifndef EMU
#define DEV __device__ __forceinline__
typedef unsigned short bf16_t;
typedef short bf16x8 __attribute__((ext_vector_type(8)));
typedef float f32x4 __attribute__((ext_vector_type(4)));
DEV void wave_sync() { __builtin_amdgcn_wave_barrier(); }
#define RW_BAR() do { asm volatile("s_waitcnt lgkmcnt(0)" ::: "memory"); __builtin_amdgcn_s_barrier(); asm volatile("" ::: "memory"); } while (0)
DEV f32x4 mfma16(bf16x8 a, bf16x8 b, f32x4 c) { return __builtin_amdgcn_mfma_f32_16x16x32_bf16(a, b, c, 0, 0, 0); }
#endif
#ifdef EMU
#define RW_LAS
#define RW_OPAQUE(v_)
#else
#define RW_OPAQUE(v_) asm volatile("" : "+v"(v_))
#define RW_LAS __attribute__((address_space(3)))
#endif
#ifdef EMU
#define RW_BAR() __syncthreads()
#endif
typedef unsigned u32x2 __attribute__((ext_vector_type(2)));
typedef unsigned u32x4v __attribute__((ext_vector_type(4)));

#ifdef EMU
DEV unsigned f2bf(float f) { unsigned u = __builtin_bit_cast(unsigned, f); return (u + 0x7fffu + ((u >> 16) & 1u)) >> 16; }
DEV unsigned pk2bf(float lo, float hi) { return f2bf(lo) | (f2bf(hi) << 16); }
#else
DEV unsigned pk2bf(float lo, float hi) { typedef float f2_ __attribute__((ext_vector_type(2))); typedef __bf16 b2_ __attribute__((ext_vector_type(2))); const f2_ v = {lo, hi}; const b2_ b = __builtin_convertvector(v, b2_); return __builtin_bit_cast(unsigned, b); }
DEV unsigned f2bf(float f) { return pk2bf(f, 0.f) & 0xffffu; }
#endif
DEV float bf2f(unsigned h) { return __builtin_bit_cast(float, h << 16); }

constexpr int RW_NPROJ = 3328, RW_PB0 = 1536, RW_T = 4096, RW_MP = 16384;
constexpr int RW_LD = 72;
constexpr int RW_SLOT = 64 * RW_LD * 2;
constexpr int RW_LDF = 68;

struct RwkvP {
    const bf16_t* proj;
    const float* mu;
    const float *w0, *a0, *k_k, *k_a, *r_k, *ln_w, *ln_b;
    const float *w2, *a2, *g2;
    const bf16_t *w2t, *a2t, *g2t;
    const float* state_wkv; const float* state_shift;
    bf16_t* MT; float* NN; bf16_t* QQ; float* Y0; bf16_t* SC;
    bf16_t* VG; bf16_t* GG; float* BON;
    bf16_t* mixin;
    const bf16_t* XL; const bf16_t* XH;
    float* wkv_p; float* wkv_s;
};

DEV bf16x8 ld8(const bf16_t* p) { return *(const bf16x8*)p; }
DEV u32x2 ld4(const bf16_t* p) { return *(const u32x2*)p; }
DEV void st4(bf16_t* p, u32x2 w) { *(u32x2*)p = w; }
DEV void st1(bf16_t* p, unsigned h) { *p = (bf16_t)h; }
#ifndef EMU
DEV bf16x8 ld8(const RW_LAS bf16_t* p) { return *(const RW_LAS bf16x8*)p; }
DEV u32x2 ld4(const RW_LAS bf16_t* p) { return *(const RW_LAS u32x2*)p; }
DEV void st4(RW_LAS bf16_t* p, u32x2 w) { *(RW_LAS u32x2*)p = w; }
DEV void st1(RW_LAS bf16_t* p, unsigned h) { *p = (bf16_t)h; }
#endif
template <bool SX = false, bool SY = false, class XP, class YP>
DEV f32x4 mm_tile(XP X, int ldx, int m0, YP Y, int ldy, int n0, int K, f32x4 acc, int lane, int kbeg = 0) {
    const int xr = m0 + (lane & 15), yr = n0 + (lane & 15);
    XP xp = X + xr * ldx; YP yp = Y + yr * ldy;
    const int xs = SX ? ((xr >> 3) & 7) : 0, ys = SY ? ((yr >> 3) & 7) : 0;
    for (int k0 = kbeg; k0 < kbeg + K; k0 += 32) {
        const int kb = (k0 >> 3) + (lane >> 4);
        const bf16x8 xf = ld8(xp + 8 * (kb ^ xs)), yf = ld8(yp + 8 * (kb ^ ys));
        acc = mfma16(yf, xf, acc);
    }
    return acc;
}
template <class DP> DEV void st_rm(DP D, int ld, int m0, int n0, f32x4 v, int lane) {
    u32x2 w; w.x = pk2bf(v[0], v[1]); w.y = pk2bf(v[2], v[3]);
    st4(D + (m0 + (lane & 15)) * ld + n0 + 4 * (lane >> 4), w);
}
template <class DP> DEV void st_tr(DP D, int ld, int m0, int n0, f32x4 v, int lane) {
#pragma unroll
    for (int r = 0; r < 4; ++r) st1(D + (n0 + 4 * (lane >> 4) + r) * ld + m0 + (lane & 15), f2bf(v[r]));
}
template <class SP> DEV f32x4 ld_rm(SP S, int ld, int m0, int n0, int lane) {
    const u32x2 w = ld4(S + (m0 + (lane & 15)) * ld + n0 + 4 * (lane >> 4));
    return (f32x4){bf2f(w.x & 0xffffu), bf2f(w.x >> 16), bf2f(w.y & 0xffffu), bf2f(w.y >> 16)};
}
#ifdef EMU
DEV float dpp_q1(float v, int lane) { return __shfl(v, lane ^ 1); }
DEV float dpp_q2(float v, int lane) { return __shfl(v, lane ^ 2); }
DEV float dpp_hm(float v, int lane) { return __shfl(v, (lane & ~7) | (7 - (lane & 7))); }
DEV float dpp_rm(float v, int lane) { return __shfl(v, (lane & ~15) | (15 - (lane & 15))); }
DEV float dpp_x8(float v, int lane) { return __shfl(v, lane ^ 8); }
DEV float sum_x32(float v, int lane) { return v + __shfl(v, lane ^ 32); }
#else
DEV float dpp_q1(float v, int) { return __builtin_bit_cast(float, __builtin_amdgcn_update_dpp(0, __builtin_bit_cast(int, v), 0xB1, 0xF, 0xF, true)); }
DEV float dpp_q2(float v, int) { return __builtin_bit_cast(float, __builtin_amdgcn_update_dpp(0, __builtin_bit_cast(int, v), 0x4E, 0xF, 0xF, true)); }
DEV float dpp_hm(float v, int) { return __builtin_bit_cast(float, __builtin_amdgcn_update_dpp(0, __builtin_bit_cast(int, v), 0x141, 0xF, 0xF, true)); }
DEV float dpp_rm(float v, int) { return __builtin_bit_cast(float, __builtin_amdgcn_update_dpp(0, __builtin_bit_cast(int, v), 0x140, 0xF, 0xF, true)); }
DEV float dpp_x8(float v, int) { return __builtin_bit_cast(float, __builtin_amdgcn_update_dpp(0, __builtin_bit_cast(int, v), 0x128, 0xF, 0xF, true)); }
DEV float sum_x32(float v, int) { return v + __shfl_xor(v, 32); }
#endif
#ifdef EMU
DEV float dpp_shr(float v, int n, int lane) { const float o = __shfl(v, (lane - n) & 63); return (lane & 15) >= n ? o : 0.f; }
#else
template <int N> DEV float dpp_shr_(float v) { return __builtin_bit_cast(float, __builtin_amdgcn_update_dpp(0, __builtin_bit_cast(int, v), 0x110 + N, 0xF, 0xF, true)); }
DEV float dpp_shr(float v, int n, int) { return n == 1 ? dpp_shr_<1>(v) : (n == 2 ? dpp_shr_<2>(v) : (n == 4 ? dpp_shr_<4>(v) : dpp_shr_<8>(v))); }
#endif
DEV float rscan16(float v, int lane) { v += dpp_shr(v, 1, lane); v += dpp_shr(v, 2, lane); v += dpp_shr(v, 4, lane); v += dpp_shr(v, 8, lane); return v; }
DEV float rsum16(float v, int lane) { v += dpp_q1(v, lane); v += dpp_q2(v, lane); v += dpp_hm(v, lane); v += dpp_rm(v, lane); return v; }
DEV float wsum64d(float v, int lane) { v = rsum16(v, lane); v += __shfl_xor(v, 16); return sum_x32(v, lane); }
#ifdef EMU
DEV float rcpf_(float x) { return 1.f / x; }
DEV float rsqf_(float x) { return 1.f / sqrtf(x); }
DEV float logf_(float x) { return logf(x); }
#else
DEV float rcpf_(float x) { return __builtin_amdgcn_rcpf(x); }
DEV float rsqf_(float x) { return __builtin_amdgcn_rsqf(x); }
DEV float logf_(float x) { return __logf(x); }
#endif
DEV float sigmoidf_(float x) { return rcpf_(1.f + __expf(-x)); }
DEV float tanhf_(float x) { const float e = __expf(-2.f * fabsf(x)); const float t = (1.f - e) * rcpf_(1.f + e); return x < 0.f ? -t : t; }
DEV float softplusf_(float x) { return fmaxf(x, 0.f) + logf_(1.f + __expf(-fabsf(x))); }

struct RwkvGrp { f32x4 pm[2], ll[2];
    bf16x8 xf[8]; u32x4v pr, pk, pvv;
    bf16x8 yw[2][2], ya[2][2], yg[2][4];
    f32x4 dq[2], dy[2];
};
DEV void rw_prefetch(RwkvGrp& g, const RwkvP& p, int b, int h, int c) {
    int tid = threadIdx.x; RW_OPAQUE(tid); const int lane = tid & 63, wid = tid >> 6, mi = wid >> 1; const int r0 = b * RW_T + c * 64;
    const bf16_t* xh = p.XH + ((size_t)(r0 + (tid >> 3)) * 8 + h) * 192 + (tid & 7) * 8;
    g.pr = *(const u32x4v*)xh; g.pk = *(const u32x4v*)(xh + 64); g.pvv = *(const u32x4v*)(xh + 128);
    const bf16_t* xl = p.XL + (size_t)(r0 + 16 * mi + (lane & 15)) * 256 + 8 * (lane >> 4);
#pragma unroll
    for (int j = 0; j < 8; ++j) g.xf[j] = *(const bf16x8*)(xl + 32 * j);
}
DEV void rw_weights(RwkvGrp& g, const RwkvP& p, int h) {
    int tid = threadIdx.x; RW_OPAQUE(tid); const int lane = tid & 63, wid = tid >> 6;
#pragma unroll
    for (int q = 0; q < 2; ++q) { const int nrow = h * 64 + 16 * (2 * (wid & 1) + q) + (lane & 15);
#pragma unroll
        for (int j = 0; j < 2; ++j) { g.yw[q][j] = *(const bf16x8*)(p.w2t + (size_t)nrow * 64 + 32 * j + 8 * (lane >> 4)); g.ya[q][j] = *(const bf16x8*)(p.a2t + (size_t)nrow * 64 + 32 * j + 8 * (lane >> 4)); }
#pragma unroll
        for (int j = 0; j < 4; ++j) g.yg[q][j] = *(const bf16x8*)(p.g2t + (size_t)nrow * 128 + 32 * j + 8 * (lane >> 4)); }
}
#if defined(PROBE_A) && !defined(EMU)
#define RW_TICK(k) do { if (threadIdx.x == 0) { volatile RW_LAS unsigned long long* A_ = (volatile RW_LAS unsigned long long*)(lds + 147456 + 2048); const unsigned long long n_ = __builtin_amdgcn_s_memrealtime(); if ((k) > 0) A_[k] += n_ - A_[0]; A_[0] = n_; } } while (0)
#else
#define RW_TICK(k) do { } while (0)
#endif
DEV void rwkv_passA(const RwkvP& p, int b, int h, int c, RW_LAS unsigned char* lds, RwkvGrp& gs, bool first, bool last) {
    int tid = threadIdx.x; RW_OPAQUE(tid); int lane = tid & 63, wid = tid >> 6;
#define RW_STAGE() { tid = threadIdx.x; RW_OPAQUE(tid); lane = tid & 63; wid = tid >> 6; mi = wid >> 1; mrow = 16 * mi + (lane & 15); }
    int mi = wid >> 1, mrow = 16 * mi + (lane & 15);
    const int r0 = b * RW_T + c * 64;
    const int ch = c * 32 + b * 8 + h;
#define SL(i) ((RW_LAS bf16_t*)(lds + (i) * RW_SLOT))
    RW_LAS bf16_t *AT = SL(0), *KH = SL(2), *BH = SL(3), *RT = SL(4), *VT = SL(5), *KTT = SL(6), *BTT = SL(7);
    RW_LAS float* LW = (RW_LAS float*)(lds + 8 * RW_SLOT); RW_LAS float* LA = LW + 64 * RW_LDF; RW_LAS float* LC = LA + 64 * RW_LDF;
    RW_LAS bf16_t *AAK = SL(8), *P0 = SL(9), *ARK = SL(11), *ARB = SL(12);
    RW_LAS float* PCV = (RW_LAS float*)(lds + 16 * RW_SLOT + 512);
    RW_TICK(0);
    RW_LAS float* CST = (RW_LAS float*)(lds + 16 * RW_SLOT + 2560);
    if (first) { rw_weights(gs, p, h); rw_prefetch(gs, p, b, h, c);
        if (tid < 320) { const int wch = tid >> 6, d = tid & 63; const float* src = wch == 0 ? p.w0 : (wch == 1 ? p.a0 : (wch == 2 ? p.k_k : (wch == 3 ? p.k_a : p.r_k))); CST[tid] = src[h * 64 + d]; }
        RW_BAR(); }
    { RW_STAGE()
#pragma unroll
        for (int q = 0; q < 2; ++q) {
            const int ni = 2 * (wid & 1) + q; const f32x4 z = {0.f, 0.f, 0.f, 0.f};
            f32x4 aw = mfma16(gs.yw[q][0], gs.xf[0], z); aw = mfma16(gs.yw[q][1], gs.xf[1], aw);
            f32x4 aa = mfma16(gs.ya[q][0], gs.xf[2], z); aa = mfma16(gs.ya[q][1], gs.xf[3], aa);
            f32x4 ag = mfma16(gs.yg[q][0], gs.xf[4], z); ag = mfma16(gs.yg[q][1], gs.xf[5], ag); ag = mfma16(gs.yg[q][2], gs.xf[6], ag); ag = mfma16(gs.yg[q][3], gs.xf[7], ag);
            const int t = 16 * mi + (lane & 15), d0 = 16 * ni + 4 * (lane >> 4);
            f32x4 lw, la;
            const f32x4 cw0 = *(const RW_LAS f32x4*)(CST + d0), ca0 = *(const RW_LAS f32x4*)(CST + 64 + d0);
#pragma unroll
            for (int r = 0; r < 4; ++r) {
                const float wraw = -softplusf_(-(cw0[r] + aw[r])) - 0.5f; lw[r] = -__expf(wraw);
                la[r] = sigmoidf_(ca0[r] + aa[r]); }
            *(RW_LAS f32x4*)(LW + t * RW_LDF + d0) = lw; *(RW_LAS f32x4*)(LA + t * RW_LDF + d0) = la;
            f32x4 lc;
#pragma unroll
            for (int r = 0; r < 4; ++r) lc[r] = rscan16(lw[r], lane);
            *(RW_LAS f32x4*)(LC + t * RW_LDF + d0) = lc;
            if ((lane & 15) == 15) *(RW_LAS f32x4*)((RW_LAS float*)(lds + 14 * RW_SLOT) + mi * 64 + d0) = lc;
            u32x2 gw; gw.x = pk2bf(ag[0], ag[1]); gw.y = pk2bf(ag[2], ag[3]);
            *(u32x2*)(p.GG + (size_t)(r0 + t) * 512 + h * 64 + d0) = gw;
        }
    }
    RW_BAR();
    RW_TICK(1);
    RW_TICK(2);
    { RW_STAGE()
        const int t = tid >> 3, dg = tid & 7, d0 = dg * 8, hd0 = h * 64 + d0;
        float r[8], k[8], v[8], kk[8], a[8], lw[8], L[8], L63[8];
        { const unsigned wr_[4] = {gs.pr.x, gs.pr.y, gs.pr.z, gs.pr.w}, wk_[4] = {gs.pk.x, gs.pk.y, gs.pk.z, gs.pk.w}, wv_[4] = {gs.pvv.x, gs.pvv.y, gs.pvv.z, gs.pvv.w};
#pragma unroll
          for (int i = 0; i < 4; ++i) { r[2 * i] = bf2f(wr_[i] & 0xffffu); r[2 * i + 1] = bf2f(wr_[i] >> 16); k[2 * i] = bf2f(wk_[i] & 0xffffu); k[2 * i + 1] = bf2f(wk_[i] >> 16); v[2 * i] = bf2f(wv_[i] & 0xffffu); v[2 * i + 1] = bf2f(wv_[i] >> 16); } }
#pragma unroll
        for (int q = 0; q < 2; ++q) {
            const f32x4 x1 = *(const RW_LAS f32x4*)(LW + t * RW_LDF + d0 + 4 * q), x3 = *(const RW_LAS f32x4*)(LA + t * RW_LDF + d0 + 4 * q);
            f32x4 x2 = *(const RW_LAS f32x4*)(LC + t * RW_LDF + d0 + 4 * q), x4 = {0.f, 0.f, 0.f, 0.f};
#pragma unroll
            for (int bb = 0; bb < 4; ++bb) { const f32x4 tt = *(const RW_LAS f32x4*)((const RW_LAS float*)(lds + 14 * RW_SLOT) + bb * 64 + d0 + 4 * q); x4 = x4 + tt; if (bb < (t >> 4)) x2 = x2 + tt; }
#pragma unroll
            for (int e = 0; e < 4; ++e) { lw[4 * q + e] = x1[e]; L[4 * q + e] = x2[e]; a[4 * q + e] = x3[e]; L63[4 * q + e] = x4[e]; }
        }
        float n2 = 0.f, bon = 0.f; float k2[8];
#pragma unroll
        for (int e = 0; e < 8; ++e) { kk[e] = k[e] * CST[128 + d0 + e]; n2 += kk[e] * kk[e]; k2[e] = k[e] * (1.f + (a[e] - 1.f) * CST[192 + d0 + e]); bon += r[e] * k2[e] * CST[256 + d0 + e]; }
        n2 += dpp_q1(n2, lane); n2 += dpp_q2(n2, lane); n2 += dpp_hm(n2, lane);
        bon += dpp_q1(bon, lane); bon += dpp_q2(bon, lane); bon += dpp_hm(bon, lane);
        const float inv = rsqf_(fmaxf(n2, 1e-24f));
        if (dg == 0) p.BON[(size_t)(r0 + t) * 8 + h] = bon;
        { u32x4v w; w.x = pk2bf(v[0], v[1]); w.y = pk2bf(v[2], v[3]); w.z = pk2bf(v[4], v[5]); w.w = pk2bf(v[6], v[7]); *(u32x4v*)(p.VG + (size_t)(r0 + t) * 512 + hd0) = w; }
        float at[8], kh[8], bh[8], rt[8], kt[8], bt[8];
#pragma unroll
        for (int e = 0; e < 8; ++e) { kk[e] *= inv; const float P = __expf(L[e]), Pi = __expf(-L[e]), Pm1 = __expf(L[e] - lw[e]), Pc = __expf(L63[e] - L[e]); const float bb = kk[e] * a[e];
            at[e] = -kk[e] * Pm1; kh[e] = k2[e] * Pi; bh[e] = bb * Pi; rt[e] = r[e] * P; kt[e] = k2[e] * Pc; bt[e] = bb * Pc; }
#define RW_ST8(D, ARR_) { u32x4v w_; w_.x = pk2bf(ARR_[0], ARR_[1]); w_.y = pk2bf(ARR_[2], ARR_[3]); w_.z = pk2bf(ARR_[4], ARR_[5]); w_.w = pk2bf(ARR_[6], ARR_[7]); *(RW_LAS u32x4v*)(D + t * RW_LD + d0) = w_; }
        RW_ST8(AT, at) RW_ST8(KH, kh) RW_ST8(BH, bh) RW_ST8(RT, rt)
#undef RW_ST8
        { const int tsw = t ^ (8 * dg);
#pragma unroll
          for (int e = 0; e < 8; ++e) { VT[(d0 + e) * RW_LD + tsw] = (bf16_t)f2bf(v[e]); KTT[(d0 + e) * RW_LD + tsw] = (bf16_t)f2bf(kt[e]); BTT[(d0 + e) * RW_LD + tsw] = (bf16_t)f2bf(bt[e]); } }
        if (t == 0) {
#pragma unroll
            for (int e = 0; e < 8; ++e) PCV[d0 + e] = __expf(L63[e]); }
    }
    RW_BAR();
    if (!first) {
        RW_STAGE()
        const int chp = (c - 1) * 32 + b * 8 + h; bf16_t* gQp = p.QQ + (size_t)chp * 4096; float* gYp = p.Y0 + (size_t)chp * 4096;
#pragma unroll
        for (int q = 0; q < 2; ++q) { const int ni = 2 * (wid & 1) + q; st_rm(gQp, 64, 16 * mi, 16 * ni, gs.dq[q], lane); *(f32x4*)(gYp + mrow * 64 + 16 * ni + 4 * (lane >> 4)) = gs.dy[q]; }
    }
    if (!last) rw_prefetch(gs, p, b, h, c + 1);
    RW_TICK(3);
    const f32x4 z4 = {0.f, 0.f, 0.f, 0.f};
    RW_STAGE()
    RW_LAS bf16_t *POFF = SL(10), *DD = SL(13), *WT = SL(3), *UT = SL(2);
#pragma unroll
    for (int q = 0; q < 2; ++q) {
        const int ni = 2 * (wid & 1) + q, nc0 = 16 * ni + 4 * (lane >> 4);
        f32x4 ak = mm_tile(AT, RW_LD, 16 * mi, KH, RW_LD, 16 * ni, 64, z4, lane);
        f32x4 ab = mm_tile(AT, RW_LD, 16 * mi, BH, RW_LD, 16 * ni, 64, z4, lane);
        f32x4 rk = mm_tile(RT, RW_LD, 16 * mi, KH, RW_LD, 16 * ni, 64, z4, lane);
        f32x4 rb = mm_tile(RT, RW_LD, 16 * mi, BH, RW_LD, 16 * ni, 64, z4, lane);
#pragma unroll
        for (int r = 0; r < 4; ++r) { const int n = nc0 + r; if (!(n < mrow)) { ak[r] = 0.f; ab[r] = 0.f; } if (!(n <= mrow)) { rk[r] = 0.f; rb[r] = 0.f; } }
        st_rm(AAK, RW_LD, 16 * mi, 16 * ni, ak, lane); st_rm(P0, RW_LD, 16 * mi, 16 * ni, ab, lane); st_rm(POFF, RW_LD, 16 * mi, 16 * ni, mi == ni ? z4 : ab, lane);
        st_rm(ARK, RW_LD, 16 * mi, 16 * ni, rk, lane); st_rm(ARB, RW_LD, 16 * mi, 16 * ni, rb, lane);
    }
    for (int i = tid; i < RW_SLOT / 4; i += 512) ((RW_LAS unsigned*)DD)[i] = 0u;
    RW_BAR();
    RW_TICK(4);
    RW_STAGE()
    if (wid == 0) {
        const int bi = lane >> 4, col = lane & 15; float x[16];
#pragma unroll
        for (int j = 0; j < 16; ++j) {
            float sacc = (j == col) ? 1.f : 0.f;
            if (j > 0) { const RW_LAS bf16_t* arow = P0 + (16 * bi + j) * RW_LD + 16 * bi;
                const bf16x8 a0 = ld8(arow), a1 = ld8(arow + 8);
#pragma unroll
                for (int k = 0; k < 16; ++k) if (k < j) sacc += bf2f((unsigned)(unsigned short)(k < 8 ? a0[k & 7] : a1[k & 7])) * x[k]; }
            x[j] = sacc;
        }
#pragma unroll
        for (int j = 0; j < 16; ++j) st1(DD + (16 * bi + j) * RW_LD + 16 * bi + col, f2bf(x[j]));
    } else {
        for (int i = tid - 64; i < 2 * RW_SLOT / 4; i += 448) { ((RW_LAS unsigned*)SL(2))[i] = 0u; ((RW_LAS unsigned*)SL(14))[i] = 0u; }
    }
    RW_BAR();
    RW_STAGE()
    {
        const int sx = wid & 3, kind = wid >> 2; RW_LAS bf16_t* OUT = kind ? UT : WT; RW_LAS bf16_t* SCR = SL(14) + wid * (16 * RW_LD);
#pragma unroll
        for (int i = 0; i < 4; ++i) {
            f32x4 acc = kind ? mm_tile<false, true>(AAK, RW_LD, 16 * i, VT, RW_LD, 16 * sx, 64, z4, lane) : ld_rm(AT, RW_LD, 16 * i, 16 * sx, lane);
            if (i > 0) acc = mm_tile(POFF, RW_LD, 16 * i, OUT, RW_LD, 16 * sx, i == 3 ? 64 : 32, acc, lane);
            st_tr(SCR, RW_LD, 16 * i, 0, acc, lane);
            wave_sync();
            const f32x4 xo = mm_tile(DD, RW_LD, 16 * i, SCR, RW_LD, 0, 32, z4, lane, 32 * (i >> 1));
            st_tr(OUT, RW_LD, 16 * i, 16 * sx, xo, lane);
            wave_sync();
        }
    }
    RW_BAR();
    RW_TICK(5);
    RW_TICK(6);
    f32x4 y0r[2], nnr[2];
    RW_STAGE()
    if (first) {
#pragma unroll
        for (int q = 0; q < 2; ++q) { const int nc0 = 16 * (2 * (wid & 1) + q) + 4 * (lane >> 4);
#pragma unroll
            for (int r = 0; r < 4; ++r) gs.pm[q][r] = (nc0 + r == mrow) ? 1.f : 0.f;
            gs.ll[q] = z4; }
    }
#pragma unroll
    for (int q = 0; q < 2; ++q) {
        const int ni = 2 * (wid & 1) + q, nc0 = 16 * ni + 4 * (lane >> 4);
        const f32x4 qq = mm_tile(ARB, RW_LD, 16 * mi, WT, RW_LD, 16 * ni, 64, ld_rm(RT, RW_LD, 16 * mi, 16 * ni, lane), lane);
        st_rm(SL(0), RW_LD, 16 * mi, 16 * ni, qq, lane);
        y0r[q] = mm_tile<false, true>(ARK, RW_LD, 16 * mi, VT, RW_LD, 16 * ni, 64, z4, lane); y0r[q] = mm_tile(ARB, RW_LD, 16 * mi, UT, RW_LD, 16 * ni, 64, y0r[q], lane);
        f32x4 mt = mm_tile<true, false>(BTT, RW_LD, 16 * mi, WT, RW_LD, 16 * ni, 64, z4, lane);
#pragma unroll
        for (int r = 0; r < 4; ++r) if (nc0 + r == mrow) mt[r] += PCV[mrow];
        st_rm(SL(1), RW_LD, 16 * mi, 16 * ni, mt, lane);
        nnr[q] = mm_tile<true, true>(VT, RW_LD, 16 * mi, KTT, RW_LD, 16 * ni, 64, z4, lane); nnr[q] = mm_tile<false, true>(UT, RW_LD, 16 * mi, BTT, RW_LD, 16 * ni, 64, nnr[q], lane);
        st_rm(SL(14), RW_LD, 16 * mi, 16 * ni, gs.pm[q], lane); st_rm(SL(15), RW_LD, 16 * mi, 16 * ni, gs.ll[q], lane);
    }
    RW_BAR();
    RW_TICK(7);
    { RW_STAGE()
        bf16_t* gQ = p.QQ + (size_t)ch * 4096; float* gY0 = p.Y0 + (size_t)ch * 4096;
#pragma unroll
        for (int q = 0; q < 2; ++q) {
            const int ni = 2 * (wid & 1) + q, nc0 = 16 * ni + 4 * (lane >> 4);
            const f32x4 q2 = mm_tile(SL(0), RW_LD, 16 * mi, SL(14), RW_LD, 16 * ni, 64, z4, lane);
            const f32x4 y2 = mm_tile(SL(0), RW_LD, 16 * mi, SL(15), RW_LD, 16 * ni, 64, y0r[q], lane);
            if (last) { st_rm(gQ, 64, 16 * mi, 16 * ni, q2, lane); *(f32x4*)(gY0 + mrow * 64 + nc0) = y2; } else { gs.dq[q] = q2; gs.dy[q] = y2; }
            gs.pm[q] = mm_tile(SL(14), RW_LD, 16 * mi, SL(1), RW_LD, 16 * ni, 64, z4, lane);
            gs.ll[q] = mm_tile(SL(15), RW_LD, 16 * mi, SL(1), RW_LD, 16 * ni, 64, nnr[q], lane);
            if (last) {
                const size_t grp = (size_t)((c >> 3) * 32 + b * 8 + h);
                st_tr(p.MT + grp * 4096, 64, 16 * mi, 16 * ni, gs.pm[q], lane);
                *(f32x4*)(p.NN + grp * 4096 + mrow * 64 + nc0) = gs.ll[q];
            }
        }
    }
    RW_BAR();
    RW_TICK(8);
#undef SL
#undef RW_STAGE
}

constexpr int PBD = 4;
struct PbOps { bf16x8 m[4][2]; f32x4 n[4]; };
DEV void pb_load(PbOps& o, const RwkvP& p, size_t ch, int vrow, int lane) {
    const bf16_t* M = p.MT + ch * 4096 + (lane & 15) * 64 + 8 * (lane >> 4); const float* N = p.NN + ch * 4096 + vrow * 64 + 4 * (lane >> 4);
#pragma unroll
    for (int ni = 0; ni < 4; ++ni) { o.m[ni][0] = *(const bf16x8*)(M + ni * 1024); o.m[ni][1] = *(const bf16x8*)(M + ni * 1024 + 32); o.n[ni] = *(const f32x4*)(N + 16 * ni); }
}
DEV void rwkv_passB(const RwkvP& p, int b, int h, int vb, RW_LAS unsigned char* wlds, int lane, int nchunk = 8) {
    RW_LAS bf16_t* S = (RW_LAS bf16_t*)wlds;
    for (int i = lane; i < 16 * RW_LD / 2; i += 64) ((RW_LAS unsigned*)S)[i] = 0u;
    wave_sync();
    f32x4 acc[4];
#pragma unroll
    for (int ni = 0; ni < 4; ++ni) acc[ni] = (f32x4){0.f, 0.f, 0.f, 0.f};
    const int vrow = vb * 16 + (lane & 15);
    const size_t chb = (size_t)(b * 8 + h);
#define PB_CH(c_) ((size_t)(c_) * 32 + chb)
    PbOps ops[PBD];
#pragma unroll
    for (int d = 0; d < PBD; ++d) pb_load(ops[d], p, PB_CH(d < nchunk ? d : nchunk - 1), vrow, lane);
    const RW_LAS bf16_t* xp = S + (lane & 15) * RW_LD + 8 * (lane >> 4);
    for (int c0 = 0; c0 < nchunk; c0 += PBD) {
#pragma unroll
        for (int d = 0; d < PBD; ++d) {
            const int c = c0 + d; const size_t ch = PB_CH(c);
            { const int rr = lane >> 2, cc = (lane & 3) * 16;
              const u32x4v w0 = *(const RW_LAS u32x4v*)(S + rr * RW_LD + cc), w1 = *(const RW_LAS u32x4v*)(S + rr * RW_LD + cc + 8);
              bf16_t* dst = p.SC + ch * 4096 + (size_t)(vb * 16 + rr) * 64 + cc; *(u32x4v*)dst = w0; *(u32x4v*)(dst + 8) = w1; }
            const bf16x8 x0 = ld8(xp), x1 = ld8(xp + 32);
#pragma unroll
            for (int ni = 0; ni < 4; ++ni) { acc[ni] = mfma16(ops[d].m[ni][0], x0, ops[d].n[ni]); acc[ni] = mfma16(ops[d].m[ni][1], x1, acc[ni]); }
            { const int cn = c + PBD; pb_load(ops[d], p, PB_CH(cn < nchunk ? cn : nchunk - 1), vrow, lane); }
            wave_sync();
#pragma unroll
            for (int ni = 0; ni < 4; ++ni) st_rm(S, RW_LD, 0, 16 * ni, acc[ni], lane);
            wave_sync();
        }
    }
    float* out = p.wkv_p + (size_t)(b * 8 + h) * 4096;
#pragma unroll
    for (int ni = 0; ni < 4; ++ni) *(f32x4*)(out + vrow * 64 + 16 * ni + 4 * (lane >> 4)) = acc[ni];
#undef PB_CH
}

struct PcIn { bf16x8 qf[2]; f32x4 y0[4]; u32x2 vg[4], gg[4]; float bon; };
DEV void pc_load(PcIn& o, const RwkvP& p, const bf16_t* Q, const float* Y0, int r0, int h, int mi, int lane) {
    const int t = 16 * mi + (lane & 15);
    o.qf[0] = *(const bf16x8*)(Q + t * 64 + 8 * (lane >> 4)); o.qf[1] = *(const bf16x8*)(Q + t * 64 + 32 + 8 * (lane >> 4));
    o.bon = p.BON[(size_t)(r0 + t) * 8 + h];
#pragma unroll
    for (int ni = 0; ni < 4; ++ni) { const int v0 = 16 * ni + 4 * (lane >> 4), hv = h * 64 + v0;
        o.y0[ni] = *(const f32x4*)(Y0 + t * 64 + v0); o.vg[ni] = *(const u32x2*)(p.VG + (size_t)(r0 + t) * 512 + hv); o.gg[ni] = *(const u32x2*)(p.GG + (size_t)(r0 + t) * 512 + hv); }
}
DEV void pc_compute(const PcIn& in, const bf16x8 (&sf)[4][2], const RwkvP& p, int r0, int h, int mi, int lane) {
    const int t = 16 * mi + (lane & 15); f32x4 y[4];
#pragma unroll
    for (int ni = 0; ni < 4; ++ni) { y[ni] = mfma16(sf[ni][0], in.qf[0], in.y0[ni]); y[ni] = mfma16(sf[ni][1], in.qf[1], y[ni]); }
    float s = 0.f;
#pragma unroll
    for (int ni = 0; ni < 4; ++ni) s += (y[ni][0] + y[ni][1]) + (y[ni][2] + y[ni][3]);
    s += __shfl_xor(s, 16); s += __shfl_xor(s, 32);
    const float mean = s * (1.f / 64.f); float q = 0.f;
#pragma unroll
    for (int ni = 0; ni < 4; ++ni)
#pragma unroll
        for (int r = 0; r < 4; ++r) { const float d = y[ni][r] - mean; q += d * d; }
    q += __shfl_xor(q, 16); q += __shfl_xor(q, 32);
    const float rstd = rsqf_(q * (1.f / 64.f) + 64e-5f);
#pragma unroll
    for (int ni = 0; ni < 4; ++ni) {
        const int v0 = 16 * ni + 4 * (lane >> 4), hv = h * 64 + v0;
        const u32x2 vw = in.vg[ni], gw = in.gg[ni];
        const float vv[4] = {bf2f(vw.x & 0xffffu), bf2f(vw.x >> 16), bf2f(vw.y & 0xffffu), bf2f(vw.y >> 16)};
        const float gg[4] = {bf2f(gw.x & 0xffffu), bf2f(gw.x >> 16), bf2f(gw.y & 0xffffu), bf2f(gw.y >> 16)};
        const f32x4 lw = *(const f32x4*)(p.ln_w + hv), lb = *(const f32x4*)(p.ln_b + hv);
        float o[4];
#pragma unroll
        for (int r = 0; r < 4; ++r) o[r] = ((y[ni][r] - mean) * rstd * lw[r] + lb[r] + in.bon * vv[r]) * gg[r];
        u32x2 w; w.x = pk2bf(o[0], o[1]); w.y = pk2bf(o[2], o[3]);
        *(u32x2*)(p.mixin + (size_t)(r0 + t) * 1024 + 512 + hv) = w;
    }
}
DEV void rwkv_passC(const RwkvP& p, int b, int h, int c, int lane) {
    const size_t ch = (size_t)(c * 32 + b * 8 + h); const int r0 = b * RW_T + c * 64;
    const bf16_t* Q = p.QQ + ch * 4096; const bf16_t* S = p.SC + (size_t)((c >> 3) * 32 + b * 8 + h) * 4096; const float* Y0 = p.Y0 + ch * 4096;
    bf16x8 sf[4][2];
#pragma unroll
    for (int ni = 0; ni < 4; ++ni) { sf[ni][0] = *(const bf16x8*)(S + (16 * ni + (lane & 15)) * 64 + 8 * (lane >> 4)); sf[ni][1] = *(const bf16x8*)(S + (16 * ni + (lane & 15)) * 64 + 32 + 8 * (lane >> 4)); }
    PcIn A, B;
    pc_load(A, p, Q, Y0, r0, h, 0, lane); pc_load(B, p, Q, Y0, r0, h, 1, lane);
    pc_compute(A, sf, p, r0, h, 0, lane); pc_load(A, p, Q, Y0, r0, h, 2, lane);
    pc_compute(B, sf, p, r0, h, 1, lane); pc_load(B, p, Q, Y0, r0, h, 3, lane);
    pc_compute(A, sf, p, r0, h, 2, lane); pc_compute(B, sf, p, r0, h, 3, lane);
}

DEV void rwkv_sample(const RwkvP& p, int n, int h, RW_LAS unsigned char* wlds, int lane) {
    RW_LAS float* W = (RW_LAS float*)wlds;
    const int row = RW_MP + n, d = lane, hd = h * 64 + d;
    const bf16_t* pb = p.proj + (size_t)row * RW_NPROJ + RW_PB0; const float* pv = p.state_shift + (size_t)n * 1792;
#define XS(col) (bf2f(pb[col]) + (pv[col] - bf2f(pb[col])) * p.mu[col])
    const float r = XS(hd), k = XS(512 + hd), v = XS(1024 + hd);
    const float tw = tanhf_(XS(1536 + d)), xa = XS(1600 + d), sg0 = sigmoidf_(XS(1664 + d)), sg1 = sigmoidf_(XS(1728 + d));
#undef XS
    float aw = 0.f, aa = 0.f, ag = 0.f;
    W[d] = tw; W[64 + d] = xa; W[128 + d] = sg0; W[192 + d] = sg1;
    wave_sync();
#pragma unroll 8
    for (int j = 0; j < 64; ++j) { const float twj = W[j], xaj = W[64 + j], g0 = W[128 + j], g1 = W[192 + j];
        aw += twj * p.w2[j * 512 + hd]; aa += xaj * p.a2[j * 512 + hd]; ag += g0 * p.g2[j * 512 + hd] + g1 * p.g2[(64 + j) * 512 + hd]; }
    wave_sync();
    const float wraw = -softplusf_(-(p.w0[hd] + aw)) - 0.5f; const float w = __expf(-__expf(wraw));
    const float a = sigmoidf_(p.a0[hd] + aa);
    float kk = k * p.k_k[hd]; float n2 = kk * kk;
#pragma unroll
    for (int o = 1; o < 64; o <<= 1) n2 += __shfl_xor(n2, o);
    kk *= rsqf_(fmaxf(n2, 1e-24f));
    const float k2 = k * (1.f + (a - 1.f) * p.k_a[hd]);
    float bon = r * k2 * p.r_k[hd];
#pragma unroll
    for (int o = 1; o < 64; o <<= 1) bon += __shfl_xor(bon, o);
    W[d] = w; W[64 + d] = kk * a; W[128 + d] = k2; W[192 + d] = r; W[256 + d] = -kk;
    wave_sync();
    const float* S0 = p.state_wkv + ((size_t)(n * 8 + h) * 64 + lane) * 64;
    float* S1 = p.wkv_s + ((size_t)(n * 8 + h) * 64 + lane) * 64;
    float sa = 0.f;
#pragma unroll 4
    for (int q = 0; q < 16; ++q) { const f32x4 s = *(const f32x4*)(S0 + 4 * q);
#pragma unroll
        for (int e = 0; e < 4; ++e) sa += s[e] * W[256 + 4 * q + e]; }
    float y = 0.f;
#pragma unroll 4
    for (int q = 0; q < 16; ++q) { const f32x4 s = *(const f32x4*)(S0 + 4 * q); f32x4 o;
#pragma unroll
        for (int e = 0; e < 4; ++e) { const int kx = 4 * q + e; o[e] = s[e] * W[kx] + sa * W[64 + kx] + v * W[128 + kx]; y += o[e] * W[192 + kx]; }
        *(f32x4*)(S1 + 4 * q) = o; }
    float s = y;
#pragma unroll
    for (int o = 1; o < 64; o <<= 1) s += __shfl_xor(s, o);
    const float mean = s * (1.f / 64.f); float q2 = (y - mean) * (y - mean);
#pragma unroll
    for (int o = 1; o < 64; o <<= 1) q2 += __shfl_xor(q2, o);
    const float rstd = 1.f / sqrtf(q2 * (1.f / 64.f) + 64e-5f);
    const float o = ((y - mean) * rstd * p.ln_w[hd] + p.ln_b[hd] + bon * v) * ag;
    p.mixin[(size_t)row * 1024 + 512 + hd] = (bf16_t)f2bf(o);
    wave_sync();
}

constexpr int MK_MP = 16384, MK_MS = 128, MK_MR = 16512, MK_MPAD = 16640, MK_D = 1024, MK_FF = 2816, MK_NPROJ = 3328;
constexpr float MK_EPS = 1e-6f;
constexpr float MK_C2 = 0.125f * 1.4426950408889634f;
constexpr float MK_LAM_INIT = 0.2f;

DEV void ldbf8(const bf16_t* p, float (&x)[8]) { const u32x4v w = *(const u32x4v*)p; const unsigned ww[4] = {w.x, w.y, w.z, w.w};
#pragma unroll
    for (int i = 0; i < 4; ++i) { x[2 * i] = bf2f(ww[i] & 0xffffu); x[2 * i + 1] = bf2f(ww[i] >> 16); } }
DEV void unbf8(u32x4v w, float (&x)[8]) { const unsigned ww[4] = {w.x, w.y, w.z, w.w};
#pragma unroll
    for (int i = 0; i < 4; ++i) { x[2 * i] = bf2f(ww[i] & 0xffffu); x[2 * i + 1] = bf2f(ww[i] >> 16); } }
DEV f32x4 ldbf4(const bf16_t* p) { const u32x2 w = *(const u32x2*)p; return (f32x4){bf2f(w.x & 0xffffu), bf2f(w.x >> 16), bf2f(w.y & 0xffffu), bf2f(w.y >> 16)}; }
#ifdef EMU
#define MK_NTLOAD(p_) (*(p_))
#else
#define MK_NTLOAD(p_) (*(p_))
#endif
#ifdef EMU
DEV float exp2f_(float x) { return exp2f(x); }
#else
DEV float exp2f_(float x) { return __builtin_amdgcn_exp2f(x); }
#endif
DEV float wsum64(float v) { int lane_ = threadIdx.x & 63; return wsum64d(v, lane_); }
DEV void ld_row(const float* row, int lane, f32x4 (&v)[4]) {
#pragma unroll
    for (int j = 0; j < 4; ++j) v[j] = *(const f32x4*)(row + 4 * lane + 256 * j);
}
DEV void st_row(float* row, int lane, const f32x4 (&v)[4]) {
#pragma unroll
    for (int j = 0; j < 4; ++j) *(f32x4*)(row + 4 * lane + 256 * j) = v[j];
}
DEV void st_row_bf16(bf16_t* row, int lane, const f32x4 (&v)[4]) {
#pragma unroll
    for (int j = 0; j < 4; ++j) { u32x2 w; w.x = pk2bf(v[j][0], v[j][1]); w.y = pk2bf(v[j][2], v[j][3]); *(u32x2*)(row + 4 * lane + 256 * j) = w; }
}
DEV void ld_row(const bf16_t* row, int lane, f32x4 (&v)[4]) {
#pragma unroll
    for (int j = 0; j < 4; ++j) v[j] = ldbf4(row + 4 * lane + 256 * j);
}
DEV void st_row(bf16_t* row, int lane, const f32x4 (&v)[4]) { st_row_bf16(row, lane, v); }
DEV float row_rstd(const f32x4 (&v)[4]) {
    float s = 0.f;
#pragma unroll
    for (int j = 0; j < 4; ++j) s += (v[j][0] * v[j][0] + v[j][1] * v[j][1]) + (v[j][2] * v[j][2] + v[j][3] * v[j][3]);
    return rsqf_(wsum64(s) * (1.f / 1024.f) + MK_EPS);
}
DEV void row_norm(const f32x4 (&v)[4], const float* g, int lane, f32x4 (&o)[4]) {
    const float rs = row_rstd(v);
#pragma unroll
    for (int j = 0; j < 4; ++j) { const f32x4 gg = *(const f32x4*)(g + 4 * lane + 256 * j); o[j] = v[j] * rs * gg; }
}
DEV const float* x_row(const float* xp, const float* xs, int r) { return r < MK_MP ? xp + (size_t)r * MK_D : xs + (size_t)(r - MK_MP) * MK_D; }

DEV void rowpass_A(const float* xp, const float* xs, const float* gpre, bf16_t* XN, int r, int lane) {
    f32x4 v[4], o[4];
    if (r >= MK_MR) {
#pragma unroll
        for (int j = 0; j < 4; ++j) o[j] = (f32x4){0.f, 0.f, 0.f, 0.f};
    } else { ld_row(x_row(xp, xs, r), lane, v); row_norm(v, gpre, lane, o); }
    st_row_bf16(XN + (size_t)r * MK_D, lane, o);
}
DEV void ld_rowF(const bf16_t* F, const float* FS, int r, int lane, f32x4 (&f)[4]) {
    if (r < MK_MP) {
#pragma unroll
        for (int j = 0; j < 4; ++j) f[j] = ldbf4(F + (size_t)r * MK_D + 4 * lane + 256 * j);
        return; }
    f32x4 t[4]; ld_row(FS + (size_t)(r - MK_MP) * MK_D, lane, f);
#pragma unroll
    for (int ks = 1; ks < 4; ++ks) { ld_row(FS + (size_t)(ks * MK_MS + r - MK_MP) * MK_D, lane, t);
#pragma unroll
        for (int j = 0; j < 4; ++j) f[j] = f[j] + t[j]; }
}
template <class RP> DEV void rowpass_B(const RP* resrow, const bf16_t* F, const float* FS, const float* gpost, float scale, bf16_t* HRES, const float* gpre, bf16_t* XN, int r, int lane) {
    f32x4 f[4], x[4], o[4];
    ld_rowF(F, FS, r, lane, f); ld_row(resrow, lane, x);
    row_norm(f, gpost, lane, o);
#pragma unroll
    for (int j = 0; j < 4; ++j) x[j] = x[j] + o[j] * scale;
    st_row(HRES + (size_t)r * MK_D, lane, x);
    row_norm(x, gpre, lane, o);
    st_row_bf16(XN + (size_t)r * MK_D, lane, o);
}
DEV void rowpass_D(const bf16_t* HRES, const bf16_t* F, const float* FS, const float* gpost, float* outrow, int r, int lane) {
    f32x4 f[4], x[4], o[4];
    ld_rowF(F, FS, r, lane, f); ld_row(HRES + (size_t)r * MK_D, lane, x);
    row_norm(f, gpost, lane, o);
#pragma unroll
    for (int j = 0; j < 4; ++j) x[j] = x[j] + o[j] * 0.5f;
    st_row(outrow, lane, x);
}

DEV void rowpass_A2(const float* xp, const float* xs, const float* gpre, bf16_t* XN, int r0, int r1, int lane) {
    f32x4 v0[4], v1[4], o[4];
    ld_row(x_row(xp, xs, r0), lane, v0); ld_row(x_row(xp, xs, r1), lane, v1);
    row_norm(v0, gpre, lane, o); st_row_bf16(XN + (size_t)r0 * MK_D, lane, o);
    row_norm(v1, gpre, lane, o); st_row_bf16(XN + (size_t)r1 * MK_D, lane, o);
}
DEV void rowpass_A4(const float* xp, const float* xs, const float* gpre, bf16_t* XN, int r0, int stride, int lane) {
    f32x4 v[4][4], o[4];
#pragma unroll
    for (int i = 0; i < 4; ++i) ld_row(x_row(xp, xs, r0 + i * stride), lane, v[i]);
#pragma unroll
    for (int i = 0; i < 4; ++i) { row_norm(v[i], gpre, lane, o); st_row_bf16(XN + (size_t)(r0 + i * stride) * MK_D, lane, o); }
}
template <class RP> DEV void rowpass_B2(const RP* res0, const RP* res1, const bf16_t* F, const float* FS, const float* gpost, float scale, bf16_t* HRES, const float* gpre, bf16_t* XN, int r0, int r1, int lane) {
    f32x4 f0[4], f1[4], x0[4], x1[4], o[4];
    ld_rowF(F, FS, r0, lane, f0); ld_row(res0, lane, x0); ld_rowF(F, FS, r1, lane, f1); ld_row(res1, lane, x1);
    row_norm(f0, gpost, lane, o);
#pragma unroll
    for (int j = 0; j < 4; ++j) x0[j] = x0[j] + o[j] * scale;
    row_norm(f1, gpost, lane, o);
#pragma unroll
    for (int j = 0; j < 4; ++j) x1[j] = x1[j] + o[j] * scale;
    st_row(HRES + (size_t)r0 * MK_D, lane, x0); st_row(HRES + (size_t)r1 * MK_D, lane, x1);
    row_norm(x0, gpre, lane, o); st_row_bf16(XN + (size_t)r0 * MK_D, lane, o);
    row_norm(x1, gpre, lane, o); st_row_bf16(XN + (size_t)r1 * MK_D, lane, o);
}
DEV void rowpass_D2(const bf16_t* HRES, const bf16_t* F, const float* FS, const float* gpost, float* out0, float* out1, int r0, int r1, int lane) {
    f32x4 f0[4], f1[4], x0[4], x1[4], o[4];
    ld_rowF(F, FS, r0, lane, f0); ld_row(HRES + (size_t)r0 * MK_D, lane, x0); ld_rowF(F, FS, r1, lane, f1); ld_row(HRES + (size_t)r1 * MK_D, lane, x1);
    row_norm(f0, gpost, lane, o);
#pragma unroll
    for (int j = 0; j < 4; ++j) x0[j] = x0[j] + o[j] * 0.5f;
    row_norm(f1, gpost, lane, o);
#pragma unroll
    for (int j = 0; j < 4; ++j) x1[j] = x1[j] + o[j] * 0.5f;
    st_row(out0, lane, x0); st_row(out1, lane, x1);
}

struct PostP {
    const bf16_t* proj; bf16_t *QB, *KB, *VB;
    float *k_p, *v_p, *k_s, *v_s, *shift_p, *shift_s;
    const float* ropetab;
    const float* mu; bf16_t* XL; bf16_t* XH;
};
DEV void rope_tab_entry(float* tab, int idx) { const int pos = idx >> 3, i = idx & 7; const float invf = expf(-(float)i * 0.125f * 13.122363377404328f); const float ang = (float)pos * invf; tab[pos * 16 + i] = cosf(ang); tab[pos * 16 + 8 + i] = sinf(ang); }
struct PwPre { u32x4v rx[4], rp[4]; };
DEV void post_win_rwkv_load(PwPre& o, const PostP& p, int r, int lane) {
    const bf16_t* row = p.proj + (size_t)r * MK_NPROJ; const bool hasprev = (r & 4095) != 0; const bf16_t* prow = row - MK_NPROJ;
#pragma unroll
    for (int i = 0; i < 4; ++i) { const int col = 8 * (lane + 64 * i);
        if (col < 1792) { o.rx[i] = *(const u32x4v*)(row + 1536 + col); o.rp[i] = hasprev ? *(const u32x4v*)(prow + 1536 + col) : (u32x4v){0u, 0u, 0u, 0u}; }
        else { o.rx[i] = (u32x4v){0u, 0u, 0u, 0u}; o.rp[i] = (u32x4v){0u, 0u, 0u, 0u}; } }
}
DEV void post_win_rwkv_core(const PwPre& in, const PostP& p, int r, int lane) {
#pragma unroll
    for (int i = 0; i < 4; ++i) {
        const int col = 8 * (lane + 64 * i);
        if (col < 1792) {
            float x[8], pv[8], xs[8]; unbf8(in.rx[i], x); unbf8(in.rp[i], pv);
            const f32x4 m0 = *(const f32x4*)(p.mu + col), m1 = *(const f32x4*)(p.mu + col + 4);
#pragma unroll
            for (int e = 0; e < 8; ++e) xs[e] = x[e] + (pv[e] - x[e]) * (e < 4 ? m0[e & 3] : m1[e & 3]);
            if (col < 1536) { const int s = col >> 9, cc = col & 511; bf16_t* dst = p.XH + ((size_t)r * 8 + (cc >> 6)) * 192 + s * 64 + (cc & 63);
                u32x4v w; w.x = pk2bf(xs[0], xs[1]); w.y = pk2bf(xs[2], xs[3]); w.z = pk2bf(xs[4], xs[5]); w.w = pk2bf(xs[6], xs[7]); *(u32x4v*)dst = w; }
            else { const int j = col - 1536; float y[8];
#pragma unroll
                for (int e = 0; e < 8; ++e) y[e] = j < 64 ? tanhf_(xs[e]) : (j < 128 ? xs[e] : sigmoidf_(xs[e]));
                u32x4v w; w.x = pk2bf(y[0], y[1]); w.y = pk2bf(y[2], y[3]); w.z = pk2bf(y[4], y[5]); w.w = pk2bf(y[6], y[7]); *(u32x4v*)(p.XL + (size_t)r * 256 + j) = w; }
        }
    }
}
DEV void post_win_row_rwkv(const PostP& p, int r, int lane) { if (r < MK_MP) { PwPre pre; post_win_rwkv_load(pre, p, r, lane); post_win_rwkv_core(pre, p, r, lane); } }
DEV void post_win_row(const PostP& p, int r, int lane) {
    const bf16_t* row = p.proj + (size_t)r * MK_NPROJ;
    const int pos = r < MK_MP ? (r & 4095) : 2048;
    const int i8 = lane & 7;
    float cs[8], sn[8];
    { const f32x4 c0 = *(const f32x4*)(p.ropetab + pos * 16), c1 = *(const f32x4*)(p.ropetab + pos * 16 + 4), s0 = *(const f32x4*)(p.ropetab + pos * 16 + 8), s1 = *(const f32x4*)(p.ropetab + pos * 16 + 12);
#pragma unroll
      for (int e = 0; e < 4; ++e) { cs[e] = c0[e]; cs[4 + e] = c1[e]; sn[e] = s0[e]; sn[4 + e] = s1[e]; } }
    float* kout = r < MK_MP ? p.k_p + (size_t)r * 512 : p.k_s + (size_t)(r - MK_MP) * 512;
    float* vout = r < MK_MP ? p.v_p + (size_t)r * 512 : p.v_s + (size_t)(r - MK_MP) * 512;
    u32x4v rqkv[3];
#pragma unroll
    for (int s = 0; s < 3; ++s) rqkv[s] = *(const u32x4v*)(row + s * 512 + lane * 8);
    PwPre pre; if (r < MK_MP) post_win_rwkv_load(pre, p, r, lane);
#pragma unroll
    for (int s = 0; s < 3; ++s) {
        float x[8]; unbf8(rqkv[s], x);
        if (s < 2) {
            float o[8];
#pragma unroll
            for (int e = 0; e < 8; ++e) { const float other = dpp_q1(x[e], lane); o[e] = i8 == 0 ? x[e] * cs[e] - other * sn[e] : (i8 == 1 ? x[e] * cs[e] + other * sn[e] : x[e]); }
#pragma unroll
            for (int e = 0; e < 8; ++e) x[e] = o[e];
        }
        if (s >= 1) { float* o = s == 1 ? kout : vout; *(f32x4*)(o + lane * 8) = (f32x4){x[0], x[1], x[2], x[3]}; *(f32x4*)(o + lane * 8 + 4) = (f32x4){x[4], x[5], x[6], x[7]}; }
        const float sc = s == 0 ? MK_C2 : 1.f;
        u32x4v w; w.x = pk2bf(x[0] * sc, x[1] * sc); w.y = pk2bf(x[2] * sc, x[3] * sc); w.z = pk2bf(x[4] * sc, x[5] * sc); w.w = pk2bf(x[6] * sc, x[7] * sc);
        bf16_t* dst = (s == 0 ? p.QB : (s == 1 ? p.KB : p.VB)) + (size_t)r * 512 + lane * 8;
        *(u32x4v*)dst = w;
    }
    float* sh = nullptr;
    if (r >= MK_MP) sh = p.shift_s + (size_t)(r - MK_MP) * 1792; else if ((r & 4095) == 4095) sh = p.shift_p + (size_t)(r >> 12) * 1792;
    if (sh) { for (int i = lane; i < 448; i += 64) *(f32x4*)(sh + 4 * i) = ldbf4(row + 1536 + 4 * i); }
    if (r < MK_MP) post_win_rwkv_core(pre, p, r, lane);
}

DEV void attn_combine_core(u32x4v w0, u32x4v w1, const float* subln, float lam, bf16_t* mixin, int r, int lane) {
    const unsigned ww[8] = {w0.x, w0.y, w0.z, w0.w, w1.x, w1.y, w1.z, w1.w};
    float x[16], y[16]; float ss = 0.f;
#pragma unroll
    for (int i = 0; i < 8; ++i) { x[2 * i] = bf2f(ww[i] & 0xffffu); x[2 * i + 1] = bf2f(ww[i] >> 16); }
#pragma unroll
    for (int i = 0; i < 16; ++i) { const float o = dpp_x8(x[i], lane); y[i] = x[i] - lam * o; ss += y[i] * y[i]; }
    ss += dpp_q1(ss, lane); ss += dpp_q2(ss, lane); ss += dpp_hm(ss, lane);
    const float rs = rsqf_(ss * (1.f / 128.f) + MK_EPS) * (1.f - MK_LAM_INIT);
    if ((lane & 8) == 0) {
        const int h = lane >> 4, half = (lane >> 2) & 1, e0 = half * 64 + (lane & 3) * 16;
        unsigned o[8];
#pragma unroll
        for (int i = 0; i < 8; ++i) o[i] = pk2bf(y[2 * i] * rs * subln[e0 + 2 * i], y[2 * i + 1] * rs * subln[e0 + 2 * i + 1]);
        bf16_t* dst = mixin + (size_t)r * 1024 + h * 128 + e0;
        *(u32x4v*)dst = (u32x4v){o[0], o[1], o[2], o[3]}; *(u32x4v*)(dst + 8) = (u32x4v){o[4], o[5], o[6], o[7]};
    }
}
DEV void attn_combine_row(const bf16_t* O16, const float* subln, float lam, bf16_t* mixin, int r, int lane) {
    const u32x4v w0 = *(const u32x4v*)(O16 + (size_t)r * 1024 + lane * 16), w1 = *(const u32x4v*)(O16 + (size_t)r * 1024 + lane * 16 + 8);
    attn_combine_core(w0, w1, subln, lam, mixin, r, lane);
}
template <int NR> DEV void attn_combine_rows(const bf16_t* O16, const float* subln, float lam, bf16_t* mixin, int r0, int stride, int lane) {
    u32x4v w0[NR], w1[NR];
#pragma unroll
    for (int i = 0; i < NR; ++i) { const bf16_t* p = O16 + (size_t)(r0 + i * stride) * 1024 + lane * 16; w0[i] = *(const u32x4v*)p; w1[i] = *(const u32x4v*)(p + 8); }
#pragma unroll
    for (int i = 0; i < NR; ++i) attn_combine_core(w0[i], w1[i], subln, lam, mixin, r0 + i * stride, lane);
}

struct DecP {
    const float *cache_k, *cache_v; const int* page_table;
    const bf16_t* QB;
    float *PM, *PL, *PO;
    const float *k_s, *v_s;
    const float* subln; bf16_t* mixin;
};
struct DecState { float m[2], l[2], o[2][8]; };
DEV void dec_token(DecState& S, const float (&q)[8], const f32x4& k0, const f32x4& k1, const f32x4& v0, const f32x4& v1, int lane) {
    float s = (q[0] * k0[0] + q[1] * k0[1]) + (q[2] * k0[2] + q[3] * k0[3]) + (q[4] * k1[0] + q[5] * k1[1]) + (q[6] * k1[2] + q[7] * k1[3]);
    s += dpp_q1(s, lane); s += dpp_q2(s, lane); s += dpp_hm(s, lane);
    const float so = dpp_rm(s, lane);
    const bool j1 = (lane & 8) != 0; const float sj[2] = {j1 ? so : s, j1 ? s : so};
    const float vv[8] = {v0[0], v0[1], v0[2], v0[3], v1[0], v1[1], v1[2], v1[3]};
#pragma unroll
    for (int j = 0; j < 2; ++j) {
        const float mn = fmaxf(S.m[j], sj[j]); const float al = exp2f_(S.m[j] - mn), pp = exp2f_(sj[j] - mn);
        S.m[j] = mn; S.l[j] = S.l[j] * al + pp;
#pragma unroll
        for (int e = 0; e < 8; ++e) S.o[j][e] = S.o[j][e] * al + pp * vv[e];
    }
}
template <int NB> DEV void dec_batch(DecState& S, const float (&q)[8], const f32x4 (&kk)[NB][2], const f32x4 (&vv)[NB][2], int lane) {
    float s0[NB], s1[NB];
    const bool j1 = (lane & 8) != 0;
#pragma unroll
    for (int i = 0; i < NB; ++i) {
        float s = (q[0] * kk[i][0][0] + q[1] * kk[i][0][1]) + (q[2] * kk[i][0][2] + q[3] * kk[i][0][3]) + (q[4] * kk[i][1][0] + q[5] * kk[i][1][1]) + (q[6] * kk[i][1][2] + q[7] * kk[i][1][3]);
        s += dpp_q1(s, lane); s += dpp_q2(s, lane); s += dpp_hm(s, lane);
        const float so = dpp_rm(s, lane);
        s0[i] = j1 ? so : s; s1[i] = j1 ? s : so;
    }
#pragma unroll
    for (int j = 0; j < 2; ++j) {
        float bm = j == 0 ? s0[0] : s1[0];
#pragma unroll
        for (int i = 1; i < NB; ++i) bm = fmaxf(bm, j == 0 ? s0[i] : s1[i]);
        const float mn = fmaxf(S.m[j], bm), al = exp2f_(S.m[j] - mn);
        S.m[j] = mn; float l = S.l[j] * al;
#pragma unroll
        for (int e = 0; e < 8; ++e) S.o[j][e] *= al;
#pragma unroll
        for (int i = 0; i < NB; ++i) { const float pp = exp2f_((j == 0 ? s0[i] : s1[i]) - mn); l += pp;
#pragma unroll
            for (int e = 0; e < 4; ++e) { S.o[j][e] += pp * vv[i][0][e]; S.o[j][4 + e] += pp * vv[i][1][e]; } }
        S.l[j] = l;
    }
}
struct DecState2 { float m[2][2], l[2][2], o[2][2][4]; };
template <int NB> DEV void dec_batch2(DecState2& S, const f32x4 (&qa), const f32x4 (&qb), const f32x4 (&kk)[NB][2], const f32x4 (&vv)[NB][2], int lane) {
    float s[2][2][NB];
    const bool j1 = (lane & 16) != 0;
#pragma unroll
    for (int i = 0; i < NB; ++i) {
        float sa = (qa[0] * kk[i][0][0] + qa[1] * kk[i][0][1]) + (qa[2] * kk[i][0][2] + qa[3] * kk[i][0][3]);
        float sb = (qb[0] * kk[i][1][0] + qb[1] * kk[i][1][1]) + (qb[2] * kk[i][1][2] + qb[3] * kk[i][1][3]);
        sa = rsum16(sa, lane); sb = rsum16(sb, lane);
        const float oa = __shfl_xor(sa, 16), ob = __shfl_xor(sb, 16);
        s[0][0][i] = j1 ? oa : sa; s[0][1][i] = j1 ? sa : oa; s[1][0][i] = j1 ? ob : sb; s[1][1][i] = j1 ? sb : ob;
    }
#pragma unroll
    for (int g = 0; g < 2; ++g)
#pragma unroll
        for (int j = 0; j < 2; ++j) {
            float bm = s[g][j][0];
#pragma unroll
            for (int i = 1; i < NB; ++i) bm = fmaxf(bm, s[g][j][i]);
            const float mn = fmaxf(S.m[g][j], bm), al = exp2f_(S.m[g][j] - mn);
            S.m[g][j] = mn; float l = S.l[g][j] * al;
#pragma unroll
            for (int e = 0; e < 4; ++e) S.o[g][j][e] *= al;
#pragma unroll
            for (int i = 0; i < NB; ++i) { const float pp = exp2f_(s[g][j][i] - mn); l += pp;
#pragma unroll
                for (int e = 0; e < 4; ++e) S.o[g][j][e] += pp * vv[i][g][e]; }
            S.l[g][j] = l;
        }
}
DEV void decode_unit(const DecP& p, int n, int part, RW_LAS unsigned char* lds) {
    const int half = part >> 1, tb = (part & 1) * 64;
    const int tid = threadIdx.x, lane = tid & 63, wid = tid >> 6;
    RW_LAS float* LM = (RW_LAS float*)lds; RW_LAS float* LL = LM + 64; RW_LAS float* LO = LM + 128;
    const int page = p.page_table[n * 16 + half * 8 + wid];
    const float* kp = p.cache_k + (size_t)page * 65536 + lane * 4; const float* vp = p.cache_v + (size_t)page * 65536 + lane * 4;
    f32x4 qa, qb;
    { const bf16_t* qrow = p.QB + (size_t)(MK_MP + n) * 512; qa = ldbf4(qrow + 4 * lane); qb = ldbf4(qrow + 256 + 4 * lane); }
    DecState2 S;
#pragma unroll
    for (int g = 0; g < 2; ++g)
#pragma unroll
        for (int j = 0; j < 2; ++j) { S.m[g][j] = -1e30f; S.l[g][j] = 0.f;
#pragma unroll
            for (int e = 0; e < 4; ++e) S.o[g][j][e] = 0.f; }
#pragma unroll 1
    for (int t0 = tb; t0 < tb + 64; t0 += 8) {
        f32x4 kk[8][2], vv[8][2];
#pragma unroll
        for (int i = 0; i < 8; ++i) { kk[i][0] = *(const f32x4*)(kp + (size_t)(t0 + i) * 512); kk[i][1] = *(const f32x4*)(kp + (size_t)(t0 + i) * 512 + 256);
                                      vv[i][0] = *(const f32x4*)(vp + (size_t)(t0 + i) * 512); vv[i][1] = *(const f32x4*)(vp + (size_t)(t0 + i) * 512 + 256); }
        dec_batch2<8>(S, qa, qb, kk, vv, lane);
    }
    if ((lane & 31) == 0) { const int ha = lane >> 5;
#pragma unroll
        for (int j = 0; j < 2; ++j) { LM[wid * 8 + ha * 2 + j] = S.m[0][j]; LL[wid * 8 + ha * 2 + j] = S.l[0][j]; LM[wid * 8 + (2 + ha) * 2 + j] = S.m[1][j]; LL[wid * 8 + (2 + ha) * 2 + j] = S.l[1][j]; } }
#pragma unroll
    for (int j = 0; j < 2; ++j) { *(RW_LAS f32x4*)(LO + (wid * 2 + j) * 512 + 4 * lane) = (f32x4){S.o[0][j][0], S.o[0][j][1], S.o[0][j][2], S.o[0][j][3]};
                                  *(RW_LAS f32x4*)(LO + (wid * 2 + j) * 512 + 256 + 4 * lane) = (f32x4){S.o[1][j][0], S.o[1][j][1], S.o[1][j][2], S.o[1][j][3]}; }
    __syncthreads();
    if (tid < 128) {
        const int j = tid >> 6, ll = tid & 63, h = ll >> 4, hj = h * 2 + j;
        float M = -1e30f;
#pragma unroll
        for (int w = 0; w < 8; ++w) M = fmaxf(M, LM[w * 8 + hj]);
        float l = 0.f, o[8] = {0.f, 0.f, 0.f, 0.f, 0.f, 0.f, 0.f, 0.f};
#pragma unroll
        for (int w = 0; w < 8; ++w) { const float f = exp2f_(LM[w * 8 + hj] - M); l += LL[w * 8 + hj] * f;
#pragma unroll
            for (int e = 0; e < 8; ++e) o[e] += LO[(w * 2 + j) * 512 + ll * 8 + e] * f; }
        float* po = p.PO + ((size_t)(n * 4 + part) * 2 + j) * 512 + ll * 8;
        *(f32x4*)po = (f32x4){o[0], o[1], o[2], o[3]}; *(f32x4*)(po + 4) = (f32x4){o[4], o[5], o[6], o[7]};
        if ((ll & 15) == 0) { p.PM[(n * 4 + part) * 8 + hj] = M; p.PL[(n * 4 + part) * 8 + hj] = l; }
    }
    __syncthreads();
}
DEV void decode_final(const DecP& p, int n, float lam, int lane) {
    const int h = lane >> 4;
    float q[8];
    { const u32x4v w = *(const u32x4v*)(p.QB + (size_t)(MK_MP + n) * 512 + lane * 8); const unsigned ww[4] = {w.x, w.y, w.z, w.w};
#pragma unroll
      for (int i = 0; i < 4; ++i) { q[2 * i] = bf2f(ww[i] & 0xffffu); q[2 * i + 1] = bf2f(ww[i] >> 16); } }
    DecState S;
#pragma unroll
    for (int j = 0; j < 2; ++j) {
        const int hj = h * 2 + j; float mm[4], M = -1e30f;
#pragma unroll
        for (int pt = 0; pt < 4; ++pt) { mm[pt] = p.PM[(n * 4 + pt) * 8 + hj]; M = fmaxf(M, mm[pt]); }
        S.m[j] = M; S.l[j] = 0.f;
#pragma unroll
        for (int e = 0; e < 8; ++e) S.o[j][e] = 0.f;
#pragma unroll
        for (int pt = 0; pt < 4; ++pt) { const float f = exp2f_(mm[pt] - M); S.l[j] += p.PL[(n * 4 + pt) * 8 + hj] * f;
            const float* op = p.PO + ((size_t)(n * 4 + pt) * 2 + j) * 512 + lane * 8;
#pragma unroll
            for (int e = 0; e < 8; ++e) S.o[j][e] += op[e] * f; }
    }
    const float* kc = p.k_s + (size_t)n * 512 + lane * 8; const float* vc = p.v_s + (size_t)n * 512 + lane * 8;
    dec_token(S, q, *(const f32x4*)kc, *(const f32x4*)(kc + 4), *(const f32x4*)vc, *(const f32x4*)(vc + 4), lane);
    float y[8]; float ss = 0.f;
#pragma unroll
    for (int e = 0; e < 8; ++e) { y[e] = S.o[0][e] / S.l[0] - lam * (S.o[1][e] / S.l[1]); ss += y[e] * y[e]; }
    ss = rsum16(ss, lane);
    const float rs = 1.f / sqrtf(ss * (1.f / 128.f) + MK_EPS) * (1.f - MK_LAM_INIT);
    const int e0 = (lane & 15) * 8;
    u32x4v w; w.x = pk2bf(y[0] * rs * p.subln[e0], y[1] * rs * p.subln[e0 + 1]); w.y = pk2bf(y[2] * rs * p.subln[e0 + 2], y[3] * rs * p.subln[e0 + 3]);
    w.z = pk2bf(y[4] * rs * p.subln[e0 + 4], y[5] * rs * p.subln[e0 + 5]); w.w = pk2bf(y[6] * rs * p.subln[e0 + 6], y[7] * rs * p.subln[e0 + 7]);
    *(u32x4v*)(p.mixin + (size_t)(MK_MP + n) * 1024 + h * 128 + e0) = w;
}
DEV float compute_lam(const float* q1, const float* k1, const float* q2, const float* k2, int lane) {
    const float a = wsum64(q1[lane] * k1[lane]), b = wsum64(q2[lane] * k2[lane]);
    return __expf(a) - __expf(b) + MK_LAM_INIT;
}

DEV void skinny_item(const bf16_t* A, const bf16_t* Wt, int K, float* FS, int item, int wid, int lane) {
    const int cgp = item >> 2, ks = item & 3, kq = K >> 2;
    const bf16_t* ap = A + (size_t)(16 * wid + (lane & 15)) * K + ks * kq + 8 * (lane >> 4);
    const bf16_t* bp = Wt + (size_t)(16 * cgp + (lane & 15)) * K + ks * kq + 8 * (lane >> 4);
    f32x4 acc = {0.f, 0.f, 0.f, 0.f};
#pragma unroll 8
    for (int k0 = 0; k0 < kq; k0 += 32) { const bf16x8 a = *(const bf16x8*)(ap + k0), b = *(const bf16x8*)(bp + k0); acc = mfma16(b, a, acc); }
    *(f32x4*)(FS + (size_t)(ks * MK_MS + 16 * wid + (lane & 15)) * MK_D + 16 * cgp + 4 * (lane >> 4)) = acc;
}

DEV void transpose_item64(const float* W, int N, int K, bf16_t* WT, int k0, int n0, int dst_row0, RW_LAS float* scr, int lane) {
#pragma unroll 4
    for (int i = 0; i < 16; ++i) { const int kk = 4 * i + (lane >> 4); const f32x4 v = *(const f32x4*)(W + (size_t)(k0 + kk) * N + n0 + 4 * (lane & 15));
        RW_LAS float* d = scr + kk * 65 + 4 * (lane & 15); d[0] = v[0]; d[1] = v[1]; d[2] = v[2]; d[3] = v[3]; }
    wave_sync();
    const int c = lane & 7;
#pragma unroll
    for (int j = 0; j < 8; ++j) { const int n = (lane >> 3) + 8 * j; const RW_LAS float* s = scr + (8 * c) * 65 + n;
        u32x4v o; o.x = pk2bf(s[0 * 65], s[1 * 65]); o.y = pk2bf(s[2 * 65], s[3 * 65]); o.z = pk2bf(s[4 * 65], s[5 * 65]); o.w = pk2bf(s[6 * 65], s[7 * 65]);
        *(u32x4v*)(WT + (size_t)(dst_row0 + n) * K + k0 + 8 * c) = o; }
    wave_sync();
}

#define GAS __attribute__((address_space(1)))
#define LAS __attribute__((address_space(3)))
typedef unsigned short bf16;
typedef unsigned v4u __attribute__((ext_vector_type(4)));
typedef float f32x4 __attribute__((ext_vector_type(4)));
typedef short bf16x8 __attribute__((ext_vector_type(8)));
typedef GAS unsigned gu32;
typedef GAS unsigned long long gu64;
#define RLX_AGENT __ATOMIC_RELAXED, __HIP_MEMORY_SCOPE_AGENT
#define LDS_WAIT() asm volatile("s_waitcnt lgkmcnt(0)" ::: "memory")
#define VM_WAIT() asm volatile("s_waitcnt vmcnt(0)" ::: "memory")
__device__ __forceinline__ unsigned long long rt() { return __builtin_amdgcn_s_memrealtime(); }
__device__ __forceinline__ unsigned pk2(float lo, float hi) { return f2bf(lo) | (f2bf(hi) << 16); }

#define XB_TMO      128
#define XB_XCNT(j)  (256  + 64 * (j))
#define XB_XSUB(j)  (1280 + 64 * (j))
#define XB_XGEN(j)  (2304 + 64 * (j))
#define XB_TOP      3328
#define XB_TOPGEN   3392
#define XCD_BAR_WORDS 3456
#define XB_SPIN_CAP (1u << 18)

__device__ __forceinline__ unsigned xb_ld(unsigned* p)              { return __hip_atomic_load(p, __ATOMIC_RELAXED, __HIP_MEMORY_SCOPE_AGENT); }
__device__ __forceinline__ unsigned xb_add(unsigned* p, unsigned v) { return __hip_atomic_fetch_add(p, v, __ATOMIC_RELAXED, __HIP_MEMORY_SCOPE_AGENT); }
__device__ __forceinline__ unsigned xb_xcc_id() { return (unsigned)__builtin_amdgcn_s_getreg((3 << 11) | 20) & 0xFu; }
#define XB_SPIN(cond, bar) do { unsigned _sp = 0; while (cond) { __builtin_amdgcn_s_sleep(1); \
    if ((++_sp & 255u) == 0u) { if (xb_ld(&(bar)[XB_TMO])) break; if (_sp > XB_SPIN_CAP) { atomicAdd(&(bar)[XB_TMO], 1u); break; } } } } while (0)

struct XcdBarrier {
    unsigned* bar; unsigned x;
    volatile LAS unsigned* st;
};

__device__ __forceinline__ XcdBarrier xcd_barrier_post(unsigned* bar, volatile LAS unsigned* st) {
    XcdBarrier b; b.bar = bar; b.x = xb_xcc_id(); b.st = st;
    if (threadIdx.x == 0) (void)xb_add(&bar[XB_XCNT(b.x)], 1u);
    return b;
}
__device__ __forceinline__ void xcd_barrier_complete(unsigned* bar, unsigned x, unsigned& nloc, unsigned& nx) {
    const unsigned G = gridDim.x * gridDim.y * gridDim.z;
    unsigned sum, cnt, mine, sp = 0u;
    for (;;) {
        sum = 0u; cnt = 0u; mine = 0u;
#pragma unroll
        for (unsigned j = 0; j < 16; ++j) { const unsigned c = xb_ld(&bar[XB_XCNT(j)]); sum += c; cnt += (c > 0u) ? 1u : 0u; mine = (j == x) ? c : mine; }
        if (sum == G) break;
        __builtin_amdgcn_s_sleep(1);
        if ((++sp & 255u) == 0u) { if (xb_ld(&bar[XB_TMO])) break; if (sp > XB_SPIN_CAP) { atomicAdd(&bar[XB_TMO], 1u); break; } }
    }
    nloc = mine > 0u ? mine : 1u; nx = cnt > 0u ? cnt : 1u;
}

__device__ __forceinline__ void xcd_barrier(const XcdBarrier& b) {
    asm volatile("s_waitcnt vmcnt(0)" ::: "memory");
    __syncthreads();
    if (threadIdx.x == 0) {
        unsigned* bar = b.bar;
        __builtin_amdgcn_s_waitcnt(0);
        unsigned nloc = b.st[0], nx = b.st[1];
        if (nloc == 0u) { xcd_barrier_complete(bar, b.x, nloc, nx); b.st[0] = nloc; b.st[1] = nx; }
        const unsigned old = xb_add(&bar[XB_XSUB(b.x)], 1u);
        const unsigned gen = old / nloc;
        if (old + 1u == (gen + 1u) * nloc) {
            __builtin_amdgcn_fence(__ATOMIC_RELEASE, "agent");
            asm volatile("s_waitcnt vmcnt(0)" ::: "memory");
            const unsigned og = xb_add(&bar[XB_TOP], 1u);
            const unsigned tg = og / nx;
            if (og + 1u == (tg + 1u) * nx) xb_add(&bar[XB_TOPGEN], 1u);
            else XB_SPIN(xb_ld(&bar[XB_TOPGEN]) == tg, bar);
            __builtin_amdgcn_fence(__ATOMIC_ACQUIRE, "agent");
            xb_add(&bar[XB_XGEN(b.x)], 1u);
            asm volatile("s_waitcnt vmcnt(0)" ::: "memory");
        } else {
            XB_SPIN(xb_ld(&bar[XB_XGEN(b.x)]) == gen, bar);
            __builtin_amdgcn_fence(__ATOMIC_ACQUIRE, "agent");
            asm volatile("s_waitcnt vmcnt(0)" ::: "memory");
        }
    }
    __syncthreads();
}

constexpr int NWAVES = 8;
#ifndef MK_NDX
#define MK_NDX 12
#endif
#ifndef MK_N_LAUNCHES
#define MK_N_LAUNCHES 1
#endif
constexpr int N_PHASES = 13;
constexpr size_t MiB = 1u << 20;
constexpr size_t WS_CTL = 0, CTL_ZERO_BYTES = 1 * MiB;
constexpr size_t WS_WGU1 = 1 * MiB, WS_WD1 = 13 * MiB, WS_WIN = 19 * MiB, WS_WOUT = 26 * MiB, WS_WGU2 = 28 * MiB, WS_WD2 = 40 * MiB, WS_W2T = 46 * MiB, WS_A2T = WS_W2T + 65536, WS_G2T = WS_A2T + 65536;
constexpr size_t WS_XN = 47 * MiB;
constexpr size_t WS_H = 80 * MiB;
constexpr size_t WS_F = 170 * MiB;
constexpr size_t WS_HRES = 235 * MiB;
constexpr size_t WS_PROJ = 300 * MiB;
constexpr size_t WS_QB = 512 * MiB, WS_KB = 529 * MiB, WS_VB = 546 * MiB;
constexpr size_t WS_O16 = 563 * MiB;
constexpr size_t WS_MIXIN = 595 * MiB;
constexpr size_t WS_MT = 628 * MiB, WS_NN = 644 * MiB, WS_QQ = 676 * MiB, WS_Y0 = 692 * MiB, WS_SC = 724 * MiB, WS_VG = 740 * MiB, WS_GG = 756 * MiB, WS_BON = 772 * MiB;
constexpr size_t WS_PM = 773 * MiB, WS_PL = WS_PM + 65536, WS_PO = 774 * MiB, WS_FS = 776 * MiB  , WS_ROPE = 778 * MiB  , WS_XL = 779 * MiB  , WS_XH = 787 * MiB  , WS_END = 883 * MiB;
constexpr int CW_TMO = 0, CW_CODE = 1, CW_QA = 2048, CW_QD = 2112, CW_BAR = 4096;
constexpr int RING_OFF = 0, RING_BYTES = 147456;
constexpr int LDSCTL_OFF = RING_BYTES, MISC_OFF = LDSCTL_OFF + 320;
constexpr int LDS_BYTES = 151552;

struct Args { const float* in[37]; float* out; unsigned char* ws; int ph_lo, ph_hi, li, pad; };

__device__ __forceinline__ void p0_transpose_item(const float* W, int K, int N, bf16* WT, int k0, int n0, int dst_row0, LAS float* scr, int lane) {
#pragma unroll 8
    for (int i = 0; i < 32; ++i) { const int kk = 2 * i + (lane >> 5); scr[kk * 33 + (lane & 31)] = W[(size_t)(k0 + kk) * N + n0 + (lane & 31)]; }
    LDS_WAIT(); asm volatile("" ::: "memory");
    const int c = lane & 7;
#pragma unroll
    for (int j = 0; j < 4; ++j) { const int n = (lane >> 3) + 8 * j; const LAS float* s = scr + (8 * c) * 33 + n;
        v4u o; o.x = pk2(s[0 * 33], s[1 * 33]); o.y = pk2(s[2 * 33], s[3 * 33]); o.z = pk2(s[4 * 33], s[5 * 33]); o.w = pk2(s[6 * 33], s[7 * 33]);
        *(GAS v4u*)(WT + (size_t)(dst_row0 + n) * K + k0 + 8 * c) = o; }
    LDS_WAIT(); asm volatile("" ::: "memory");
}

__global__ void __launch_bounds__(NWAVES * 64, 2) mk_fwd(Args args) {
    extern __shared__ __attribute__((aligned(16))) unsigned char lds[];
    LAS unsigned char* ldsl = (LAS unsigned char*)lds;
    volatile LAS unsigned* MISC = (volatile LAS unsigned*)(ldsl + MISC_OFF);
    constexpr int G = 256, NGW = G * NWAVES;
#define PH_LOCALS int tid = threadIdx.x; asm volatile("" : "+v"(tid)); const int lane = tid & 63; const int wave = __builtin_amdgcn_readfirstlane(tid >> 6); \
    int bx = blockIdx.x; asm volatile("" : "+s"(bx)); const int vcu = (bx & 7) * 32 + (bx >> 3); const int gw = vcu * NWAVES + wave; (void)lane; (void)gw; (void)vcu;
    gu32* ctl = (gu32*)(args.ws + WS_CTL);
    for (int u = threadIdx.x; u < (LDS_BYTES - LDSCTL_OFF) / 4; u += NWAVES * 64) ((LAS unsigned*)(ldsl + LDSCTL_OFF))[u] = 0u;
    __syncthreads();
    XcdBarrier bar = xcd_barrier_post((unsigned*)(ctl + CW_BAR) + args.li * XCD_BAR_WORDS, MISC + 8);
#if MK_N_LAUNCHES == 1
    constexpr int lo = 0, hi = N_PHASES;
#else
    const int lo = args.ph_lo, hi = args.ph_hi;
#endif
#ifndef PH_MASK
#define PH_MASK 0x1fff
#endif
#define IN(k) (((PH_MASK >> (k)) & 1) && lo <= (k) && (k) < hi)
#if defined(PROBE_A)
#define STAMP(k) do { if (threadIdx.x == 0) *(volatile LAS unsigned long long*)(ldsl + LDSCTL_OFF + 1024 + 8 * (k)) = __builtin_amdgcn_s_memrealtime(); } while (0)
#else
#define STAMP(k) do { } while (0)
#endif
#define SEAM(k) do { if (IN(k) && IN((k) + 1)) xcd_barrier(bar); STAMP((k) + 1); } while (0)
    STAMP(0);
#define INP(i) (args.in[i])
#define WSB(off) ((bf16*)(args.ws + (off)))
#define WSF(off) ((float*)(args.ws + (off)))
#define x_p INP(0)
#define x_s INP(1)
#define subln INP(20)
#define XN WSB(WS_XN)
#define HB WSB(WS_H)
#define Fb WSB(WS_F)
#define HRES WSB(WS_HRES)
#define PROJ WSB(WS_PROJ)
#define QB WSB(WS_QB)
#define KB WSB(WS_KB)
#define VB WSB(WS_VB)
#define O16 WSB(WS_O16)
#define MIXIN WSB(WS_MIXIN)
#define FSb WSF(WS_FS)
#define o_yp (args.out)
#define o_ys (args.out + 16777216)
#define o_kp (args.out + 16908288)
#define o_vp (args.out + 25296896)
#define o_wkvp (args.out + 33685504)
#define o_shp (args.out + 33816576)
#define o_ks (args.out + 33823744)
#define o_vs (args.out + 33889280)
#define o_wkvs (args.out + 33954816)
#define o_shs (args.out + 38149120)
#define MAKE_RP() RwkvP rp; rp.proj = PROJ; rp.mu = INP(21); rp.w0 = INP(22); rp.w2 = INP(23); rp.a0 = INP(24); rp.a2 = INP(25); rp.g2 = INP(26); rp.k_k = INP(27); rp.k_a = INP(28); rp.r_k = INP(29); \
    rp.ln_w = INP(30); rp.ln_b = INP(31); rp.w2t = WSB(WS_W2T); rp.a2t = WSB(WS_A2T); rp.g2t = WSB(WS_G2T); rp.state_wkv = INP(4); rp.state_shift = INP(5); \
    rp.MT = WSB(WS_MT); rp.NN = WSF(WS_NN); rp.QQ = WSB(WS_QQ); rp.Y0 = WSF(WS_Y0); rp.SC = WSB(WS_SC); rp.VG = WSB(WS_VG); rp.GG = WSB(WS_GG); \
    rp.BON = WSF(WS_BON); rp.mixin = MIXIN; rp.wkv_p = o_wkvp; rp.wkv_s = o_wkvs; rp.XL = WSB(WS_XL); rp.XH = WSB(WS_XH);
#define MAKE_DP() DecP dp{INP(2), INP(3), (const int*)INP(6), QB, WSF(WS_PM), WSF(WS_PL), WSF(WS_PO), o_ks, o_vs, subln, MIXIN};
#define CONVERT_ITEM(id_) do { int r = (id_); \
        if (r < 2816) { const int which = r / 704; r -= which * 704; const int kb = r / 44, nb = r % 44, n0 = 64 * nb; \
            const float* W = which == 0 ? INP(9) : (which == 1 ? INP(10) : (which == 2 ? INP(34) : INP(35))); bf16* WT = which < 2 ? WSB(WS_WGU1) : WSB(WS_WGU2); \
            transpose_item64(W, 2816, 1024, WT, 64 * kb, n0, (n0 >> 7) * 256 + (which & 1) * 128 + (n0 & 127), scr, lane); } \
        else if (r < 4224) { r -= 2816; const int which = r / 704; r -= which * 704; const int kb = r / 16, nb = r % 16; \
            transpose_item64(which == 0 ? INP(11) : INP(36), 1024, 2816, which == 0 ? WSB(WS_WD1) : WSB(WS_WD2), 64 * kb, 64 * nb, 64 * nb, scr, lane); } \
        else if (r < 5056) { r -= 4224; const int kb = r / 52, nb = r % 52; transpose_item64(INP(14), 3328, 1024, WSB(WS_WIN), 64 * kb, 64 * nb, 64 * nb, scr, lane); } \
        else if (r < 5312) { r -= 5056; const int kb = r / 16, nb = r % 16; transpose_item64(INP(15), 1024, 1024, WSB(WS_WOUT), 64 * kb, 64 * nb, 64 * nb, scr, lane); } \
        else if (r < 5320) { r -= 5312; transpose_item64(INP(23), 512, 64, WSB(WS_W2T), 0, 64 * r, 64 * r, scr, lane); } \
        else if (r < 5328) { r -= 5320; transpose_item64(INP(25), 512, 64, WSB(WS_A2T), 0, 64 * r, 64 * r, scr, lane); } \
        else { r -= 5328; const int kb = r / 8, nb = r % 8; transpose_item64(INP(26), 512, 128, WSB(WS_G2T), 64 * kb, 64 * nb, 64 * nb, scr, lane); } } while (0)
    if (IN(0)) { PH_LOCALS
        LAS float* scr = (LAS float*)(ldsl + RING_OFF + wave * 16896);
        for (int it = gw; it < 2976; it += NGW) { const int id = it < 1408 ? it : (it < 2112 ? it + 1408 : (it < 2944 ? it + 2112 : it + 2368)); CONVERT_ITEM(id); }
        { int r = gw; for (; r + NGW < MK_MR; r += 2 * NGW) rowpass_A2(x_p, x_s, INP(7), XN, r, r + NGW, lane);
          for (; r < MK_MPAD; r += NGW) rowpass_A(x_p, x_s, INP(7), XN, r, lane); }
        { const int idx = gw * 64 + lane; if (idx < 4096 * 8) rope_tab_entry(WSF(WS_ROPE), idx); }
    }
    SEAM(0);
    if (IN(1)) { PH_LOCALS pg8::Gemm g{XN, WSB(WS_WGU1), MK_MPAD, 5632, 1024}; pg8::StaticOrder S; S.init(MK_MPAD, 5632, G, bx); pg8::EpiSwiGLU E{HB, MK_FF};
        pg8::gemm_phase<pg8::EpiSwiGLU, pg8::StaticOrder, true, true>(ldsl + RING_OFF, g, S, E);
        if (bx >= 150) { LAS float* scr = (LAS float*)(ldsl + RING_OFF + wave * 16896);
            for (int it = (bx - 150) * NWAVES + wave; it < 960; it += 106 * NWAVES) { const int id = it < 704 ? it + 3520 : it + 4352; CONVERT_ITEM(id); } }
    }
    SEAM(1);
    if (IN(2)) { PH_LOCALS skinny_item(HB + (size_t)MK_MP * MK_FF, WSB(WS_WD1), MK_FF, FSb, vcu, wave, lane);
        pg8::Gemm g{HB, WSB(WS_WD1), MK_MP, 1024, MK_FF}; pg8::StaticOrder S; S.init(MK_MP, 1024, G, bx); pg8::EpiBf16P E{Fb, 1024};
        pg8::gemm_phase<pg8::EpiBf16P, pg8::StaticOrder, true, true>(ldsl + RING_OFF, g, S, E); }
    SEAM(2);
    if (IN(3)) { PH_LOCALS int r = gw;
        for (; r + NGW < MK_MR; r += 2 * NGW) rowpass_B2(x_row(x_p, x_s, r), x_row(x_p, x_s, r + NGW), Fb, FSb, INP(8), 0.5f, HRES, INP(12), XN, r, r + NGW, lane);
        for (; r < MK_MR; r += NGW) rowpass_B(x_row(x_p, x_s, r), Fb, FSb, INP(8), 0.5f, HRES, INP(12), XN, r, lane); }
    SEAM(3);
    if (IN(4)) { PH_LOCALS pg8::Gemm g{XN, WSB(WS_WIN), MK_MPAD, MK_NPROJ, 1024}; pg8::StaticOrder S; S.init(MK_MPAD, MK_NPROJ, G, bx); pg8::EpiBf16P E{PROJ, MK_NPROJ};
        pg8::gemm_phase<pg8::EpiBf16P, pg8::StaticOrder, true, true>(ldsl + RING_OFF, g, S, E);
        if (bx >= 77) { LAS float* scr = (LAS float*)(ldsl + RING_OFF + wave * 16896);
            for (int it = (bx - 77) * NWAVES + wave; it < 1408; it += 179 * NWAVES) CONVERT_ITEM(it + 1408); }
    }
    SEAM(4);
    if (IN(5)) { PH_LOCALS
        PostP pp{PROJ, QB, KB, VB, o_kp, o_vp, o_ks, o_vs, o_shp, o_shs, WSF(WS_ROPE), INP(21), WSB(WS_XL), WSB(WS_XH)}; MAKE_RP()
        for (int r = gw; r < MK_MR; r += NGW) post_win_row(pp, r, lane);
        if (wave < 4) { const int su = bx * 4 + wave; if (su < 1024) rwkv_sample(rp, su >> 3, su & 7, ldsl + wave * 4096, lane); }
        STAMP(16);
        xcd_barrier(bar);
        STAMP(17);
        { RwkvGrp gs; for (int i = 0; i < 8; ++i) { const int u = vcu * 8 + i; rwkv_passA(rp, u >> 9, (u >> 6) & 7, u & 63, ldsl, gs, i == 0, i == 7); } }
    }
    SEAM(5);
    if (IN(6)) { PH_LOCALS
        MAKE_RP()
        if ((bx >> 3) < 16 && wave == 0) { const int id = (bx & 7) * 16 + (bx >> 3); rwkv_passB(rp, (id >> 2) >> 3, (id >> 2) & 7, id & 3, ldsl, lane); }
        __syncthreads(); STAMP(14);
        {
            MAKE_DP()
            const attn_body::bf16* aQ = (const attn_body::bf16*)QB; const attn_body::bf16* aK = (const attn_body::bf16*)KB; const attn_body::bf16* aV = (const attn_body::bf16*)VB; attn_body::bf16* aO = (attn_body::bf16*)O16;
            volatile LAS int* qw = (volatile LAS int*)(ldsl + LDSCTL_OFF + 64);
            gu32* qa = ctl + CW_QA; gu32* qd = ctl + CW_QD;
            const bool dec_first = (bx >> 3) >= 32 - MK_NDX;
            bool a_done = false, d_done = false;
            for (;;) {
                if (tid == 0) {
                    int code = -1;
                    for (int pass = 0; pass < 2 && code < 0; ++pass) {
                        const bool want_dec = (pass == 0) == dec_first;
                        if (want_dec) { if (!d_done) { const unsigned j = __hip_atomic_fetch_add(qd, 1u, RLX_AGENT); if (j < 512u) code = 0x10000 | (int)j; else d_done = true; } }
                        else { if (!a_done) { const unsigned i = __hip_atomic_fetch_add(qa, 1u, RLX_AGENT); if (i < 1024u) code = (int)i; else a_done = true; } }
                    }
                    *qw = code;
                }
                __syncthreads();
                const int code = __builtin_amdgcn_readfirstlane(*qw);
                __syncthreads();
                if (code < 0) break;
                if (code & 0x10000) decode_unit(dp, (code & 0xffff) >> 2, code & 3, ldsl);
                else attn_body::attn_unit<8>((code & 63) >> 4, code & 15, 15 - (code >> 6), aQ, aK, aV, aO, (char*)lds + RING_OFF);
            }
        }
        STAMP(15);
    }
    SEAM(6);
    if (IN(7)) { PH_LOCALS
        MAKE_RP()
        const float lam = compute_lam(INP(16), INP(17), INP(18), INP(19), lane);
        { const int u = vcu * 8 + wave; if (u < 2048) rwkv_passC(rp, u >> 9, (u >> 6) & 7, u & 63, lane); }
        attn_combine_rows<4>(O16, subln, lam, MIXIN, gw, NGW, lane); attn_combine_rows<4>(O16, subln, lam, MIXIN, gw + 4 * NGW, NGW, lane);
        MAKE_DP()
        if (gw < 128) decode_final(dp, gw, lam, lane);
        else if (gw < 256) { bf16* z = MIXIN + (size_t)(MK_MR + gw - 128) * 1024 + lane * 16; *(v4u*)z = (v4u){0u, 0u, 0u, 0u}; *(v4u*)(z + 8) = (v4u){0u, 0u, 0u, 0u}; }
    }
    SEAM(7);
    if (IN(8)) { PH_LOCALS skinny_item(MIXIN + (size_t)MK_MP * 1024, WSB(WS_WOUT), 1024, FSb, vcu, wave, lane);
        pg8::Gemm g{MIXIN, WSB(WS_WOUT), MK_MP, 1024, 1024}; pg8::StaticOrder S; S.init(MK_MP, 1024, G, bx); pg8::EpiBf16P E{Fb, 1024};
        pg8::gemm_phase<pg8::EpiBf16P, pg8::StaticOrder, true, true>(ldsl + RING_OFF, g, S, E); }
    SEAM(8);
    if (IN(9)) { PH_LOCALS int r = gw;
        for (; r + NGW < MK_MR; r += 2 * NGW) rowpass_B2(HRES + (size_t)r * MK_D, HRES + (size_t)(r + NGW) * MK_D, Fb, FSb, INP(13), 1.0f, HRES, INP(32), XN, r, r + NGW, lane);
        for (; r < MK_MR; r += NGW) rowpass_B(HRES + (size_t)r * MK_D, Fb, FSb, INP(13), 1.0f, HRES, INP(32), XN, r, lane); }
    SEAM(9);
    if (IN(10)) { PH_LOCALS pg8::Gemm g{XN, WSB(WS_WGU2), MK_MPAD, 5632, 1024}; pg8::StaticOrder S; S.init(MK_MPAD, 5632, G, bx); pg8::EpiSwiGLU E{HB, MK_FF};
        pg8::gemm_phase<pg8::EpiSwiGLU, pg8::StaticOrder, true, true>(ldsl + RING_OFF, g, S, E); }
    SEAM(10);
    if (IN(11)) { PH_LOCALS skinny_item(HB + (size_t)MK_MP * MK_FF, WSB(WS_WD2), MK_FF, FSb, vcu, wave, lane);
        pg8::Gemm g{HB, WSB(WS_WD2), MK_MP, 1024, MK_FF}; pg8::StaticOrder S; S.init(MK_MP, 1024, G, bx); pg8::EpiBf16P E{Fb, 1024};
        pg8::gemm_phase<pg8::EpiBf16P, pg8::StaticOrder, true, true>(ldsl + RING_OFF, g, S, E); }
    SEAM(11);
    if (IN(12)) { PH_LOCALS int r = gw;
#define YROW(rr) ((rr) < MK_MP ? o_yp + (size_t)(rr) * MK_D : o_ys + (size_t)((rr) - MK_MP) * MK_D)
        for (; r + NGW < MK_MR; r += 2 * NGW) rowpass_D2(HRES, Fb, FSb, INP(33), YROW(r), YROW(r + NGW), r, r + NGW, lane);
        for (; r < MK_MR; r += NGW) rowpass_D(HRES, Fb, FSb, INP(33), YROW(r), r, lane);
#undef YROW
    }
    STAMP(13);
#if defined(PROBE_A)
    if (blockIdx.x == 0 && threadIdx.x == 0) {
        volatile LAS unsigned long long* T = (volatile LAS unsigned long long*)(ldsl + LDSCTL_OFF + 1024);
#if defined(PROBE_ACC)
        volatile LAS unsigned long long* AC = (volatile LAS unsigned long long*)(ldsl + LDSCTL_OFF + 2048);
        const unsigned long long ta = AC[PROBE_A], tb = AC[PROBE_B];
#else
        const unsigned long long ta = T[PROBE_A1] - T[PROBE_A], tb = T[PROBE_B1] - T[PROBE_B];
#endif
        const unsigned long long delay = 10000ull * (ta / 1000ull) + 500000ull * (tb / 1000ull);
        const unsigned long long t0 = __builtin_amdgcn_s_memrealtime();
        while (__builtin_amdgcn_s_memrealtime() - t0 < delay) __builtin_amdgcn_s_sleep(32);
    }
#endif
#undef IN
#undef SEAM
}

extern "C" void kernel_launch(void* const* d_in, const int* in_sizes, int n_in, void* d_out, int out_size, void* d_ws, size_t ws_size, hipStream_t stream) {
    static int grid = 0;
    if (grid == 0) {
        if (n_in != 37 || ws_size < WS_END) { fprintf(stderr, "kernel_launch: unexpected inputs (n_in %d, ws %zu)\n", n_in, ws_size); grid = -1; return; }
        int dev = 0, cus = 0, per_cu = 0;
        if (hipGetDevice(&dev) != hipSuccess || hipDeviceGetAttribute(&cus, hipDeviceAttributeMultiprocessorCount, dev) != hipSuccess) { grid = -1; return; }
        if (hipFuncSetAttribute((const void*)mk_fwd, hipFuncAttributeMaxDynamicSharedMemorySize, LDS_BYTES) != hipSuccess) { fprintf(stderr, "kernel_launch: hipFuncSetAttribute failed\n"); grid = -1; return; }
        if (hipOccupancyMaxActiveBlocksPerMultiprocessor(&per_cu, (const void*)mk_fwd, NWAVES * 64, LDS_BYTES) != hipSuccess || per_cu < 1) fprintf(stderr, "kernel_launch: occupancy query says %d\n", per_cu);
        (void)hipGetLastError();
        if (cus < 256) { fprintf(stderr, "kernel_launch: needs a 256-CU device (got %d)\n", cus); grid = -1; return; }
        grid = 256;
    }
    if (grid < 0) return;
    if (hipMemsetAsync((char*)d_ws + WS_CTL, 0, CTL_ZERO_BYTES, stream) != hipSuccess) return;
    Args a{};
    for (int i = 0; i < 37; ++i) a.in[i] = (const float*)d_in[i];
    a.out = (float*)d_out; a.ws = (unsigned char*)d_ws;
    constexpr int NL = MK_N_LAUNCHES;
    for (int li = 0; li < NL; ++li) {
        a.ph_lo = li * N_PHASES / NL; a.ph_hi = (li + 1) * N_PHASES / NL; a.li = li;
        hipLaunchKernelGGL(mk_fwd, dim3(grid), dim3(NWAVES * 64), LDS_BYTES, stream, a);
    }
}
```

```cpp
#include <hip/hip_runtime.h>
#include <cstdio>
#include <cstdint>
namespace pg8 {
#define PG8_LAS __attribute__((address_space(3)))
typedef unsigned short bf16_t;
typedef short bf16x8 __attribute__((ext_vector_type(8)));
typedef float f32x4 __attribute__((ext_vector_type(4)));
typedef unsigned u32x4 __attribute__((ext_vector_type(4)));
constexpr int BM = 256, BK = 64, HALF = 128, HTB = HALF * BK * 2  , STAGE_BYTES = 8 * HTB, NXCD = 8, WGM = 8;

__host__ __device__ __forceinline__ int lds_byte(int r, int c) { const int st = (r >> 4) * 2 + (c >> 5), rr = r & 15, cc = c & 31, ob = rr * 64 + cc * 2; return st * 1024 + (ob ^ (((ob >> 9) & 1) << 5)); }
__host__ __device__ __forceinline__ void stage_rc(int b, int& R, int& C) { const int st = b / 1024, sb = b % 1024, swz = sb ^ (((sb >> 9) & 1) << 5); R = (st >> 1) * 16 + swz / 64; C = (st & 1) * 32 + (swz % 64) / 2; }
__host__ __device__ __forceinline__ int perm32(int rho) { const int n = rho >> 4, i = rho & 15; return 8 * (i >> 2) + 4 * n + (i & 3); }

struct Unit { int pm, pn; };
struct Gemm { const bf16_t* A; const bf16_t* Bt; int M, N, K; };

struct StaticOrder {
    int nM, nN, nwg, G, c;
    __host__ __device__ void init(int M, int N, int G_, int c_) { nM = M / BM; nN = N / BM; nwg = nM * nN; G = G_; c = c_; }
    __host__ __device__ bool next(int i, Unit& u) const {
        const long L = (long)i * G + c; if (L >= nwg) return false;
        int wgid = (int)L; { const int q = nwg / NXCD, r = nwg % NXCD, xcd = wgid % NXCD, off = wgid / NXCD; wgid = (xcd < r ? xcd * (q + 1) : r * (q + 1) + (xcd - r) * q) + off; }
        const int nig = WGM * nN, gid = wgid / nig, fm = gid * WGM, gsz = (nM - fm) < WGM ? (nM - fm) : WGM;
        u.pm = fm + ((wgid % nig) % gsz); u.pn = (wgid % nig) / gsz; return true;
    }
    __device__ __forceinline__ void a_ready(const Unit&) const {}
    __device__ __forceinline__ void done(const Unit&) const {}
};

__device__ __forceinline__ unsigned cvt_pk_bf16(float lo, float hi) { unsigned r; asm volatile("v_cvt_pk_bf16_f32 %0, %1, %2" : "=v"(r) : "v"(lo), "v"(hi)); return r; }
typedef float f32x2 __attribute__((ext_vector_type(2)));
struct EpiF32 {
    static constexpr bool PERM = false, AFTER_DRAIN = false;
    float* C; int ldc; const float* bias;
    __device__ __forceinline__ void operator()(const f32x4 (&acc)[2][2][4][2], const Unit& u, int wr, int wc, int fr, int fq) const {
        const int row0 = u.pm * BM + wr * 64 + fr, col0 = u.pn * BM + wc * 32 + 4 * fq;
#pragma unroll
        for (int ai = 0; ai < 2; ++ai)
#pragma unroll
            for (int m = 0; m < 4; ++m) { float* rowp = C + (size_t)(row0 + ai * HALF + m * 16) * ldc + col0;
#pragma unroll
                for (int bj = 0; bj < 2; ++bj)
#pragma unroll
                    for (int n = 0; n < 2; ++n) *(f32x4*)(rowp + bj * HALF + n * 16) = acc[ai][bj][m][n]; }
    }
};
struct EpiBf16P {
    static constexpr bool PERM = true, AFTER_DRAIN = false;
    bf16_t* O; int ldc;
    __device__ __forceinline__ void operator()(const f32x4 (&acc)[2][2][4][2], const Unit& u, int wr, int wc, int fr, int fq) const {
        const int row0 = u.pm * BM + wr * 64 + fr, col0 = u.pn * BM + wc * 32 + 8 * fq;
#pragma unroll
        for (int ai = 0; ai < 2; ++ai)
#pragma unroll
            for (int m = 0; m < 4; ++m) { bf16_t* rowp = O + (size_t)(row0 + ai * HALF + m * 16) * ldc + col0;
#pragma unroll
                for (int bj = 0; bj < 2; ++bj) { const f32x4 v0 = acc[ai][bj][m][0], v1 = acc[ai][bj][m][1];
                    u32x4 w; w.x = cvt_pk_bf16(v0[0], v0[1]); w.y = cvt_pk_bf16(v0[2], v0[3]); w.z = cvt_pk_bf16(v1[0], v1[1]); w.w = cvt_pk_bf16(v1[2], v1[3]);
                    *(u32x4*)(rowp + bj * HALF) = w; } }
    }
};
struct EpiSwiGLU {
    static constexpr bool PERM = true, AFTER_DRAIN = false;
    bf16_t* O; int ldc;
    __device__ __forceinline__ void operator()(const f32x4 (&acc)[2][2][4][2], const Unit& u, int wr, int wc, int fr, int fq) const {
        const int row0 = u.pm * BM + wr * 64 + fr, col0 = u.pn * HALF + wc * 32 + 8 * fq;
#pragma unroll
        for (int ai = 0; ai < 2; ++ai)
#pragma unroll
            for (int m = 0; m < 4; ++m) { bf16_t* rowp = O + (size_t)(row0 + ai * HALF + m * 16) * ldc + col0;
                float h[8];
#pragma unroll
                for (int n = 0; n < 2; ++n)
#pragma unroll
                    for (int j = 0; j < 4; ++j) { const float g = acc[ai][0][m][n][j], up = acc[ai][1][m][n][j];
                        h[4 * n + j] = g * __builtin_amdgcn_rcpf(1.0f + __builtin_amdgcn_exp2f(-1.4426950408889634f * g)) * up; }
                u32x4 w; w.x = cvt_pk_bf16(h[0], h[1]); w.y = cvt_pk_bf16(h[2], h[3]); w.z = cvt_pk_bf16(h[4], h[5]); w.w = cvt_pk_bf16(h[6], h[7]);
                *(u32x4*)rowp = w; }
    }
};
struct PanelRms {
    unsigned* xbuf;
    unsigned* cnt;
    unsigned* tmo;
    int ntn; float eps; unsigned code;
    __device__ __forceinline__ bool run(const f32x4 (&v)[2][2][4][2], const Unit& u, int wr, int wc, int fr, int fq, PG8_LAS unsigned char* lds, int wid, int lane) const {
        PG8_LAS float* P = (PG8_LAS float*)lds;
        PG8_LAS float* S = (PG8_LAS float*)(lds + 8192);
        PG8_LAS unsigned* flag = (PG8_LAS unsigned*)(lds + 8192 + 2048);
#pragma unroll
        for (int ai = 0; ai < 2; ++ai)
#pragma unroll
            for (int m = 0; m < 4; ++m) {
                float s = 0.f;
#pragma unroll
                for (int bj = 0; bj < 2; ++bj)
#pragma unroll
                    for (int n = 0; n < 2; ++n) { const f32x4 x = v[ai][bj][m][n]; s += (x[0] * x[0] + x[1] * x[1]) + (x[2] * x[2] + x[3] * x[3]); }
                s += __shfl_xor(s, 16); s += __shfl_xor(s, 32);
                if (fq == 0) P[(ai * HALF + wr * 64 + m * 16 + fr) * 4 + wc] = s;
            }
        asm volatile("s_waitcnt lgkmcnt(0)" ::: "memory"); __builtin_amdgcn_s_barrier(); asm volatile("" ::: "memory");
        const int row = wid * 32 + (lane & 31);
        if (lane < 32) {
            const float t = (P[row * 4 + 0] + P[row * 4 + 1]) + (P[row * 4 + 2] + P[row * 4 + 3]);
            unsigned long long* slot = (unsigned long long*)xbuf + ((size_t)(u.pm * BM + row) * 4 + u.pn);
            __hip_atomic_store(slot, (unsigned long long)__float_as_uint(t), __ATOMIC_RELAXED, __HIP_MEMORY_SCOPE_AGENT);
        }
        asm volatile("s_waitcnt vmcnt(0)" ::: "memory");
        if (lane == 0) __hip_atomic_fetch_add(cnt + 64 * u.pm, 1u, __ATOMIC_RELAXED, __HIP_MEMORY_SCOPE_AGENT);
        if (wid == 0) {
            bool dead = false; const unsigned long long t0 = __builtin_amdgcn_s_memrealtime(); const unsigned want = 8u * (unsigned)ntn;
            for (;;) {
                if ((unsigned)__builtin_amdgcn_readfirstlane(__hip_atomic_load(cnt + 64 * u.pm, __ATOMIC_RELAXED, __HIP_MEMORY_SCOPE_AGENT)) >= want) break;
                if (__builtin_amdgcn_s_memrealtime() - t0 > 2000000ull) {
                    if (lane == 0) { unsigned expect = 0u; __hip_atomic_compare_exchange_strong(tmo + 1, &expect, code | (unsigned)(u.pm & 0xff), __ATOMIC_RELAXED, __ATOMIC_RELAXED, __HIP_MEMORY_SCOPE_AGENT);
                                     __hip_atomic_store(tmo, 1u, __ATOMIC_RELAXED, __HIP_MEMORY_SCOPE_AGENT); }
                    dead = true; break; }
                __builtin_amdgcn_s_sleep(2);
            }
            __builtin_amdgcn_fence(__ATOMIC_ACQUIRE, "agent");
            if (lane == 0) flag[0] = dead ? 1u : 0u;
        }
        asm volatile("s_waitcnt vmcnt(0) lgkmcnt(0)" ::: "memory"); __builtin_amdgcn_s_barrier(); asm volatile("" ::: "memory");
        const bool bad = flag[0] != 0u;
        if (lane < 32) {
            const unsigned long long* slot = (const unsigned long long*)xbuf + (size_t)(u.pm * BM + row) * 4; float q = 0.f;
#pragma unroll
            for (int t = 0; t < 4; ++t) if (t < ntn) q += __uint_as_float((unsigned)__hip_atomic_load(slot + t, __ATOMIC_RELAXED, __HIP_MEMORY_SCOPE_AGENT));
            S[row] = 1.0f / sqrtf(q / (256.0f * (float)ntn) + eps);
        }
        asm volatile("s_waitcnt lgkmcnt(0)" ::: "memory"); __builtin_amdgcn_s_barrier(); asm volatile("" ::: "memory");
        return bad;
    }
};
struct EpiRmsRes {
    static constexpr bool PERM = false, AFTER_DRAIN = true;
    const float* base; float* out; int ldc; const float* g1; float scale; PanelRms st;
    __device__ __forceinline__ void fused(f32x4 (&acc)[2][2][4][2], const Unit& u, int wr, int wc, int fr, int fq, PG8_LAS unsigned char* lds, int wid, int lane) const {
        const PG8_LAS float* S = (const PG8_LAS float*)(lds + 8192);
        const int col0 = u.pn * BM + wc * 32 + 4 * fq;
        const bool bad = st.run(acc, u, wr, wc, fr, fq, lds, wid, lane);
        const float qnan = __builtin_nanf("");
        f32x4 gv[2][2];
#pragma unroll
        for (int bj = 0; bj < 2; ++bj)
#pragma unroll
            for (int n = 0; n < 2; ++n) gv[bj][n] = *(const f32x4*)(g1 + col0 + bj * HALF + n * 16) * scale;
#pragma unroll
        for (int ai = 0; ai < 2; ++ai)
#pragma unroll
            for (int m = 0; m < 4; ++m) { const int r = ai * HALF + wr * 64 + m * 16 + fr; const float rs = S[r]; const size_t off = (size_t)(u.pm * BM + r) * ldc + col0;
#pragma unroll
                for (int bj = 0; bj < 2; ++bj)
#pragma unroll
                    for (int n = 0; n < 2; ++n) { const f32x4 bs = *(const f32x4*)(base + off + bj * HALF + n * 16); f32x4 o = bs + acc[ai][bj][m][n] * rs * gv[bj][n];
                        if (bad) o = (f32x4){qnan, qnan, qnan, qnan}; *(f32x4*)(out + off + bj * HALF + n * 16) = o; }
                if (m & 1) asm volatile("" ::: "memory"); }
    }
};
struct EpiRmsResRms {
    static constexpr bool PERM = false, AFTER_DRAIN = true;
    const float* base; float* out; bf16_t* xn; int ldc; const float* g1; float scale; const float* g2; PanelRms st1, st2;
    __device__ __forceinline__ void fused(f32x4 (&acc)[2][2][4][2], const Unit& u, int wr, int wc, int fr, int fq, PG8_LAS unsigned char* lds, int wid, int lane) const {
        typedef unsigned u32x2v __attribute__((ext_vector_type(2)));
        const PG8_LAS float* S = (const PG8_LAS float*)(lds + 8192);
        const int col0 = u.pn * BM + wc * 32 + 4 * fq;
        bool bad = st1.run(acc, u, wr, wc, fr, fq, lds, wid, lane);
        const float qnan = __builtin_nanf("");
        {
            f32x4 gv[2][2];
#pragma unroll
            for (int bj = 0; bj < 2; ++bj)
#pragma unroll
                for (int n = 0; n < 2; ++n) gv[bj][n] = *(const f32x4*)(g1 + col0 + bj * HALF + n * 16) * scale;
#pragma unroll
            for (int ai = 0; ai < 2; ++ai)
#pragma unroll
                for (int m = 0; m < 4; ++m) { const int r = ai * HALF + wr * 64 + m * 16 + fr; const float rs = S[r]; const size_t off = (size_t)(u.pm * BM + r) * ldc + col0;
#pragma unroll
                    for (int bj = 0; bj < 2; ++bj)
#pragma unroll
                        for (int n = 0; n < 2; ++n) { const f32x4 bs = *(const f32x4*)(base + off + bj * HALF + n * 16); acc[ai][bj][m][n] = bs + acc[ai][bj][m][n] * rs * gv[bj][n]; }
                    asm volatile("" : "+v"(acc[ai][0][m][0]), "+v"(acc[ai][0][m][1]), "+v"(acc[ai][1][m][0]), "+v"(acc[ai][1][m][1]));
                    if (m & 1) asm volatile("" ::: "memory"); }
        }
        const bool bad1 = bad;
        bad = st2.run(acc, u, wr, wc, fr, fq, lds, wid, lane) || bad;
        f32x4 gv2[2][2];
#pragma unroll
        for (int bj = 0; bj < 2; ++bj)
#pragma unroll
            for (int n = 0; n < 2; ++n) gv2[bj][n] = *(const f32x4*)(g2 + col0 + bj * HALF + n * 16);
#pragma unroll
        for (int ai = 0; ai < 2; ++ai)
#pragma unroll
            for (int m = 0; m < 4; ++m) { const int r = ai * HALF + wr * 64 + m * 16 + fr; const float rs = S[r]; const size_t off = (size_t)(u.pm * BM + r) * ldc + col0;
#pragma unroll
                for (int bj = 0; bj < 2; ++bj)
#pragma unroll
                    for (int n = 0; n < 2; ++n) { const f32x4 x1 = acc[ai][bj][m][n]; *(f32x4*)(out + off + bj * HALF + n * 16) = bad1 ? (f32x4){qnan, qnan, qnan, qnan} : x1;
                        const f32x4 o = x1 * rs * gv2[bj][n]; u32x2v w; w.x = cvt_pk_bf16(o[0], o[1]); w.y = cvt_pk_bf16(o[2], o[3]);
                        if (bad) { w.x = 0x7fc07fc0u; w.y = 0x7fc07fc0u; } *(u32x2v*)(xn + off + bj * HALF + n * 16) = w; }
                asm volatile("" ::: "memory"); }
    }
};
template <class Epi, class Sched, bool ALIGN_EPI = false, bool SP2 = false>
__device__ __forceinline__ void gemm_phase(PG8_LAS unsigned char* lds, const Gemm g, const Sched& S, const Epi& E) {
    int tid = threadIdx.x; asm volatile("" : "+v"(tid));
    const int wid = __builtin_amdgcn_readfirstlane(tid >> 6), lane = tid & 63, wr = wid >> 2, wc = wid & 3, fr = lane & 15, fq = lane >> 4;
    const int K = g.K, nt = K / BK;
    unsigned voffA[2], voffB[2];
#pragma unroll
    for (int i = 0; i < 2; ++i) { int R, C; stage_rc(tid * 16 + i * 8192, R, C); const int Rb = Epi::PERM ? ((R & ~31) + perm32(R & 31)) : R;
        voffA[i] = (unsigned)(R * K + C) * 2u; voffB[i] = (unsigned)(Rb * K + C) * 2u; }
    const size_t kstep = (size_t)(BK * 2);
    const size_t hstep = (size_t)HALF * K * 2;
    const size_t tstep = 2 * hstep;
    const unsigned ldsw = (unsigned)wid * 1024u;
    const int aoff = lds_byte(wr * 64 + fr, fq * 8), boff = lds_byte(wc * 32 + fr, fq * 8);
#define PG8_SA(b, h) (((b) * 2 + (h)) * HTB)
#define PG8_SB(b, h) ((4 + (b) * 2 + (h)) * HTB)
#define PG8_STAGE(bufoff, gbase, voff) do { _Pragma("unroll") for (int _i = 0; _i < 2; ++_i) \
        __builtin_amdgcn_global_load_lds((const unsigned*)((const char*)(gbase) + (voff)[_i]), (PG8_LAS unsigned*)(lds + (bufoff) + ldsw + _i * 8192), 16, 0, 0); } while (0)
#define PG8_LDA(dst, b, h) do { _Pragma("unroll") for (int m = 0; m < 4; ++m) _Pragma("unroll") for (int k = 0; k < 2; ++k) dst[m][k] = *(const PG8_LAS bf16x8*)(lds + PG8_SA(b, h) + aoff + m * 2048 + k * 1024); } while (0)
#define PG8_LDB(dst, b, h) do { _Pragma("unroll") for (int n = 0; n < 2; ++n) _Pragma("unroll") for (int k = 0; k < 2; ++k) dst[n][k] = *(const PG8_LAS bf16x8*)(lds + PG8_SB(b, h) + boff + n * 2048 + k * 1024); } while (0)
#define PG8_MMA(ai, bj, At, Bt) do { __builtin_amdgcn_s_setprio(1); _Pragma("unroll") for (int m = 0; m < 4; ++m) _Pragma("unroll") for (int n = 0; n < 2; ++n) _Pragma("unroll") for (int k = 0; k < 2; ++k) \
        acc[ai][bj][m][n] = __builtin_amdgcn_mfma_f32_16x16x32_bf16(Bt[n][k], At[m][k], acc[ai][bj][m][n], 0, 0, 0); __builtin_amdgcn_s_setprio(0); } while (0)
#define PG8_WAIT_V(n) asm volatile("s_waitcnt vmcnt(" #n ")" ::: "memory")
#define PG8_WAIT_L(n) asm volatile("s_waitcnt lgkmcnt(" #n ")" ::: "memory")
#define PG8_BAR __builtin_amdgcn_s_barrier()
#define PG8_SCHED __builtin_amdgcn_sched_barrier(0)
    Unit cur, nxt; int ui = 0;
    if (!S.next(0, cur)) return;
    f32x4 acc[2][2][4][2];
#pragma unroll
    for (int a = 0; a < 2; ++a)
#pragma unroll
        for (int b = 0; b < 2; ++b)
#pragma unroll
            for (int m = 0; m < 4; ++m)
#pragma unroll
                for (int n = 0; n < 2; ++n) acc[a][b][m][n] = (f32x4){0.f, 0.f, 0.f, 0.f};
    bf16x8 At[4][2], B0[2][2], B1[2][2];
    const char* cA = (const char*)g.A + (size_t)cur.pm * tstep; const char* cB = (const char*)g.Bt + (size_t)cur.pn * tstep;
    S.a_ready(cur);
    if constexpr (SP2) {
        PG8_STAGE(PG8_SB(0, 0), cB, voffB); PG8_STAGE(PG8_SB(0, 1), cB + hstep, voffB); PG8_STAGE(PG8_SA(0, 0), cA, voffA); PG8_STAGE(PG8_SA(0, 1), cA + hstep, voffA);
        if (wr == 1) PG8_BAR;
        PG8_WAIT_V(2); PG8_BAR;
        PG8_STAGE(PG8_SB(1, 0), cB + kstep, voffB); PG8_STAGE(PG8_SA(1, 0), cA + kstep, voffA); PG8_STAGE(PG8_SB(1, 1), cB + hstep + kstep, voffB);
        PG8_WAIT_V(6); PG8_BAR;
    } else {
        PG8_STAGE(PG8_SB(0, 0), cB, voffB); PG8_STAGE(PG8_SA(0, 0), cA, voffA); PG8_STAGE(PG8_SB(0, 1), cB + hstep, voffB); PG8_STAGE(PG8_SA(0, 1), cA + hstep, voffA);
        if (wr == 1) PG8_BAR;
        PG8_WAIT_V(4); PG8_BAR;
        PG8_STAGE(PG8_SB(1, 0), cB + kstep, voffB); PG8_STAGE(PG8_SA(1, 0), cA + kstep, voffA); PG8_STAGE(PG8_SB(1, 1), cB + hstep + kstep, voffB);
        PG8_WAIT_V(6); PG8_BAR;
    }
    for (;;) {
        const bool has_next = S.next(ui + 1, nxt);
        const char* nA = has_next ? (const char*)g.A + (size_t)nxt.pm * tstep : cA; const char* nB = has_next ? (const char*)g.Bt + (size_t)nxt.pn * tstep : cB;
        for (int t = 0; t < nt; t += 2) {
            const bool last = (t == nt - 2);
            const char* a1 = cA + (size_t)(t + 1) * kstep;
            const char* a2 = last ? nA : cA + (size_t)(t + 2) * kstep; const char* b2 = last ? nB : cB + (size_t)(t + 2) * kstep;
            const char* a3 = a2 + kstep; const char* b3 = b2 + kstep;
            if (last && has_next) S.a_ready(nxt);
            if constexpr (SP2) {
            PG8_LDB(B0, 0, 0); PG8_LDB(B1, 0, 1); PG8_SCHED; PG8_LDA(At, 0, 0); PG8_STAGE(PG8_SA(1, 1), a1 + hstep, voffA);
            PG8_WAIT_V(8); PG8_WAIT_L(0); PG8_BAR; PG8_MMA(0, 0, At, B0); PG8_MMA(0, 1, At, B1); PG8_BAR; PG8_SCHED;
            PG8_LDA(At, 0, 1); PG8_STAGE(PG8_SB(0, 0), b2, voffB); PG8_STAGE(PG8_SB(0, 1), b2 + hstep, voffB); PG8_STAGE(PG8_SA(0, 0), a2, voffA);
            PG8_WAIT_V(8); PG8_WAIT_L(0); PG8_BAR; PG8_MMA(1, 0, At, B0); PG8_MMA(1, 1, At, B1); PG8_BAR; PG8_SCHED;
            PG8_LDB(B0, 1, 0); PG8_LDB(B1, 1, 1); PG8_SCHED; PG8_LDA(At, 1, 0); PG8_STAGE(PG8_SA(0, 1), a2 + hstep, voffA);
            PG8_WAIT_V(8); PG8_WAIT_L(0); PG8_BAR; PG8_MMA(0, 0, At, B0); PG8_MMA(0, 1, At, B1); PG8_BAR; PG8_SCHED;
            PG8_LDA(At, 1, 1); PG8_STAGE(PG8_SB(1, 0), b3, voffB); PG8_STAGE(PG8_SB(1, 1), b3 + hstep, voffB); PG8_STAGE(PG8_SA(1, 0), a3, voffA);
            PG8_WAIT_V(8); PG8_WAIT_L(0); PG8_BAR; PG8_MMA(1, 0, At, B0); PG8_MMA(1, 1, At, B1); PG8_BAR; PG8_SCHED;
            } else {
            PG8_LDB(B0, 0, 0); PG8_SCHED; PG8_LDA(At, 0, 0); PG8_STAGE(PG8_SA(1, 1), a1 + hstep, voffA);
            PG8_WAIT_L(8); PG8_BAR; PG8_WAIT_L(0); PG8_MMA(0, 0, At, B0); PG8_BAR; PG8_SCHED;
            PG8_LDB(B1, 0, 1); PG8_STAGE(PG8_SB(0, 0), b2, voffB);
            PG8_BAR; PG8_WAIT_L(0); PG8_MMA(0, 1, At, B1); PG8_BAR;
            PG8_LDA(At, 0, 1); PG8_STAGE(PG8_SA(0, 0), a2, voffA);
            PG8_BAR; PG8_WAIT_L(0); PG8_MMA(1, 0, At, B0); PG8_BAR; PG8_SCHED;
            PG8_STAGE(PG8_SB(0, 1), b2 + hstep, voffB);
            PG8_WAIT_V(6); PG8_BAR; PG8_MMA(1, 1, At, B1); PG8_BAR;
            PG8_LDB(B0, 1, 0); PG8_SCHED; PG8_LDA(At, 1, 0); PG8_STAGE(PG8_SA(0, 1), a2 + hstep, voffA);
            PG8_WAIT_L(8); PG8_BAR; PG8_WAIT_L(0); PG8_MMA(0, 0, At, B0); PG8_BAR; PG8_SCHED;
            PG8_LDB(B1, 1, 1); PG8_STAGE(PG8_SB(1, 0), b3, voffB);
            PG8_BAR; PG8_WAIT_L(0); PG8_MMA(0, 1, At, B1); PG8_BAR;
            PG8_LDA(At, 1, 1); PG8_STAGE(PG8_SA(1, 0), a3, voffA);
            PG8_BAR; PG8_WAIT_L(0); PG8_MMA(1, 0, At, B0); PG8_BAR; PG8_SCHED;
            PG8_STAGE(PG8_SB(1, 1), b3 + hstep, voffB);
            PG8_WAIT_V(6); PG8_BAR; PG8_MMA(1, 1, At, B1); PG8_BAR;
            }
        }
        if constexpr (ALIGN_EPI) { if (wr == 0) PG8_BAR; }
        if constexpr (!Epi::AFTER_DRAIN) { E(acc, cur, wr, wc, fr, fq); S.done(cur); }
        if (!has_next) break;
#pragma unroll
        for (int a = 0; a < 2; ++a)
#pragma unroll
            for (int b = 0; b < 2; ++b)
#pragma unroll
                for (int m = 0; m < 4; ++m)
#pragma unroll
                    for (int n = 0; n < 2; ++n) acc[a][b][m][n] = (f32x4){0.f, 0.f, 0.f, 0.f};
        cur = nxt; cA = nA; cB = nB; ++ui;
        if constexpr (ALIGN_EPI) { if (wr == 1) PG8_BAR; }
    }
    PG8_WAIT_V(0);
    if constexpr (!ALIGN_EPI) { if (wr == 0) PG8_BAR; }
    PG8_BAR;
    if constexpr (Epi::AFTER_DRAIN) { E.fused(acc, cur, wr, wc, fr, fq, lds, wid, lane); S.done(cur); }
#undef PG8_SA
#undef PG8_SB
#undef PG8_STAGE
#undef PG8_LDA
#undef PG8_LDB
#undef PG8_MMA
#undef PG8_WAIT_V
#undef PG8_WAIT_L
#undef PG8_BAR
#undef PG8_SCHED
}
}

#define PG8_SP2 true
#define PG8_ALIGN true
#include <hip/hip_bf16.h>
#include <cmath>
namespace attn_body {
using bf16=__hip_bfloat16;
using bf16x8=__attribute__((ext_vector_type(8)))short;
using s16x4=__attribute__((ext_vector_type(4)))short;
using f32x16=__attribute__((ext_vector_type(16)))float;
using u32x4=__attribute__((ext_vector_type(4)))unsigned;
constexpr int BATCH=4,NHEAD=16,SEQ=4096,D=64,DM=NHEAD*D,DMI=512;
constexpr int NW=8,QBLK=32,QB=QBLK*NW,KVBLK=64,NQB=SEQ/QB;
constexpr int ATTN_PITCH=DM, ATTN_UNIT_ROWS=QB;
__device__ __forceinline__ int crow(int r,int hi){return (r&3)+8*(r>>2)+4*hi;}
#define SBAR() __builtin_amdgcn_sched_barrier(0)
__device__ __forceinline__ void cmask(f32x16&p0,f32x16&p1,int jb,int qrel,int hi){
  const float NEG=-INFINITY; int kb=64*jb+4*hi;
  #pragma unroll
  for(int r=0;r<16;++r){int kv=kb+(r&3)+8*(r>>2); if(kv>qrel)p0[r]=NEG; if(kv+32>qrel)p1[r]=NEG;}
}

constexpr int NSLOT=3, SLOTB=8192;
constexpr int LDS_K=0, LDS_V=NSLOT*SLOTB, LDS_WS=2*NSLOT*SLOTB, LDS_OST=LDS_WS+NW*64*4, LDS_BYTES=LDS_OST+NW*4096;
constexpr float C2=0.125f*1.4426950408889634f;
__device__ __forceinline__ void glds16(const void*gsrc,unsigned lds_dst){unsigned keep;
  asm volatile("s_mov_b32 %0, m0\n\ts_mov_b32 m0, %2\n\ts_nop 0\n\tglobal_load_lds_dwordx4 %1, off\n\ts_mov_b32 m0, %0":"=&s"(keep):"v"(gsrc),"s"(lds_dst):"memory");}
__device__ __forceinline__ float max3f(float a,float b,float c){float r;asm("v_max3_f32 %0, %1, %2, %3":"=v"(r):"v"(a),"v"(b),"v"(c));return r;}
__device__ __forceinline__ float max2f(float a,float b){float r;asm("v_max_f32_e32 %0, %1, %2":"=v"(r):"v"(a),"v"(b));return r;}
__device__ __forceinline__ float fadd_s(float a,float b){float r;asm("v_add_f32_e32 %0, %1, %2":"=v"(r):"v"(a),"v"(b));return r;}
__device__ __forceinline__ float fsub_s(float a,float b){float r;asm("v_sub_f32_e32 %0, %1, %2":"=v"(r):"v"(a),"v"(b));return r;}
typedef float f32x2_t __attribute__((ext_vector_type(2))); typedef __bf16 bf16x2_t __attribute__((ext_vector_type(2)));
__device__ __forceinline__ unsigned cvtpk_s(float lo,float hi){f32x2_t v={lo,hi};bf16x2_t b=__builtin_convertvector(v,bf16x2_t);return __builtin_bit_cast(unsigned,b);}
#define WAIT_BAR(N) asm volatile("s_waitcnt vmcnt(" #N ") lgkmcnt(0)\n\ts_barrier":::"memory")

__device__ __forceinline__ void qkt(f32x16&p0,f32x16&p1,const char*Kslot,const bf16x8*qr,const f32x16&negm,int r32,int hi){
  const char*kb=Kslot+hi*1024+r32*16;
  #pragma unroll
  for(int d0=0;d0<4;++d0){
    const bf16x8 b0=*reinterpret_cast<const bf16x8*>(kb+d0*2048);
    const bf16x8 b1=*reinterpret_cast<const bf16x8*>(kb+d0*2048+512);
    if(d0==0){p0=__builtin_amdgcn_mfma_f32_32x32x16_bf16(b0,qr[0],negm,0,0,0);p1=__builtin_amdgcn_mfma_f32_32x32x16_bf16(b1,qr[0],negm,0,0,0);}
    else{p0=__builtin_amdgcn_mfma_f32_32x32x16_bf16(b0,qr[d0],p0,0,0,0);p1=__builtin_amdgcn_mfma_f32_32x32x16_bf16(b1,qr[d0],p1,0,0,0);}}
}
typedef __attribute__((address_space(3))) const char* lds_cptr;
typedef short v4i16_t __attribute__((ext_vector_type(4)));
__device__ __forceinline__ void kload8(bf16x8*kf,lds_cptr kp){
  kf[0]=*(const __attribute__((address_space(3))) bf16x8*)(kp);      kf[1]=*(const __attribute__((address_space(3))) bf16x8*)(kp+512);
  kf[2]=*(const __attribute__((address_space(3))) bf16x8*)(kp+2048); kf[3]=*(const __attribute__((address_space(3))) bf16x8*)(kp+2560);
  kf[4]=*(const __attribute__((address_space(3))) bf16x8*)(kp+4096); kf[5]=*(const __attribute__((address_space(3))) bf16x8*)(kp+4608);
  kf[6]=*(const __attribute__((address_space(3))) bf16x8*)(kp+6144); kf[7]=*(const __attribute__((address_space(3))) bf16x8*)(kp+6656);
}
__device__ __forceinline__ void kload2(bf16x8*kf,lds_cptr kp,int j){ kf[2*j]=*(const __attribute__((address_space(3))) bf16x8*)(kp+j*2048); kf[2*j+1]=*(const __attribute__((address_space(3))) bf16x8*)(kp+j*2048+512); }
__device__ __forceinline__ s16x4 vtr(lds_cptr p){ return __builtin_bit_cast(s16x4,__builtin_amdgcn_ds_read_tr16_b64_v4i16((__attribute__((address_space(3))) v4i16_t*)p)); }
__device__ __forceinline__ float rowmax(const f32x16&p0,const f32x16&p1){
  float a=max3f(p0[0],p0[1],p1[0]),b=max3f(p0[2],p0[3],p1[1]);a=max3f(a,p1[2],p1[3]);
  #pragma unroll
  for(int r=4;r<16;r+=4){a=max3f(a,p0[r],p0[r+1]);b=max3f(b,p0[r+2],p0[r+3]);a=max3f(a,p1[r],p1[r+1]);b=max3f(b,p1[r+2],p1[r+3]);}
  const float m=max2f(a,b);
  auto rr=__builtin_amdgcn_permlane32_swap(__float_as_uint(m),__float_as_uint(m),false,false);
  return max2f(__uint_as_float(rr[0]),__uint_as_float(rr[1]));
}
__device__ __forceinline__ void pv(f32x16*o,int vb,bf16x8 pa0,bf16x8 pa1,bf16x8 pa2,bf16x8 pa3){
  #pragma unroll
  for(int d0=0;d0<2;++d0){s16x4 lo[4],hi[4];
    #pragma unroll
    for(int ks=0;ks<4;++ks){
      asm volatile("ds_read_b64_tr_b16 %0,%1 offset:%c2":"=&v"(lo[ks]):"v"(vb),"i"(d0*4096+ks*1024):"memory");
      asm volatile("ds_read_b64_tr_b16 %0,%1 offset:%c2":"=&v"(hi[ks]):"v"(vb),"i"(d0*4096+ks*1024+512):"memory");}
    asm volatile("s_waitcnt lgkmcnt(0)":::"memory");SBAR();
    #define PK(k) (bf16x8){lo[k][0],lo[k][1],lo[k][2],lo[k][3],hi[k][0],hi[k][1],hi[k][2],hi[k][3]}
    o[d0]=__builtin_amdgcn_mfma_f32_32x32x16_bf16(pa0,PK(0),o[d0],0,0,0);
    o[d0]=__builtin_amdgcn_mfma_f32_32x32x16_bf16(pa1,PK(1),o[d0],0,0,0);
    o[d0]=__builtin_amdgcn_mfma_f32_32x32x16_bf16(pa2,PK(2),o[d0],0,0,0);
    o[d0]=__builtin_amdgcn_mfma_f32_32x32x16_bf16(pa3,PK(3),o[d0],0,0,0);
    #undef PK
  }
}

#ifndef ATTN_STORE16
#define ATTN_STORE16(p,v) (*(u32x4*)(p)=(v))
#endif
template<int THRL> __device__ __forceinline__ void attn_unit(int b,int h,int qb,const bf16*Q,const bf16*__restrict__ K,const bf16*__restrict__ V,bf16*O,char*shm){
  int tid=threadIdx.x; asm volatile("":"+v"(tid)); const int lane=tid&63,r32=lane&31,hi=lane>>5; const int wid=__builtin_amdgcn_readfirstlane(tid>>6);
  const long rowbase=(long)b*SEQ; const int q0=qb*QB;
  const int hq=h>>1, hv=((h>>2)<<1)|(h&1);
  const bf16*Qw=Q+(rowbase+q0+wid*QBLK)*DMI+hq*D;
  const bf16*Kh=K+rowbase*DMI+hq*D,*Vh=V+rowbase*DMI+hv*D;
  const unsigned lds0=(unsigned)(uintptr_t)shm;
  float*wsf=(float*)(shm+LDS_WS)+wid*64;
  const bf16*ksrc=Kh+(long)lane*DMI+wid*8;
  const bf16*vsrc=Vh+(long)(16*(wid&3)+(lane>>2))*DMI+(wid>>2)*32+(lane&3)*8;
  const unsigned kdst=lds0+LDS_K+wid*1024, vdst=lds0+LDS_V+wid*1024;
  #define DMA_K(t,slot) glds16(ksrc+(long)(t)*KVBLK*DMI,(unsigned)__builtin_amdgcn_readfirstlane(kdst+(slot)))
  #define DMA_V(t,slot) glds16(vsrc+(long)(t)*KVBLK*DMI,(unsigned)__builtin_amdgcn_readfirstlane(vdst+(slot)))
  const int vb0=(int)(lds0+LDS_V)+((lane>>4)&1)*32+(lane&3)*8+(4*hi+((lane&15)>>2))*64;
  const char*Kbase=shm+LDS_K; bf16x8 kf[8];
  const lds_cptr shm3=(lds_cptr)shm; const lds_cptr kp0=shm3+LDS_K+hi*1024+r32*16; const lds_cptr vp0=shm3+LDS_V+((lane>>4)&1)*32+(lane&3)*8+(4*hi+((lane&15)>>2))*64;
  const int NT=(q0+QB)/KVBLK;
  DMA_K(0,0);DMA_V(0,0);DMA_K(1,SLOTB);
  bf16x8 qr[4];
  #pragma unroll
  for(int d0=0;d0<4;++d0)qr[d0]=*reinterpret_cast<const bf16x8*>(&Qw[(long)r32*DMI+d0*16+hi*8]);
  float mhat=0.f,l_reg=0.f;f32x16 o[2];o[0]=f32x16{};o[1]=f32x16{};f32x16 negm=f32x16{};asm volatile("":"+v"(negm));
  const int qrel=wid*QBLK+r32;
  #define CMASK(P0,P1,t) do{int jb_=(t)-(NT-4); if(jb_>=0)cmask(P0,P1,jb_,qrel,hi);}while(0)
  bool resc=false;
  #define START(P0,P1) do{ const float rm=rowmax(P0,P1); resc=false; \
    { const float dl=rm; mhat=fadd_s(mhat,dl); \
      _Pragma("unroll") for(int r=0;r<16;++r){P0[r]=fsub_s(P0[r],dl);P1[r]=fsub_s(P1[r],dl);} \
      _Pragma("unroll") for(int r=0;r<16;++r)negm[r]=-mhat; asm volatile("":"+v"(negm)); } \
    _Pragma("unroll") for(int r=0;r<16;++r)P0[r]=__builtin_amdgcn_exp2f(P0[r]); }while(0)
  #define RESC() do{ if(resc){ asm volatile("s_waitcnt lgkmcnt(0)":::"memory"); \
      _Pragma("unroll") for(int d_=0;d_<2;++d_) _Pragma("unroll") for(int r=0;r<16;++r)o[d_][r]*=wsf[crow(r,hi)]; } }while(0)
  f32x16 pA0,pA1,pB0,pB1;
  int sl_prev=0,sl_cur=0,sl_next=SLOTB;
  #define ROT() do{sl_prev=sl_cur;sl_cur=sl_next;sl_next=(sl_next==(NSLOT-1)*SLOTB)?0:sl_next+SLOTB;}while(0)
  DMA_K(2,2*SLOTB);
  WAIT_BAR(3);
  qkt(pA0,pA1,Kbase,qr,negm,r32,hi);asm volatile("s_nop 15\n\ts_nop 7":"+v"(pA0),"+v"(pA1));CMASK(pA0,pA1,0);
  START(pA0,pA1);
  _Pragma("unroll") for(int r=0;r<16;++r)pA1[r]=__builtin_amdgcn_exp2f(pA1[r]);
  WAIT_BAR(0);
  DMA_K(3,0);DMA_V(1,SLOTB);
  ROT();
  kload8(kf,kp0+sl_cur);
  WAIT_BAR(2);
  s16x4 vlo[8],vhi[8]; u32x4 pw0,pw1,pw2,pw3;
  #define PKW(P,B) cvtpk_s(P[B],P[B+1])
  #define PAF(k) __builtin_bit_cast(bf16x8,pw##k)
  #define VFR(i) (bf16x8){vlo[i][0],vlo[i][1],vlo[i][2],vlo[i][3],vhi[i][0],vhi[i][1],vhi[i][2],vhi[i][3]}
  #define PIN(x) asm volatile("":"+v"(x))
  #define MX3(a,b,c) __builtin_fmaxf(__builtin_fmaxf((a),(b)),(c))
  #define GAPA(MF,A0,A1,A2,A3,W0,W1,PW) do{ MF; sacc+=A0; sacc+=A1; sacc+=A2; sacc+=A3; PIN(sacc); W0; W1; PIN(PW); SBAR(); }while(0)
  #define EX(v) __builtin_amdgcn_exp2f(v)
  #define GAPB(MF,X,B) do{ MF; X[B]=EX(X[B]); X[B+1]=EX(X[B+1]); X[B+2]=EX(X[B+2]); X[B+3]=EX(X[B+3]); PIN(X); SBAR(); }while(0)
  #define VRD(i) do{ vlo[i]=vtr(vp_+(((i)>>2)*4096+((i)&3)*1024)); vhi[i]=vtr(vp_+(((i)>>2)*4096+((i)&3)*1024+512)); }while(0)
  #define KRD(G,j) do{ if(G){ kload2(kf,kp0+sl_next,j); SBAR(); } }while(0)
  #define STEP(C0,C1,P0,P1,t,GK,GV,GL) do{ SBAR(); \
    const lds_cptr vp_=vp0+sl_prev; \
    VRD(0); SBAR(); float sacc=(P0[0]+P0[1]); \
    GAPA(C0=__builtin_amdgcn_mfma_f32_32x32x16_bf16(kf[0],qr[0],negm,0,0,0), P0[2],P0[3],P0[4],P0[5],     pw0[0]=PKW(P0,0), pw0[1]=PKW(P0,2), pw0); \
    VRD(4); SBAR(); GAPA(C1=__builtin_amdgcn_mfma_f32_32x32x16_bf16(kf[1],qr[0],negm,0,0,0), P0[6],P0[7],P0[8],P0[9],     pw0[2]=PKW(P0,4), pw0[3]=PKW(P0,6), pw0); \
    VRD(1); SBAR(); GAPA(C0=__builtin_amdgcn_mfma_f32_32x32x16_bf16(kf[2],qr[1],C0,0,0,0),   P0[10],P0[11],P0[12],P0[13], pw1[0]=PKW(P0,8), pw1[1]=PKW(P0,10), pw1); \
    VRD(5); SBAR(); GAPA(C1=__builtin_amdgcn_mfma_f32_32x32x16_bf16(kf[3],qr[1],C1,0,0,0),   P0[14],P0[15],P1[0],P1[1],   pw1[2]=PKW(P0,12),pw1[3]=PKW(P0,14), pw1); \
    VRD(2); SBAR(); GAPA(C0=__builtin_amdgcn_mfma_f32_32x32x16_bf16(kf[4],qr[2],C0,0,0,0),   P1[2],P1[3],P1[4],P1[5],     pw2[0]=PKW(P1,0), pw2[1]=PKW(P1,2), pw2); \
    VRD(6); SBAR(); GAPA(C1=__builtin_amdgcn_mfma_f32_32x32x16_bf16(kf[5],qr[2],C1,0,0,0),   P1[6],P1[7],P1[8],P1[9],     pw2[2]=PKW(P1,4), pw2[3]=PKW(P1,6), pw2); \
    VRD(3); SBAR(); GAPA(C0=__builtin_amdgcn_mfma_f32_32x32x16_bf16(kf[6],qr[3],C0,0,0,0),   P1[10],P1[11],P1[12],P1[13], pw3[0]=PKW(P1,8), pw3[1]=PKW(P1,10), pw3); \
    VRD(7); SBAR(); GAPA(C1=__builtin_amdgcn_mfma_f32_32x32x16_bf16(kf[7],qr[3],C1,0,0,0),   P1[14],P1[15],0.f,0.f,       pw3[2]=PKW(P1,12),pw3[3]=PKW(P1,14), pw3); \
    l_reg+=sacc; \
    if(GK){DMA_K((t)+3,sl_cur);} if(GV){DMA_V((t)+1,sl_next);} \
    CMASK(C0,C1,t); \
    { float a=MX3(C0[0],C0[1],C1[0]),b=MX3(C0[2],C0[3],C1[1]); a=MX3(a,C1[2],C1[3]); \
      _Pragma("unroll") for(int r=4;r<16;r+=4){a=MX3(a,C0[r],C0[r+1]);b=MX3(b,C0[r+2],C0[r+3]);a=MX3(a,C1[r],C1[r+1]);b=MX3(b,C1[r+2],C1[r+3]);} \
      float rm=__builtin_fmaxf(a,b); { auto rr=__builtin_amdgcn_permlane32_swap(__float_as_uint(rm),__float_as_uint(rm),false,false); rm=__builtin_fmaxf(__uint_as_float(rr[0]),__uint_as_float(rr[1])); } \
      resc=false; \
      if(__builtin_expect(__any(rm>(float)THRL),0)){ const float dl=__builtin_fmaxf(rm,0.f); mhat+=dl; \
        _Pragma("unroll") for(int r=0;r<16;++r){C0[r]-=dl;C1[r]-=dl;} \
        _Pragma("unroll") for(int r=0;r<16;++r)negm[r]=-mhat; asm volatile("":"+v"(negm)); \
        const float f=__builtin_amdgcn_exp2f(-dl); l_reg*=f; if(hi==0)wsf[r32]=f; resc=true; } } \
    SBAR(); \
    GAPB(o[0]=__builtin_amdgcn_mfma_f32_32x32x16_bf16(PAF(0),VFR(0),o[0],0,0,0), C0,0); \
    GAPB(o[1]=__builtin_amdgcn_mfma_f32_32x32x16_bf16(PAF(0),VFR(4),o[1],0,0,0), C0,4); \
    KRD(GL,0); GAPB(o[0]=__builtin_amdgcn_mfma_f32_32x32x16_bf16(PAF(1),VFR(1),o[0],0,0,0), C0,8); \
    KRD(GL,1); GAPB(o[1]=__builtin_amdgcn_mfma_f32_32x32x16_bf16(PAF(1),VFR(5),o[1],0,0,0), C0,12); \
    KRD(GL,2); GAPB(o[0]=__builtin_amdgcn_mfma_f32_32x32x16_bf16(PAF(2),VFR(2),o[0],0,0,0), C1,0); \
    KRD(GL,3); GAPB(o[1]=__builtin_amdgcn_mfma_f32_32x32x16_bf16(PAF(2),VFR(6),o[1],0,0,0), C1,4); \
    GAPB(o[0]=__builtin_amdgcn_mfma_f32_32x32x16_bf16(PAF(3),VFR(3),o[0],0,0,0), C1,8); \
    GAPB(o[1]=__builtin_amdgcn_mfma_f32_32x32x16_bf16(PAF(3),VFR(7),o[1],0,0,0), C1,12); \
    }while(0)
  int t=1;
  #undef CMASK
  #define CMASK(P0,P1,t) do{}while(0)
  for(;t+5<NT;t+=2){
    STEP(pB0,pB1,pA0,pA1,t,true,true,true);     WAIT_BAR(2); RESC(); ROT();
    STEP(pA0,pA1,pB0,pB1,t+1,true,true,true);   WAIT_BAR(2); RESC(); ROT();
  }
  #undef CMASK
  #define CMASK(P0,P1,t) do{int jb_=(t)-(NT-4); if(jb_>=0)cmask(P0,P1,jb_,qrel,hi);}while(0)
  #define ENDW(tt) do{ if((tt)+3<NT){WAIT_BAR(2);} else if((tt)+2<NT){WAIT_BAR(1);} else {WAIT_BAR(0);} }while(0)
  for(;t+1<NT;t+=2){
    STEP(pB0,pB1,pA0,pA1,t,(t+3<NT),(t+1<NT),(t+1<NT));       ENDW(t);   RESC(); ROT();
    STEP(pA0,pA1,pB0,pB1,t+1,(t+4<NT),(t+2<NT),(t+2<NT));     ENDW(t+1); RESC(); ROT();
  }
  STEP(pB0,pB1,pA0,pA1,NT-1,false,false,false); RESC();
  { float sacc=pB0[0]+pB0[1]; _Pragma("unroll") for(int r=2;r<16;++r)sacc+=pB0[r]; _Pragma("unroll") for(int r=0;r<16;++r)sacc+=pB1[r]; l_reg+=sacc;
    pw0=(u32x4){PKW(pB0,0),PKW(pB0,2),PKW(pB0,4),PKW(pB0,6)};pw1=(u32x4){PKW(pB0,8),PKW(pB0,10),PKW(pB0,12),PKW(pB0,14)};pw2=(u32x4){PKW(pB1,0),PKW(pB1,2),PKW(pB1,4),PKW(pB1,6)};pw3=(u32x4){PKW(pB1,8),PKW(pB1,10),PKW(pB1,12),PKW(pB1,14)};
    SBAR(); pv(o,vb0+sl_cur,PAF(0),PAF(1),PAF(2),PAF(3)); }
  #undef PKW
  #undef PAF
  #undef VFR
  #undef PIN
  #undef MX3
  #undef GAPA
  #undef GAPB
  #undef EX
  #undef VRD
  #undef KRD
  #undef STEP
  #undef ENDW
  {auto rr=__builtin_amdgcn_permlane32_swap(__float_as_uint(l_reg),__float_as_uint(l_reg),false,false);l_reg=__uint_as_float(rr[0])+__uint_as_float(rr[1]);}
  if(hi==0)wsf[32+r32]=l_reg;asm volatile("s_waitcnt lgkmcnt(0)":::"memory");
  float rli[16];
  #pragma unroll
  for(int r=0;r<16;++r)rli[r]=__builtin_amdgcn_rcpf(wsf[32+crow(r,hi)]);
  bf16*Ow=O+(rowbase+q0+wid*QBLK)*DM+h*D;
  { bf16*stg=(bf16*)(shm+LDS_OST)+wid*2048;
    #pragma unroll
    for(int r=0;r<16;++r){const int orow=crow(r,hi);
      #pragma unroll
      for(int d0=0;d0<2;++d0)stg[orow*64+d0*32+r32]=__float2bfloat16(o[d0][r]*rli[r]);}
    asm volatile("s_waitcnt lgkmcnt(0)":::"memory");
    #pragma unroll
    for(int i=0;i<4;++i){const int row=i*8+(lane>>3),ch=lane&7; const u32x4 v=*(const u32x4*)(stg+row*64+ch*8); ATTN_STORE16(Ow+(long)row*DM+ch*8,v);} }
  asm volatile("s_waitcnt lgkmcnt(0)\n\ts_barrier":::"memory");
  #undef DMA_K
  #undef DMA_V
  #undef CMASK
  #undef START
  #undef RESC
  #undef ROT
}
constexpr int ATTN_LDS_BYTES=LDS_BYTES;
struct AttnTensors { const bf16* Q; const bf16* K; const bf16* V; bf16* O; };
struct AttnUnit { int bh; int qb; };
struct StaticOrder {
  int vcu;
  __device__ __forceinline__ explicit StaticOrder(int grid,int block):vcu((block%8)*(grid/8)+block/8){}
  __device__ __forceinline__ bool next(int i,AttnUnit&u)const{ if(i>=4||vcu>=256)return false; const int s=vcu&3; u.bh=vcu>>2; u.qb=(i==0)?s:(i==1)?7-s:(i==2)?8+s:15-s; return true; }
  __device__ __forceinline__ void a_ready(const AttnUnit&)const{}
  __device__ __forceinline__ void done(const AttnUnit&)const{}
};
template<class Sched,int THRL=8> __device__ __forceinline__ void attn_phase(char*lds,const AttnTensors&T,const Sched&S){
  AttnUnit u;
  for(int i=0;S.next(i,u);++i){ S.a_ready(u); attn_unit<THRL>(u.bh/NHEAD,u.bh%NHEAD,u.qb,T.Q,T.K,T.V,T.O,lds); S.done(u); }
}
#undef SBAR
#undef WAIT_BAR
}

#ifndef EMU
#define DEV __device__ __forceinline__
typedef unsigned short bf16_t;
typedef short bf16x8 __attribute__((ext_vector_type(8)));
typedef float f32x4 __attribute__((ext_vector_type(4)));
DEV void wave_sync() { __builtin_amdgcn_wave_barrier(); }
#define RW_BAR() do { asm volatile("s_waitcnt lgkmcnt(0)" ::: "memory"); __builtin_amdgcn_s_barrier(); asm volatile("" ::: "memory"); } while (0)
DEV f32x4 mfma16(bf16x8 a, bf16x8 b, f32x4 c) { return __builtin_amdgcn_mfma_f32_16x16x32_bf16(a, b, c, 0, 0, 0); }
#endif
#ifdef EMU
#define RW_LAS
#define RW_OPAQUE(v_)
#else
#define RW_OPAQUE(v_) asm volatile("" : "+v"(v_))
#define RW_LAS __attribute__((address_space(3)))
#endif
#ifdef EMU
#define RW_BAR() __syncthreads()
#endif
typedef unsigned u32x2 __attribute__((ext_vector_type(2)));
typedef unsigned u32x4v __attribute__((ext_vector_type(4)));

#ifdef EMU
DEV unsigned f2bf(float f) { unsigned u = __builtin_bit_cast(unsigned, f); return (u + 0x7fffu + ((u >> 16) & 1u)) >> 16; }
DEV unsigned pk2bf(float lo, float hi) { return f2bf(lo) | (f2bf(hi) << 16); }
#else
DEV unsigned pk2bf(float lo, float hi) { typedef float f2_ __attribute__((ext_vector_type(2))); typedef __bf16 b2_ __attribute__((ext_vector_type(2))); const f2_ v = {lo, hi}; const b2_ b = __builtin_convertvector(v, b2_); return __builtin_bit_cast(unsigned, b); }
DEV unsigned f2bf(float f) { return pk2bf(f, 0.f) & 0xffffu; }
#endif
DEV float bf2f(unsigned h) { return __builtin_bit_cast(float, h << 16); }

constexpr int RW_NPROJ = 3328, RW_PB0 = 1536, RW_T = 4096, RW_MP = 16384;
constexpr int RW_LD = 72;
constexpr int RW_SLOT = 64 * RW_LD * 2;
constexpr int RW_LDF = 68;

struct RwkvP {
    const bf16_t* proj;
    const float* mu;
    const float *w0, *a0, *k_k, *k_a, *r_k, *ln_w, *ln_b;
    const float *w2, *a2, *g2;
    const bf16_t *w2t, *a2t, *g2t;
    const float* state_wkv; const float* state_shift;
    bf16_t* MT; float* NN; bf16_t* QQ; float* Y0; bf16_t* SC;
    bf16_t* VG; bf16_t* GG; float* BON;
    bf16_t* mixin;
    const bf16_t* XL; const bf16_t* XH;
    float* wkv_p; float* wkv_s;
};

DEV bf16x8 ld8(const bf16_t* p) { return *(const bf16x8*)p; }
DEV u32x2 ld4(const bf16_t* p) { return *(const u32x2*)p; }
DEV void st4(bf16_t* p, u32x2 w) { *(u32x2*)p = w; }
DEV void st1(bf16_t* p, unsigned h) { *p = (bf16_t)h; }
#ifndef EMU
DEV bf16x8 ld8(const RW_LAS bf16_t* p) { return *(const RW_LAS bf16x8*)p; }
DEV u32x2 ld4(const RW_LAS bf16_t* p) { return *(const RW_LAS u32x2*)p; }
DEV void st4(RW_LAS bf16_t* p, u32x2 w) { *(RW_LAS u32x2*)p = w; }
DEV void st1(RW_LAS bf16_t* p, unsigned h) { *p = (bf16_t)h; }
#endif
template <bool SX = false, bool SY = false, class XP, class YP>
DEV f32x4 mm_tile(XP X, int ldx, int m0, YP Y, int ldy, int n0, int K, f32x4 acc, int lane, int kbeg = 0) {
    const int xr = m0 + (lane & 15), yr = n0 + (lane & 15);
    XP xp = X + xr * ldx; YP yp = Y + yr * ldy;
    const int xs = SX ? ((xr >> 3) & 7) : 0, ys = SY ? ((yr >> 3) & 7) : 0;
    for (int k0 = kbeg; k0 < kbeg + K; k0 += 32) {
        const int kb = (k0 >> 3) + (lane >> 4);
        const bf16x8 xf = ld8(xp + 8 * (kb ^ xs)), yf = ld8(yp + 8 * (kb ^ ys));
        acc = mfma16(yf, xf, acc);
    }
    return acc;
}
template <class DP> DEV void st_rm(DP D, int ld, int m0, int n0, f32x4 v, int lane) {
    u32x2 w; w.x = pk2bf(v[0], v[1]); w.y = pk2bf(v[2], v[3]);
    st4(D + (m0 + (lane & 15)) * ld + n0 + 4 * (lane >> 4), w);
}
template <class DP> DEV void st_tr(DP D, int ld, int m0, int n0, f32x4 v, int lane) {
#pragma unroll
    for (int r = 0; r < 4; ++r) st1(D + (n0 + 4 * (lane >> 4) + r) * ld + m0 + (lane & 15), f2bf(v[r]));
}
template <class SP> DEV f32x4 ld_rm(SP S, int ld, int m0, int n0, int lane) {
    const u32x2 w = ld4(S + (m0 + (lane & 15)) * ld + n0 + 4 * (lane >> 4));
    return (f32x4){bf2f(w.x & 0xffffu), bf2f(w.x >> 16), bf2f(w.y & 0xffffu), bf2f(w.y >> 16)};
}
#ifdef EMU
DEV float dpp_q1(float v, int lane) { return __shfl(v, lane ^ 1); }
DEV float dpp_q2(float v, int lane) { return __shfl(v, lane ^ 2); }
DEV float dpp_hm(float v, int lane) { return __shfl(v, (lane & ~7) | (7 - (lane & 7))); }
DEV float dpp_rm(float v, int lane) { return __shfl(v, (lane & ~15) | (15 - (lane & 15))); }
DEV float dpp_x8(float v, int lane) { return __shfl(v, lane ^ 8); }
DEV float sum_x32(float v, int lane) { return v + __shfl(v, lane ^ 32); }
#else
DEV float dpp_q1(float v, int) { return __builtin_bit_cast(float, __builtin_amdgcn_update_dpp(0, __builtin_bit_cast(int, v), 0xB1, 0xF, 0xF, true)); }
DEV float dpp_q2(float v, int) { return __builtin_bit_cast(float, __builtin_amdgcn_update_dpp(0, __builtin_bit_cast(int, v), 0x4E, 0xF, 0xF, true)); }
DEV float dpp_hm(float v, int) { return __builtin_bit_cast(float, __builtin_amdgcn_update_dpp(0, __builtin_bit_cast(int, v), 0x141, 0xF, 0xF, true)); }
DEV float dpp_rm(float v, int) { return __builtin_bit_cast(float, __builtin_amdgcn_update_dpp(0, __builtin_bit_cast(int, v), 0x140, 0xF, 0xF, true)); }
DEV float dpp_x8(float v, int) { return __builtin_bit_cast(float, __builtin_amdgcn_update_dpp(0, __builtin_bit_cast(int, v), 0x128, 0xF, 0xF, true)); }
DEV float sum_x32(float v, int) { return v + __shfl_xor(v, 32); }
#endif
#ifdef EMU
DEV float dpp_shr(float v, int n, int lane) { const float o = __shfl(v, (lane - n) & 63); return (lane & 15) >= n ? o : 0.f; }
#else
template <int N> DEV float dpp_shr_(float v) { return __builtin_bit_cast(float, __builtin_amdgcn_update_dpp(0, __builtin_bit_cast(int, v), 0x110 + N, 0xF, 0xF, true)); }
DEV float dpp_shr(float v, int n, int) { return n == 1 ? dpp_shr_<1>(v) : (n == 2 ? dpp_shr_<2>(v) : (n == 4 ? dpp_shr_<4>(v) : dpp_shr_<8>(v))); }
#endif
DEV float rscan16(float v, int lane) { v += dpp_shr(v, 1, lane); v += dpp_shr(v, 2, lane); v += dpp_shr(v, 4, lane); v += dpp_shr(v, 8, lane); return v; }
DEV float rsum16(float v, int lane) { v += dpp_q1(v, lane); v += dpp_q2(v, lane); v += dpp_hm(v, lane); v += dpp_rm(v, lane); return v; }
DEV float wsum64d(float v, int lane) { v = rsum16(v, lane); v += __shfl_xor(v, 16); return sum_x32(v, lane); }
#ifdef EMU
DEV float rcpf_(float x) { return 1.f / x; }
DEV float rsqf_(float x) { return 1.f / sqrtf(x); }
DEV float logf_(float x) { return logf(x); }
#else
DEV float rcpf_(float x) { return __builtin_amdgcn_rcpf(x); }
DEV float rsqf_(float x) { return __builtin_amdgcn_rsqf(x); }
DEV float logf_(float x) { return __logf(x); }
#endif
DEV float sigmoidf_(float x) { return rcpf_(1.f + __expf(-x)); }
DEV float tanhf_(float x) { const float e = __expf(-2.f * fabsf(x)); const float t = (1.f - e) * rcpf_(1.f + e); return x < 0.f ? -t : t; }
DEV float softplusf_(float x) { return fmaxf(x, 0.f) + logf_(1.f + __expf(-fabsf(x))); }

struct RwkvGrp { f32x4 pm[2], ll[2];
    bf16x8 xf[8]; u32x4v pr, pk, pvv;
    bf16x8 yw[2][2], ya[2][2], yg[2][4];
    f32x4 dq[2], dy[2];
};
DEV void rw_prefetch(RwkvGrp& g, const RwkvP& p, int b, int h, int c) {
    int tid = threadIdx.x; RW_OPAQUE(tid); const int lane = tid & 63, wid = tid >> 6, mi = wid >> 1; const int r0 = b * RW_T + c * 64;
    const bf16_t* xh = p.XH + ((size_t)(r0 + (tid >> 3)) * 8 + h) * 192 + (tid & 7) * 8;
    g.pr = *(const u32x4v*)xh; g.pk = *(const u32x4v*)(xh + 64); g.pvv = *(const u32x4v*)(xh + 128);
    const bf16_t* xl = p.XL + (size_t)(r0 + 16 * mi + (lane & 15)) * 256 + 8 * (lane >> 4);
#pragma unroll
    for (int j = 0; j < 8; ++j) g.xf[j] = *(const bf16x8*)(xl + 32 * j);
}
DEV void rw_weights(RwkvGrp& g, const RwkvP& p, int h) {
    int tid = threadIdx.x; RW_OPAQUE(tid); const int lane = tid & 63, wid = tid >> 6;
#pragma unroll
    for (int q = 0; q < 2; ++q) { const int nrow = h * 64 + 16 * (2 * (wid & 1) + q) + (lane & 15);
#pragma unroll
        for (int j = 0; j < 2; ++j) { g.yw[q][j] = *(const bf16x8*)(p.w2t + (size_t)nrow * 64 + 32 * j + 8 * (lane >> 4)); g.ya[q][j] = *(const bf16x8*)(p.a2t + (size_t)nrow * 64 + 32 * j + 8 * (lane >> 4)); }
#pragma unroll
        for (int j = 0; j < 4; ++j) g.yg[q][j] = *(const bf16x8*)(p.g2t + (size_t)nrow * 128 + 32 * j + 8 * (lane >> 4)); }
}
#if defined(PROBE_A) && !defined(EMU)
#define RW_TICK(k) do { if (threadIdx.x == 0) { volatile RW_LAS unsigned long long* A_ = (volatile RW_LAS unsigned long long*)(lds + 147456 + 2048); const unsigned long long n_ = __builtin_amdgcn_s_memrealtime(); if ((k) > 0) A_[k] += n_ - A_[0]; A_[0] = n_; } } while (0)
#else
#define RW_TICK(k) do { } while (0)
#endif
DEV void rwkv_passA(const RwkvP& p, int b, int h, int c, RW_LAS unsigned char* lds, RwkvGrp& gs, bool first, bool last) {
    int tid = threadIdx.x; RW_OPAQUE(tid); int lane = tid & 63, wid = tid >> 6;
#define RW_STAGE() { tid = threadIdx.x; RW_OPAQUE(tid); lane = tid & 63; wid = tid >> 6; mi = wid >> 1; mrow = 16 * mi + (lane & 15); }
    int mi = wid >> 1, mrow = 16 * mi + (lane & 15);
    const int r0 = b * RW_T + c * 64;
    const int ch = c * 32 + b * 8 + h;
#define SL(i) ((RW_LAS bf16_t*)(lds + (i) * RW_SLOT))
    RW_LAS bf16_t *AT = SL(0), *KH = SL(2), *BH = SL(3), *RT = SL(4), *VT = SL(5), *KTT = SL(6), *BTT = SL(7);
    RW_LAS float* LW = (RW_LAS float*)(lds + 8 * RW_SLOT); RW_LAS float* LA = LW + 64 * RW_LDF; RW_LAS float* LC = LA + 64 * RW_LDF;
    RW_LAS bf16_t *AAK = SL(8), *P0 = SL(9), *ARK = SL(11), *ARB = SL(12);
    RW_LAS float* PCV = (RW_LAS float*)(lds + 16 * RW_SLOT + 512);
    RW_TICK(0);
    RW_LAS float* CST = (RW_LAS float*)(lds + 16 * RW_SLOT + 2560);
    if (first) { rw_weights(gs, p, h); rw_prefetch(gs, p, b, h, c);
        if (tid < 320) { const int wch = tid >> 6, d = tid & 63; const float* src = wch == 0 ? p.w0 : (wch == 1 ? p.a0 : (wch == 2 ? p.k_k : (wch == 3 ? p.k_a : p.r_k))); CST[tid] = src[h * 64 + d]; }
        RW_BAR(); }
    { RW_STAGE()
#pragma unroll
        for (int q = 0; q < 2; ++q) {
            const int ni = 2 * (wid & 1) + q; const f32x4 z = {0.f, 0.f, 0.f, 0.f};
            f32x4 aw = mfma16(gs.yw[q][0], gs.xf[0], z); aw = mfma16(gs.yw[q][1], gs.xf[1], aw);
            f32x4 aa = mfma16(gs.ya[q][0], gs.xf[2], z); aa = mfma16(gs.ya[q][1], gs.xf[3], aa);
            f32x4 ag = mfma16(gs.yg[q][0], gs.xf[4], z); ag = mfma16(gs.yg[q][1], gs.xf[5], ag); ag = mfma16(gs.yg[q][2], gs.xf[6], ag); ag = mfma16(gs.yg[q][3], gs.xf[7], ag);
            const int t = 16 * mi + (lane & 15), d0 = 16 * ni + 4 * (lane >> 4);
            f32x4 lw, la;
            const f32x4 cw0 = *(const RW_LAS f32x4*)(CST + d0), ca0 = *(const RW_LAS f32x4*)(CST + 64 + d0);
#pragma unroll
            for (int r = 0; r < 4; ++r) {
                const float wraw = -softplusf_(-(cw0[r] + aw[r])) - 0.5f; lw[r] = -__expf(wraw);
                la[r] = sigmoidf_(ca0[r] + aa[r]); }
            *(RW_LAS f32x4*)(LW + t * RW_LDF + d0) = lw; *(RW_LAS f32x4*)(LA + t * RW_LDF + d0) = la;
            f32x4 lc;
#pragma unroll
            for (int r = 0; r < 4; ++r) lc[r] = rscan16(lw[r], lane);
            *(RW_LAS f32x4*)(LC + t * RW_LDF + d0) = lc;
            if ((lane & 15) == 15) *(RW_LAS f32x4*)((RW_LAS float*)(lds + 14 * RW_SLOT) + mi * 64 + d0) = lc;
            u32x2 gw; gw.x = pk2bf(ag[0], ag[1]); gw.y = pk2bf(ag[2], ag[3]);
            *(u32x2*)(p.GG + (size_t)(r0 + t) * 512 + h * 64 + d0) = gw;
        }
    }
    RW_BAR();
    RW_TICK(1);
    RW_TICK(2);
    { RW_STAGE()
        const int t = tid >> 3, dg = tid & 7, d0 = dg * 8, hd0 = h * 64 + d0;
        float r[8], k[8], v[8], kk[8], a[8], lw[8], L[8], L63[8];
        { const unsigned wr_[4] = {gs.pr.x, gs.pr.y, gs.pr.z, gs.pr.w}, wk_[4] = {gs.pk.x, gs.pk.y, gs.pk.z, gs.pk.w}, wv_[4] = {gs.pvv.x, gs.pvv.y, gs.pvv.z, gs.pvv.w};
#pragma unroll
          for (int i = 0; i < 4; ++i) { r[2 * i] = bf2f(wr_[i] & 0xffffu); r[2 * i + 1] = bf2f(wr_[i] >> 16); k[2 * i] = bf2f(wk_[i] & 0xffffu); k[2 * i + 1] = bf2f(wk_[i] >> 16); v[2 * i] = bf2f(wv_[i] & 0xffffu); v[2 * i + 1] = bf2f(wv_[i] >> 16); } }
#pragma unroll
        for (int q = 0; q < 2; ++q) {
            const f32x4 x1 = *(const RW_LAS f32x4*)(LW + t * RW_LDF + d0 + 4 * q), x3 = *(const RW_LAS f32x4*)(LA + t * RW_LDF + d0 + 4 * q);
            f32x4 x2 = *(const RW_LAS f32x4*)(LC + t * RW_LDF + d0 + 4 * q), x4 = {0.f, 0.f, 0.f, 0.f};
#pragma unroll
            for (int bb = 0; bb < 4; ++bb) { const f32x4 tt = *(const RW_LAS f32x4*)((const RW_LAS float*)(lds + 14 * RW_SLOT) + bb * 64 + d0 + 4 * q); x4 = x4 + tt; if (bb < (t >> 4)) x2 = x2 + tt; }
#pragma unroll
            for (int e = 0; e < 4; ++e) { lw[4 * q + e] = x1[e]; L[4 * q + e] = x2[e]; a[4 * q + e] = x3[e]; L63[4 * q + e] = x4[e]; }
        }
        float n2 = 0.f, bon = 0.f; float k2[8];
#pragma unroll
        for (int e = 0; e < 8; ++e) { kk[e] = k[e] * CST[128 + d0 + e]; n2 += kk[e] * kk[e]; k2[e] = k[e] * (1.f + (a[e] - 1.f) * CST[192 + d0 + e]); bon += r[e] * k2[e] * CST[256 + d0 + e]; }
        n2 += dpp_q1(n2, lane); n2 += dpp_q2(n2, lane); n2 += dpp_hm(n2, lane);
        bon += dpp_q1(bon, lane); bon += dpp_q2(bon, lane); bon += dpp_hm(bon, lane);
        const float inv = rsqf_(fmaxf(n2, 1e-24f));
        if (dg == 0) p.BON[(size_t)(r0 + t) * 8 + h] = bon;
        { u32x4v w; w.x = pk2bf(v[0], v[1]); w.y = pk2bf(v[2], v[3]); w.z = pk2bf(v[4], v[5]); w.w = pk2bf(v[6], v[7]); *(u32x4v*)(p.VG + (size_t)(r0 + t) * 512 + hd0) = w; }
        float at[8], kh[8], bh[8], rt[8], kt[8], bt[8];
#pragma unroll
        for (int e = 0; e < 8; ++e) { kk[e] *= inv; const float P = __expf(L[e]), Pi = __expf(-L[e]), Pm1 = __expf(L[e] - lw[e]), Pc = __expf(L63[e] - L[e]); const float bb = kk[e] * a[e];
            at[e] = -kk[e] * Pm1; kh[e] = k2[e] * Pi; bh[e] = bb * Pi; rt[e] = r[e] * P; kt[e] = k2[e] * Pc; bt[e] = bb * Pc; }
#define RW_ST8(D, ARR_) { u32x4v w_; w_.x = pk2bf(ARR_[0], ARR_[1]); w_.y = pk2bf(ARR_[2], ARR_[3]); w_.z = pk2bf(ARR_[4], ARR_[5]); w_.w = pk2bf(ARR_[6], ARR_[7]); *(RW_LAS u32x4v*)(D + t * RW_LD + d0) = w_; }
        RW_ST8(AT, at) RW_ST8(KH, kh) RW_ST8(BH, bh) RW_ST8(RT, rt)
#undef RW_ST8
        { const int tsw = t ^ (8 * dg);
#pragma unroll
          for (int e = 0; e < 8; ++e) { VT[(d0 + e) * RW_LD + tsw] = (bf16_t)f2bf(v[e]); KTT[(d0 + e) * RW_LD + tsw] = (bf16_t)f2bf(kt[e]); BTT[(d0 + e) * RW_LD + tsw] = (bf16_t)f2bf(bt[e]); } }
        if (t == 0) {
#pragma unroll
            for (int e = 0; e < 8; ++e) PCV[d0 + e] = __expf(L63[e]); }
    }
    RW_BAR();
    if (!first) {
        RW_STAGE()
        const int chp = (c - 1) * 32 + b * 8 + h; bf16_t* gQp = p.QQ + (size_t)chp * 4096; float* gYp = p.Y0 + (size_t)chp * 4096;
#pragma unroll
        for (int q = 0; q < 2; ++q) { const int ni = 2 * (wid & 1) + q; st_rm(gQp, 64, 16 * mi, 16 * ni, gs.dq[q], lane); *(f32x4*)(gYp + mrow * 64 + 16 * ni + 4 * (lane >> 4)) = gs.dy[q]; }
    }
    if (!last) rw_prefetch(gs, p, b, h, c + 1);
    RW_TICK(3);
    const f32x4 z4 = {0.f, 0.f, 0.f, 0.f};
    RW_STAGE()
    RW_LAS bf16_t *POFF = SL(10), *DD = SL(13), *WT = SL(3), *UT = SL(2);
#pragma unroll
    for (int q = 0; q < 2; ++q) {
        const int ni = 2 * (wid & 1) + q, nc0 = 16 * ni + 4 * (lane >> 4);
        f32x4 ak = mm_tile(AT, RW_LD, 16 * mi, KH, RW_LD, 16 * ni, 64, z4, lane);
        f32x4 ab = mm_tile(AT, RW_LD, 16 * mi, BH, RW_LD, 16 * ni, 64, z4, lane);
        f32x4 rk = mm_tile(RT, RW_LD, 16 * mi, KH, RW_LD, 16 * ni, 64, z4, lane);
        f32x4 rb = mm_tile(RT, RW_LD, 16 * mi, BH, RW_LD, 16 * ni, 64, z4, lane);
#pragma unroll
        for (int r = 0; r < 4; ++r) { const int n = nc0 + r; if (!(n < mrow)) { ak[r] = 0.f; ab[r] = 0.f; } if (!(n <= mrow)) { rk[r] = 0.f; rb[r] = 0.f; } }
        st_rm(AAK, RW_LD, 16 * mi, 16 * ni, ak, lane); st_rm(P0, RW_LD, 16 * mi, 16 * ni, ab, lane); st_rm(POFF, RW_LD, 16 * mi, 16 * ni, mi == ni ? z4 : ab, lane);
        st_rm(ARK, RW_LD, 16 * mi, 16 * ni, rk, lane); st_rm(ARB, RW_LD, 16 * mi, 16 * ni, rb, lane);
    }
    for (int i = tid; i < RW_SLOT / 4; i += 512) ((RW_LAS unsigned*)DD)[i] = 0u;
    RW_BAR();
    RW_TICK(4);
    RW_STAGE()
    if (wid == 0) {
        const int bi = lane >> 4, col = lane & 15; float x[16];
#pragma unroll
        for (int j = 0; j < 16; ++j) {
            float sacc = (j == col) ? 1.f : 0.f;
            if (j > 0) { const RW_LAS bf16_t* arow = P0 + (16 * bi + j) * RW_LD + 16 * bi;
                const bf16x8 a0 = ld8(arow), a1 = ld8(arow + 8);
#pragma unroll
                for (int k = 0; k < 16; ++k) if (k < j) sacc += bf2f((unsigned)(unsigned short)(k < 8 ? a0[k & 7] : a1[k & 7])) * x[k]; }
            x[j] = sacc;
        }
#pragma unroll
        for (int j = 0; j < 16; ++j) st1(DD + (16 * bi + j) * RW_LD + 16 * bi + col, f2bf(x[j]));
    } else {
        for (int i = tid - 64; i < 2 * RW_SLOT / 4; i += 448) { ((RW_LAS unsigned*)SL(2))[i] = 0u; ((RW_LAS unsigned*)SL(14))[i] = 0u; }
    }
    RW_BAR();
    RW_STAGE()
    {
        const int sx = wid & 3, kind = wid >> 2; RW_LAS bf16_t* OUT = kind ? UT : WT; RW_LAS bf16_t* SCR = SL(14) + wid * (16 * RW_LD);
#pragma unroll
        for (int i = 0; i < 4; ++i) {
            f32x4 acc = kind ? mm_tile<false, true>(AAK, RW_LD, 16 * i, VT, RW_LD, 16 * sx, 64, z4, lane) : ld_rm(AT, RW_LD, 16 * i, 16 * sx, lane);
            if (i > 0) acc = mm_tile(POFF, RW_LD, 16 * i, OUT, RW_LD, 16 * sx, i == 3 ? 64 : 32, acc, lane);
            st_tr(SCR, RW_LD, 16 * i, 0, acc, lane);
            wave_sync();
            const f32x4 xo = mm_tile(DD, RW_LD, 16 * i, SCR, RW_LD, 0, 32, z4, lane, 32 * (i >> 1));
            st_tr(OUT, RW_LD, 16 * i, 16 * sx, xo, lane);
            wave_sync();
        }
    }
    RW_BAR();
    RW_TICK(5);
    RW_TICK(6);
    f32x4 y0r[2], nnr[2];
    RW_STAGE()
    if (first) {
#pragma unroll
        for (int q = 0; q < 2; ++q) { const int nc0 = 16 * (2 * (wid & 1) + q) + 4 * (lane >> 4);
#pragma unroll
            for (int r = 0; r < 4; ++r) gs.pm[q][r] = (nc0 + r == mrow) ? 1.f : 0.f;
            gs.ll[q] = z4; }
    }
#pragma unroll
    for (int q = 0; q < 2; ++q) {
        const int ni = 2 * (wid & 1) + q, nc0 = 16 * ni + 4 * (lane >> 4);
        const f32x4 qq = mm_tile(ARB, RW_LD, 16 * mi, WT, RW_LD, 16 * ni, 64, ld_rm(RT, RW_LD, 16 * mi, 16 * ni, lane), lane);
        st_rm(SL(0), RW_LD, 16 * mi, 16 * ni, qq, lane);
        y0r[q] = mm_tile<false, true>(ARK, RW_LD, 16 * mi, VT, RW_LD, 16 * ni, 64, z4, lane); y0r[q] = mm_tile(ARB, RW_LD, 16 * mi, UT, RW_LD, 16 * ni, 64, y0r[q], lane);
        f32x4 mt = mm_tile<true, false>(BTT, RW_LD, 16 * mi, WT, RW_LD, 16 * ni, 64, z4, lane);
#pragma unroll
        for (int r = 0; r < 4; ++r) if (nc0 + r == mrow) mt[r] += PCV[mrow];
        st_rm(SL(1), RW_LD, 16 * mi, 16 * ni, mt, lane);
        nnr[q] = mm_tile<true, true>(VT, RW_LD, 16 * mi, KTT, RW_LD, 16 * ni, 64, z4, lane); nnr[q] = mm_tile<false, true>(UT, RW_LD, 16 * mi, BTT, RW_LD, 16 * ni, 64, nnr[q], lane);
        st_rm(SL(14), RW_LD, 16 * mi, 16 * ni, gs.pm[q], lane); st_rm(SL(15), RW_LD, 16 * mi, 16 * ni, gs.ll[q], lane);
    }
    RW_BAR();
    RW_TICK(7);
    { RW_STAGE()
        bf16_t* gQ = p.QQ + (size_t)ch * 4096; float* gY0 = p.Y0 + (size_t)ch * 4096;
#pragma unroll
        for (int q = 0; q < 2; ++q) {
            const int ni = 2 * (wid & 1) + q, nc0 = 16 * ni + 4 * (lane >> 4);
            const f32x4 q2 = mm_tile(SL(0), RW_LD, 16 * mi, SL(14), RW_LD, 16 * ni, 64, z4, lane);
            const f32x4 y2 = mm_tile(SL(0), RW_LD, 16 * mi, SL(15), RW_LD, 16 * ni, 64, y0r[q], lane);
            if (last) { st_rm(gQ, 64, 16 * mi, 16 * ni, q2, lane); *(f32x4*)(gY0 + mrow * 64 + nc0) = y2; } else { gs.dq[q] = q2; gs.dy[q] = y2; }
            gs.pm[q] = mm_tile(SL(14), RW_LD, 16 * mi, SL(1), RW_LD, 16 * ni, 64, z4, lane);
            gs.ll[q] = mm_tile(SL(15), RW_LD, 16 * mi, SL(1), RW_LD, 16 * ni, 64, nnr[q], lane);
            if (last) {
                const size_t grp = (size_t)((c >> 3) * 32 + b * 8 + h);
                st_tr(p.MT + grp * 4096, 64, 16 * mi, 16 * ni, gs.pm[q], lane);
                *(f32x4*)(p.NN + grp * 4096 + mrow * 64 + nc0) = gs.ll[q];
            }
        }
    }
    RW_BAR();
    RW_TICK(8);
#undef SL
#undef RW_STAGE
}

constexpr int PBD = 4;
struct PbOps { bf16x8 m[4][2]; f32x4 n[4]; };
DEV void pb_load(PbOps& o, const RwkvP& p, size_t ch, int vrow, int lane) {
    const bf16_t* M = p.MT + ch * 4096 + (lane & 15) * 64 + 8 * (lane >> 4); const float* N = p.NN + ch * 4096 + vrow * 64 + 4 * (lane >> 4);
#pragma unroll
    for (int ni = 0; ni < 4; ++ni) { o.m[ni][0] = *(const bf16x8*)(M + ni * 1024); o.m[ni][1] = *(const bf16x8*)(M + ni * 1024 + 32); o.n[ni] = *(const f32x4*)(N + 16 * ni); }
}
DEV void rwkv_passB(const RwkvP& p, int b, int h, int vb, RW_LAS unsigned char* wlds, int lane, int nchunk = 8) {
    RW_LAS bf16_t* S = (RW_LAS bf16_t*)wlds;
    for (int i = lane; i < 16 * RW_LD / 2; i += 64) ((RW_LAS unsigned*)S)[i] = 0u;
    wave_sync();
    f32x4 acc[4];
#pragma unroll
    for (int ni = 0; ni < 4; ++ni) acc[ni] = (f32x4){0.f, 0.f, 0.f, 0.f};
    const int vrow = vb * 16 + (lane & 15);
    const size_t chb = (size_t)(b * 8 + h);
#define PB_CH(c_) ((size_t)(c_) * 32 + chb)
    PbOps ops[PBD];
#pragma unroll
    for (int d = 0; d < PBD; ++d) pb_load(ops[d], p, PB_CH(d < nchunk ? d : nchunk - 1), vrow, lane);
    const RW_LAS bf16_t* xp = S + (lane & 15) * RW_LD + 8 * (lane >> 4);
    for (int c0 = 0; c0 < nchunk; c0 += PBD) {
#pragma unroll
        for (int d = 0; d < PBD; ++d) {
            const int c = c0 + d; const size_t ch = PB_CH(c);
            { const int rr = lane >> 2, cc = (lane & 3) * 16;
              const u32x4v w0 = *(const RW_LAS u32x4v*)(S + rr * RW_LD + cc), w1 = *(const RW_LAS u32x4v*)(S + rr * RW_LD + cc + 8);
              bf16_t* dst = p.SC + ch * 4096 + (size_t)(vb * 16 + rr) * 64 + cc; *(u32x4v*)dst = w0; *(u32x4v*)(dst + 8) = w1; }
            const bf16x8 x0 = ld8(xp), x1 = ld8(xp + 32);
#pragma unroll
            for (int ni = 0; ni < 4; ++ni) { acc[ni] = mfma16(ops[d].m[ni][0], x0, ops[d].n[ni]); acc[ni] = mfma16(ops[d].m[ni][1], x1, acc[ni]); }
            { const int cn = c + PBD; pb_load(ops[d], p, PB_CH(cn < nchunk ? cn : nchunk - 1), vrow, lane); }
            wave_sync();
#pragma unroll
            for (int ni = 0; ni < 4; ++ni) st_rm(S, RW_LD, 0, 16 * ni, acc[ni], lane);
            wave_sync();
        }
    }
    float* out = p.wkv_p + (size_t)(b * 8 + h) * 4096;
#pragma unroll
    for (int ni = 0; ni < 4; ++ni) *(f32x4*)(out + vrow * 64 + 16 * ni + 4 * (lane >> 4)) = acc[ni];
#undef PB_CH
}

struct PcIn { bf16x8 qf[2]; f32x4 y0[4]; u32x2 vg[4], gg[4]; float bon; };
DEV void pc_load(PcIn& o, const RwkvP& p, const bf16_t* Q, const float* Y0, int r0, int h, int mi, int lane) {
    const int t = 16 * mi + (lane & 15);
    o.qf[0] = *(const bf16x8*)(Q + t * 64 + 8 * (lane >> 4)); o.qf[1] = *(const bf16x8*)(Q + t * 64 + 32 + 8 * (lane >> 4));
    o.bon = p.BON[(size_t)(r0 + t) * 8 + h];
#pragma unroll
    for (int ni = 0; ni < 4; ++ni) { const int v0 = 16 * ni + 4 * (lane >> 4), hv = h * 64 + v0;
        o.y0[ni] = *(const f32x4*)(Y0 + t * 64 + v0); o.vg[ni] = *(const u32x2*)(p.VG + (size_t)(r0 + t) * 512 + hv); o.gg[ni] = *(const u32x2*)(p.GG + (size_t)(r0 + t) * 512 + hv); }
}
DEV void pc_compute(const PcIn& in, const bf16x8 (&sf)[4][2], const RwkvP& p, int r0, int h, int mi, int lane) {
    const int t = 16 * mi + (lane & 15); f32x4 y[4];
#pragma unroll
    for (int ni = 0; ni < 4; ++ni) { y[ni] = mfma16(sf[ni][0], in.qf[0], in.y0[ni]); y[ni] = mfma16(sf[ni][1], in.qf[1], y[ni]); }
    float s = 0.f;
#pragma unroll
    for (int ni = 0; ni < 4; ++ni) s += (y[ni][0] + y[ni][1]) + (y[ni][2] + y[ni][3]);
    s += __shfl_xor(s, 16); s += __shfl_xor(s, 32);
    const float mean = s * (1.f / 64.f); float q = 0.f;
#pragma unroll
    for (int ni = 0; ni < 4; ++ni)
#pragma unroll
        for (int r = 0; r < 4; ++r) { const float d = y[ni][r] - mean; q += d * d; }
    q += __shfl_xor(q, 16); q += __shfl_xor(q, 32);
    const float rstd = rsqf_(q * (1.f / 64.f) + 64e-5f);
#pragma unroll
    for (int ni = 0; ni < 4; ++ni) {
        const int v0 = 16 * ni + 4 * (lane >> 4), hv = h * 64 + v0;
        const u32x2 vw = in.vg[ni], gw = in.gg[ni];
        const float vv[4] = {bf2f(vw.x & 0xffffu), bf2f(vw.x >> 16), bf2f(vw.y & 0xffffu), bf2f(vw.y >> 16)};
        const float gg[4] = {bf2f(gw.x & 0xffffu), bf2f(gw.x >> 16), bf2f(gw.y & 0xffffu), bf2f(gw.y >> 16)};
        const f32x4 lw = *(const f32x4*)(p.ln_w + hv), lb = *(const f32x4*)(p.ln_b + hv);
        float o[4];
#pragma unroll
        for (int r = 0; r < 4; ++r) o[r] = ((y[ni][r] - mean) * rstd * lw[r] + lb[r] + in.bon * vv[r]) * gg[r];
        u32x2 w; w.x = pk2bf(o[0], o[1]); w.y = pk2bf(o[2], o[3]);
        *(u32x2*)(p.mixin + (size_t)(r0 + t) * 1024 + 512 + hv) = w;
    }
}
DEV void rwkv_passC(const RwkvP& p, int b, int h, int c, int lane) {
    const size_t ch = (size_t)(c * 32 + b * 8 + h); const int r0 = b * RW_T + c * 64;
    const bf16_t* Q = p.QQ + ch * 4096; const bf16_t* S = p.SC + (size_t)((c >> 3) * 32 + b * 8 + h) * 4096; const float* Y0 = p.Y0 + ch * 4096;
    bf16x8 sf[4][2];
#pragma unroll
    for (int ni = 0; ni < 4; ++ni) { sf[ni][0] = *(const bf16x8*)(S + (16 * ni + (lane & 15)) * 64 + 8 * (lane >> 4)); sf[ni][1] = *(const bf16x8*)(S + (16 * ni + (lane & 15)) * 64 + 32 + 8 * (lane >> 4)); }
    PcIn A, B;
    pc_load(A, p, Q, Y0, r0, h, 0, lane); pc_load(B, p, Q, Y0, r0, h, 1, lane);
    pc_compute(A, sf, p, r0, h, 0, lane); pc_load(A, p, Q, Y0, r0, h, 2, lane);
    pc_compute(B, sf, p, r0, h, 1, lane); pc_load(B, p, Q, Y0, r0, h, 3, lane);
    pc_compute(A, sf, p, r0, h, 2, lane); pc_compute(B, sf, p, r0, h, 3, lane);
}

DEV void rwkv_sample(const RwkvP& p, int n, int h, RW_LAS unsigned char* wlds, int lane) {
    RW_LAS float* W = (RW_LAS float*)wlds;
    const int row = RW_MP + n, d = lane, hd = h * 64 + d;
    const bf16_t* pb = p.proj + (size_t)row * RW_NPROJ + RW_PB0; const float* pv = p.state_shift + (size_t)n * 1792;
#define XS(col) (bf2f(pb[col]) + (pv[col] - bf2f(pb[col])) * p.mu[col])
    const float r = XS(hd), k = XS(512 + hd), v = XS(1024 + hd);
    const float tw = tanhf_(XS(1536 + d)), xa = XS(1600 + d), sg0 = sigmoidf_(XS(1664 + d)), sg1 = sigmoidf_(XS(1728 + d));
#undef XS
    float aw = 0.f, aa = 0.f, ag = 0.f;
    for (int j = 0; j < 64; ++j) { const float twj = __shfl(tw, j), xaj = __shfl(xa, j), g0 = __shfl(sg0, j), g1 = __shfl(sg1, j);
        aw += twj * p.w2[j * 512 + hd]; aa += xaj * p.a2[j * 512 + hd]; ag += g0 * p.g2[j * 512 + hd] + g1 * p.g2[(64 + j) * 512 + hd]; }
    const float wraw = -softplusf_(-(p.w0[hd] + aw)) - 0.5f; const float w = __expf(-__expf(wraw));
    const float a = sigmoidf_(p.a0[hd] + aa);
    float kk = k * p.k_k[hd]; float n2 = kk * kk;
#pragma unroll
    for (int o = 1; o < 64; o <<= 1) n2 += __shfl_xor(n2, o);
    kk /= fmaxf(sqrtf(n2), 1e-12f);
    const float k2 = k * (1.f + (a - 1.f) * p.k_a[hd]);
    float bon = r * k2 * p.r_k[hd];
#pragma unroll
    for (int o = 1; o < 64; o <<= 1) bon += __shfl_xor(bon, o);
    W[d] = w; W[64 + d] = kk * a; W[128 + d] = k2; W[192 + d] = r; W[256 + d] = -kk;
    wave_sync();
    const float* S0 = p.state_wkv + ((size_t)(n * 8 + h) * 64 + lane) * 64;
    float* S1 = p.wkv_s + ((size_t)(n * 8 + h) * 64 + lane) * 64;
    float sa = 0.f;
#pragma unroll 4
    for (int q = 0; q < 16; ++q) { const f32x4 s = *(const f32x4*)(S0 + 4 * q);
#pragma unroll
        for (int e = 0; e < 4; ++e) sa += s[e] * W[256 + 4 * q + e]; }
    float y = 0.f;
#pragma unroll 4
    for (int q = 0; q < 16; ++q) { const f32x4 s = *(const f32x4*)(S0 + 4 * q); f32x4 o;
#pragma unroll
        for (int e = 0; e < 4; ++e) { const int kx = 4 * q + e; o[e] = s[e] * W[kx] + sa * W[64 + kx] + v * W[128 + kx]; y += o[e] * W[192 + kx]; }
        *(f32x4*)(S1 + 4 * q) = o; }
    float s = y;
#pragma unroll
    for (int o = 1; o < 64; o <<= 1) s += __shfl_xor(s, o);
    const float mean = s * (1.f / 64.f); float q2 = (y - mean) * (y - mean);
#pragma unroll
    for (int o = 1; o < 64; o <<= 1) q2 += __shfl_xor(q2, o);
    const float rstd = 1.f / sqrtf(q2 * (1.f / 64.f) + 64e-5f);
    const float o = ((y - mean) * rstd * p.ln_w[hd] + p.ln_b[hd] + bon * v) * ag;
    p.mixin[(size_t)row * 1024 + 512 + hd] = (bf16_t)f2bf(o);
    wave_sync();
}

constexpr int MK_MP = 16384, MK_MS = 128, MK_MR = 16512, MK_MPAD = 16640, MK_D = 1024, MK_FF = 2816, MK_NPROJ = 3328;
constexpr float MK_EPS = 1e-6f;
constexpr float MK_C2 = 0.125f * 1.4426950408889634f;
constexpr float MK_LAM_INIT = 0.2f;

DEV void ldbf8(const bf16_t* p, float (&x)[8]) { const u32x4v w = *(const u32x4v*)p; const unsigned ww[4] = {w.x, w.y, w.z, w.w};
#pragma unroll
    for (int i = 0; i < 4; ++i) { x[2 * i] = bf2f(ww[i] & 0xffffu); x[2 * i + 1] = bf2f(ww[i] >> 16); } }
DEV void unbf8(u32x4v w, float (&x)[8]) { const unsigned ww[4] = {w.x, w.y, w.z, w.w};
#pragma unroll
    for (int i = 0; i < 4; ++i) { x[2 * i] = bf2f(ww[i] & 0xffffu); x[2 * i + 1] = bf2f(ww[i] >> 16); } }
DEV f32x4 ldbf4(const bf16_t* p) { const u32x2 w = *(const u32x2*)p; return (f32x4){bf2f(w.x & 0xffffu), bf2f(w.x >> 16), bf2f(w.y & 0xffffu), bf2f(w.y >> 16)}; }
#ifdef EMU
#define MK_NTLOAD(p_) (*(p_))
#else
#define MK_NTLOAD(p_) (*(p_))
#endif
#ifdef EMU
DEV float exp2f_(float x) { return exp2f(x); }
#else
DEV float exp2f_(float x) { return __builtin_amdgcn_exp2f(x); }
#endif
DEV float wsum64(float v) { int lane_ = threadIdx.x & 63; return wsum64d(v, lane_); }
DEV void ld_row(const float* row, int lane, f32x4 (&v)[4]) {
#pragma unroll
    for (int j = 0; j < 4; ++j) v[j] = *(const f32x4*)(row + 4 * lane + 256 * j);
}
DEV void st_row(float* row, int lane, const f32x4 (&v)[4]) {
#pragma unroll
    for (int j = 0; j < 4; ++j) *(f32x4*)(row + 4 * lane + 256 * j) = v[j];
}
DEV void st_row_bf16(bf16_t* row, int lane, const f32x4 (&v)[4]) {
#pragma unroll
    for (int j = 0; j < 4; ++j) { u32x2 w; w.x = pk2bf(v[j][0], v[j][1]); w.y = pk2bf(v[j][2], v[j][3]); *(u32x2*)(row + 4 * lane + 256 * j) = w; }
}
DEV void ld_row(const bf16_t* row, int lane, f32x4 (&v)[4]) {
#pragma unroll
    for (int j = 0; j < 4; ++j) v[j] = ldbf4(row + 4 * lane + 256 * j);
}
DEV void st_row(bf16_t* row, int lane, const f32x4 (&v)[4]) { st_row_bf16(row, lane, v); }
DEV float row_rstd(const f32x4 (&v)[4]) {
    float s = 0.f;
#pragma unroll
    for (int j = 0; j < 4; ++j) s += (v[j][0] * v[j][0] + v[j][1] * v[j][1]) + (v[j][2] * v[j][2] + v[j][3] * v[j][3]);
    return rsqf_(wsum64(s) * (1.f / 1024.f) + MK_EPS);
}
DEV void row_norm(const f32x4 (&v)[4], const float* g, int lane, f32x4 (&o)[4]) {
    const float rs = row_rstd(v);
#pragma unroll
    for (int j = 0; j < 4; ++j) { const f32x4 gg = *(const f32x4*)(g + 4 * lane + 256 * j); o[j] = v[j] * rs * gg; }
}
DEV const float* x_row(const float* xp, const float* xs, int r) { return r < MK_MP ? xp + (size_t)r * MK_D : xs + (size_t)(r - MK_MP) * MK_D; }

DEV void rowpass_A(const float* xp, const float* xs, const float* gpre, bf16_t* XN, int r, int lane) {
    f32x4 v[4], o[4];
    if (r >= MK_MR) {
#pragma unroll
        for (int j = 0; j < 4; ++j) o[j] = (f32x4){0.f, 0.f, 0.f, 0.f};
    } else { ld_row(x_row(xp, xs, r), lane, v); row_norm(v, gpre, lane, o); }
    st_row_bf16(XN + (size_t)r * MK_D, lane, o);
}
DEV void ld_rowF(const bf16_t* F, const float* FS, int r, int lane, f32x4 (&f)[4]) {
    if (r < MK_MP) {
#pragma unroll
        for (int j = 0; j < 4; ++j) f[j] = ldbf4(F + (size_t)r * MK_D + 4 * lane + 256 * j);
        return; }
    f32x4 t[4]; ld_row(FS + (size_t)(r - MK_MP) * MK_D, lane, f);
#pragma unroll
    for (int ks = 1; ks < 4; ++ks) { ld_row(FS + (size_t)(ks * MK_MS + r - MK_MP) * MK_D, lane, t);
#pragma unroll
        for (int j = 0; j < 4; ++j) f[j] = f[j] + t[j]; }
}
template <class RP> DEV void rowpass_B(const RP* resrow, const bf16_t* F, const float* FS, const float* gpost, float scale, bf16_t* HRES, const float* gpre, bf16_t* XN, int r, int lane) {
    f32x4 f[4], x[4], o[4];
    ld_rowF(F, FS, r, lane, f); ld_row(resrow, lane, x);
    row_norm(f, gpost, lane, o);
#pragma unroll
    for (int j = 0; j < 4; ++j) x[j] = x[j] + o[j] * scale;
    st_row(HRES + (size_t)r * MK_D, lane, x);
    row_norm(x, gpre, lane, o);
    st_row_bf16(XN + (size_t)r * MK_D, lane, o);
}
DEV void rowpass_D(const bf16_t* HRES, const bf16_t* F, const float* FS, const float* gpost, float* outrow, int r, int lane) {
    f32x4 f[4], x[4], o[4];
    ld_rowF(F, FS, r, lane, f); ld_row(HRES + (size_t)r * MK_D, lane, x);
    row_norm(f, gpost, lane, o);
#pragma unroll
    for (int j = 0; j < 4; ++j) x[j] = x[j] + o[j] * 0.5f;
    st_row(outrow, lane, x);
}

DEV void rowpass_A2(const float* xp, const float* xs, const float* gpre, bf16_t* XN, int r0, int r1, int lane) {
    f32x4 v0[4], v1[4], o[4];
    ld_row(x_row(xp, xs, r0), lane, v0); ld_row(x_row(xp, xs, r1), lane, v1);
    row_norm(v0, gpre, lane, o); st_row_bf16(XN + (size_t)r0 * MK_D, lane, o);
    row_norm(v1, gpre, lane, o); st_row_bf16(XN + (size_t)r1 * MK_D, lane, o);
}
DEV void rowpass_A4(const float* xp, const float* xs, const float* gpre, bf16_t* XN, int r0, int stride, int lane) {
    f32x4 v[4][4], o[4];
#pragma unroll
    for (int i = 0; i < 4; ++i) ld_row(x_row(xp, xs, r0 + i * stride), lane, v[i]);
#pragma unroll
    for (int i = 0; i < 4; ++i) { row_norm(v[i], gpre, lane, o); st_row_bf16(XN + (size_t)(r0 + i * stride) * MK_D, lane, o); }
}
template <class RP> DEV void rowpass_B2(const RP* res0, const RP* res1, const bf16_t* F, const float* FS, const float* gpost, float scale, bf16_t* HRES, const float* gpre, bf16_t* XN, int r0, int r1, int lane) {
    f32x4 f0[4], f1[4], x0[4], x1[4], o[4];
    ld_rowF(F, FS, r0, lane, f0); ld_row(res0, lane, x0); ld_rowF(F, FS, r1, lane, f1); ld_row(res1, lane, x1);
    row_norm(f0, gpost, lane, o);
#pragma unroll
    for (int j = 0; j < 4; ++j) x0[j] = x0[j] + o[j] * scale;
    row_norm(f1, gpost, lane, o);
#pragma unroll
    for (int j = 0; j < 4; ++j) x1[j] = x1[j] + o[j] * scale;
    st_row(HRES + (size_t)r0 * MK_D, lane, x0); st_row(HRES + (size_t)r1 * MK_D, lane, x1);
    row_norm(x0, gpre, lane, o); st_row_bf16(XN + (size_t)r0 * MK_D, lane, o);
    row_norm(x1, gpre, lane, o); st_row_bf16(XN + (size_t)r1 * MK_D, lane, o);
}
DEV void rowpass_D2(const bf16_t* HRES, const bf16_t* F, const float* FS, const float* gpost, float* out0, float* out1, int r0, int r1, int lane) {
    f32x4 f0[4], f1[4], x0[4], x1[4], o[4];
    ld_rowF(F, FS, r0, lane, f0); ld_row(HRES + (size_t)r0 * MK_D, lane, x0); ld_rowF(F, FS, r1, lane, f1); ld_row(HRES + (size_t)r1 * MK_D, lane, x1);
    row_norm(f0, gpost, lane, o);
#pragma unroll
    for (int j = 0; j < 4; ++j) x0[j] = x0[j] + o[j] * 0.5f;
    row_norm(f1, gpost, lane, o);
#pragma unroll
    for (int j = 0; j < 4; ++j) x1[j] = x1[j] + o[j] * 0.5f;
    st_row(out0, lane, x0); st_row(out1, lane, x1);
}

struct PostP {
    const bf16_t* proj; bf16_t *QB, *KB, *VB;
    float *k_p, *v_p, *k_s, *v_s, *shift_p, *shift_s;
    const float* ropetab;
    const float* mu; bf16_t* XL; bf16_t* XH;
};
DEV void rope_tab_entry(float* tab, int idx) { const int pos = idx >> 3, i = idx & 7; const float invf = expf(-(float)i * 0.125f * 13.122363377404328f); const float ang = (float)pos * invf; tab[pos * 16 + i] = cosf(ang); tab[pos * 16 + 8 + i] = sinf(ang); }
struct PwPre { u32x4v rx[4], rp[4]; };
DEV void post_win_rwkv_load(PwPre& o, const PostP& p, int r, int lane) {
    const bf16_t* row = p.proj + (size_t)r * MK_NPROJ; const bool hasprev = (r & 4095) != 0; const bf16_t* prow = row - MK_NPROJ;
#pragma unroll
    for (int i = 0; i < 4; ++i) { const int col = 8 * (lane + 64 * i);
        if (col < 1792) { o.rx[i] = *(const u32x4v*)(row + 1536 + col); o.rp[i] = hasprev ? *(const u32x4v*)(prow + 1536 + col) : (u32x4v){0u, 0u, 0u, 0u}; }
        else { o.rx[i] = (u32x4v){0u, 0u, 0u, 0u}; o.rp[i] = (u32x4v){0u, 0u, 0u, 0u}; } }
}
DEV void post_win_rwkv_core(const PwPre& in, const PostP& p, int r, int lane) {
#pragma unroll
    for (int i = 0; i < 4; ++i) {
        const int col = 8 * (lane + 64 * i);
        if (col < 1792) {
            float x[8], pv[8], xs[8]; unbf8(in.rx[i], x); unbf8(in.rp[i], pv);
            const f32x4 m0 = *(const f32x4*)(p.mu + col), m1 = *(const f32x4*)(p.mu + col + 4);
#pragma unroll
            for (int e = 0; e < 8; ++e) xs[e] = x[e] + (pv[e] - x[e]) * (e < 4 ? m0[e & 3] : m1[e & 3]);
            if (col < 1536) { const int s = col >> 9, cc = col & 511; bf16_t* dst = p.XH + ((size_t)r * 8 + (cc >> 6)) * 192 + s * 64 + (cc & 63);
                u32x4v w; w.x = pk2bf(xs[0], xs[1]); w.y = pk2bf(xs[2], xs[3]); w.z = pk2bf(xs[4], xs[5]); w.w = pk2bf(xs[6], xs[7]); *(u32x4v*)dst = w; }
            else { const int j = col - 1536; float y[8];
#pragma unroll
                for (int e = 0; e < 8; ++e) y[e] = j < 64 ? tanhf_(xs[e]) : (j < 128 ? xs[e] : sigmoidf_(xs[e]));
                u32x4v w; w.x = pk2bf(y[0], y[1]); w.y = pk2bf(y[2], y[3]); w.z = pk2bf(y[4], y[5]); w.w = pk2bf(y[6], y[7]); *(u32x4v*)(p.XL + (size_t)r * 256 + j) = w; }
        }
    }
}
DEV void post_win_row_rwkv(const PostP& p, int r, int lane) { if (r < MK_MP) { PwPre pre; post_win_rwkv_load(pre, p, r, lane); post_win_rwkv_core(pre, p, r, lane); } }
DEV void post_win_row(const PostP& p, int r, int lane) {
    const bf16_t* row = p.proj + (size_t)r * MK_NPROJ;
    const int pos = r < MK_MP ? (r & 4095) : 2048;
    const int i8 = lane & 7;
    float cs[8], sn[8];
    { const f32x4 c0 = *(const f32x4*)(p.ropetab + pos * 16), c1 = *(const f32x4*)(p.ropetab + pos * 16 + 4), s0 = *(const f32x4*)(p.ropetab + pos * 16 + 8), s1 = *(const f32x4*)(p.ropetab + pos * 16 + 12);
#pragma unroll
      for (int e = 0; e < 4; ++e) { cs[e] = c0[e]; cs[4 + e] = c1[e]; sn[e] = s0[e]; sn[4 + e] = s1[e]; } }
    float* kout = r < MK_MP ? p.k_p + (size_t)r * 512 : p.k_s + (size_t)(r - MK_MP) * 512;
    float* vout = r < MK_MP ? p.v_p + (size_t)r * 512 : p.v_s + (size_t)(r - MK_MP) * 512;
    u32x4v rqkv[3];
#pragma unroll
    for (int s = 0; s < 3; ++s) rqkv[s] = *(const u32x4v*)(row + s * 512 + lane * 8);
    PwPre pre; if (r < MK_MP) post_win_rwkv_load(pre, p, r, lane);
#pragma unroll
    for (int s = 0; s < 3; ++s) {
        float x[8]; unbf8(rqkv[s], x);
        if (s < 2) {
            float o[8];
#pragma unroll
            for (int e = 0; e < 8; ++e) { const float other = dpp_q1(x[e], lane); o[e] = i8 == 0 ? x[e] * cs[e] - other * sn[e] : (i8 == 1 ? x[e] * cs[e] + other * sn[e] : x[e]); }
#pragma unroll
            for (int e = 0; e < 8; ++e) x[e] = o[e];
        }
        if (s >= 1) { float* o = s == 1 ? kout : vout; *(f32x4*)(o + lane * 8) = (f32x4){x[0], x[1], x[2], x[3]}; *(f32x4*)(o + lane * 8 + 4) = (f32x4){x[4], x[5], x[6], x[7]}; }
        const float sc = s == 0 ? MK_C2 : 1.f;
        u32x4v w; w.x = pk2bf(x[0] * sc, x[1] * sc); w.y = pk2bf(x[2] * sc, x[3] * sc); w.z = pk2bf(x[4] * sc, x[5] * sc); w.w = pk2bf(x[6] * sc, x[7] * sc);
        bf16_t* dst = (s == 0 ? p.QB : (s == 1 ? p.KB : p.VB)) + (size_t)r * 512 + lane * 8;
        *(u32x4v*)dst = w;
    }
    float* sh = nullptr;
    if (r >= MK_MP) sh = p.shift_s + (size_t)(r - MK_MP) * 1792; else if ((r & 4095) == 4095) sh = p.shift_p + (size_t)(r >> 12) * 1792;
    if (sh) { for (int i = lane; i < 448; i += 64) *(f32x4*)(sh + 4 * i) = ldbf4(row + 1536 + 4 * i); }
    if (r < MK_MP) post_win_rwkv_core(pre, p, r, lane);
}

DEV void attn_combine_core(u32x4v w0, u32x4v w1, const float* subln, float lam, bf16_t* mixin, int r, int lane) {
    const unsigned ww[8] = {w0.x, w0.y, w0.z, w0.w, w1.x, w1.y, w1.z, w1.w};
    float x[16], y[16]; float ss = 0.f;
#pragma unroll
    for (int i = 0; i < 8; ++i) { x[2 * i] = bf2f(ww[i] & 0xffffu); x[2 * i + 1] = bf2f(ww[i] >> 16); }
#pragma unroll
    for (int i = 0; i < 16; ++i) { const float o = dpp_x8(x[i], lane); y[i] = x[i] - lam * o; ss += y[i] * y[i]; }
    ss += dpp_q1(ss, lane); ss += dpp_q2(ss, lane); ss += dpp_hm(ss, lane);
    const float rs = rsqf_(ss * (1.f / 128.f) + MK_EPS) * (1.f - MK_LAM_INIT);
    if ((lane & 8) == 0) {
        const int h = lane >> 4, half = (lane >> 2) & 1, e0 = half * 64 + (lane & 3) * 16;
        unsigned o[8];
#pragma unroll
        for (int i = 0; i < 8; ++i) o[i] = pk2bf(y[2 * i] * rs * subln[e0 + 2 * i], y[2 * i + 1] * rs * subln[e0 + 2 * i + 1]);
        bf16_t* dst = mixin + (size_t)r * 1024 + h * 128 + e0;
        *(u32x4v*)dst = (u32x4v){o[0], o[1], o[2], o[3]}; *(u32x4v*)(dst + 8) = (u32x4v){o[4], o[5], o[6], o[7]};
    }
}
DEV void attn_combine_row(const bf16_t* O16, const float* subln, float lam, bf16_t* mixin, int r, int lane) {
    const u32x4v w0 = *(const u32x4v*)(O16 + (size_t)r * 1024 + lane * 16), w1 = *(const u32x4v*)(O16 + (size_t)r * 1024 + lane * 16 + 8);
    attn_combine_core(w0, w1, subln, lam, mixin, r, lane);
}
template <int NR> DEV void attn_combine_rows(const bf16_t* O16, const float* subln, float lam, bf16_t* mixin, int r0, int stride, int lane) {
    u32x4v w0[NR], w1[NR];
#pragma unroll
    for (int i = 0; i < NR; ++i) { const bf16_t* p = O16 + (size_t)(r0 + i * stride) * 1024 + lane * 16; w0[i] = *(const u32x4v*)p; w1[i] = *(const u32x4v*)(p + 8); }
#pragma unroll
    for (int i = 0; i < NR; ++i) attn_combine_core(w0[i], w1[i], subln, lam, mixin, r0 + i * stride, lane);
}

struct DecP {
    const float *cache_k, *cache_v; const int* page_table;
    const bf16_t* QB;
    float *PM, *PL, *PO;
    const float *k_s, *v_s;
    const float* subln; bf16_t* mixin;
};
struct DecState { float m[2], l[2], o[2][8]; };
DEV void dec_token(DecState& S, const float (&q)[8], const f32x4& k0, const f32x4& k1, const f32x4& v0, const f32x4& v1, int lane) {
    float s = (q[0] * k0[0] + q[1] * k0[1]) + (q[2] * k0[2] + q[3] * k0[3]) + (q[4] * k1[0] + q[5] * k1[1]) + (q[6] * k1[2] + q[7] * k1[3]);
    s += dpp_q1(s, lane); s += dpp_q2(s, lane); s += dpp_hm(s, lane);
    const float so = dpp_rm(s, lane);
    const bool j1 = (lane & 8) != 0; const float sj[2] = {j1 ? so : s, j1 ? s : so};
    const float vv[8] = {v0[0], v0[1], v0[2], v0[3], v1[0], v1[1], v1[2], v1[3]};
#pragma unroll
    for (int j = 0; j < 2; ++j) {
        const float mn = fmaxf(S.m[j], sj[j]); const float al = exp2f_(S.m[j] - mn), pp = exp2f_(sj[j] - mn);
        S.m[j] = mn; S.l[j] = S.l[j] * al + pp;
#pragma unroll
        for (int e = 0; e < 8; ++e) S.o[j][e] = S.o[j][e] * al + pp * vv[e];
    }
}
template <int NB> DEV void dec_batch(DecState& S, const float (&q)[8], const f32x4 (&kk)[NB][2], const f32x4 (&vv)[NB][2], int lane) {
    float s0[NB], s1[NB];
    const bool j1 = (lane & 8) != 0;
#pragma unroll
    for (int i = 0; i < NB; ++i) {
        float s = (q[0] * kk[i][0][0] + q[1] * kk[i][0][1]) + (q[2] * kk[i][0][2] + q[3] * kk[i][0][3]) + (q[4] * kk[i][1][0] + q[5] * kk[i][1][1]) + (q[6] * kk[i][1][2] + q[7] * kk[i][1][3]);
        s += dpp_q1(s, lane); s += dpp_q2(s, lane); s += dpp_hm(s, lane);
        const float so = dpp_rm(s, lane);
        s0[i] = j1 ? so : s; s1[i] = j1 ? s : so;
    }
#pragma unroll
    for (int j = 0; j < 2; ++j) {
        float bm = j == 0 ? s0[0] : s1[0];
#pragma unroll
        for (int i = 1; i < NB; ++i) bm = fmaxf(bm, j == 0 ? s0[i] : s1[i]);
        const float mn = fmaxf(S.m[j], bm), al = exp2f_(S.m[j] - mn);
        S.m[j] = mn; float l = S.l[j] * al;
#pragma unroll
        for (int e = 0; e < 8; ++e) S.o[j][e] *= al;
#pragma unroll
        for (int i = 0; i < NB; ++i) { const float pp = exp2f_((j == 0 ? s0[i] : s1[i]) - mn); l += pp;
#pragma unroll
            for (int e = 0; e < 4; ++e) { S.o[j][e] += pp * vv[i][0][e]; S.o[j][4 + e] += pp * vv[i][1][e]; } }
        S.l[j] = l;
    }
}
DEV void decode_unit(const DecP& p, int n, int half, RW_LAS unsigned char* lds) {
    const int tid = threadIdx.x, lane = tid & 63, wid = tid >> 6;
    RW_LAS float* LM = (RW_LAS float*)lds; RW_LAS float* LL = LM + 64; RW_LAS float* LO = LM + 128;
    const int page = p.page_table[n * 16 + half * 8 + wid];
    const float* kp = p.cache_k + (size_t)page * 65536 + lane * 8; const float* vp = p.cache_v + (size_t)page * 65536 + lane * 8;
    float q[8];
    { const u32x4v w = *(const u32x4v*)(p.QB + (size_t)(MK_MP + n) * 512 + lane * 8); const unsigned ww[4] = {w.x, w.y, w.z, w.w};
#pragma unroll
      for (int i = 0; i < 4; ++i) { q[2 * i] = bf2f(ww[i] & 0xffffu); q[2 * i + 1] = bf2f(ww[i] >> 16); } }
    DecState S;
#pragma unroll
    for (int j = 0; j < 2; ++j) { S.m[j] = -1e30f; S.l[j] = 0.f;
#pragma unroll
        for (int e = 0; e < 8; ++e) S.o[j][e] = 0.f; }
#pragma unroll 1
    for (int t0 = 0; t0 < 128; t0 += 8) {
        f32x4 kk[8][2], vv[8][2];
#pragma unroll
        for (int i = 0; i < 8; ++i) { kk[i][0] = MK_NTLOAD((const f32x4*)(kp + (size_t)(t0 + i) * 512)); kk[i][1] = MK_NTLOAD((const f32x4*)(kp + (size_t)(t0 + i) * 512 + 4));
                                      vv[i][0] = MK_NTLOAD((const f32x4*)(vp + (size_t)(t0 + i) * 512)); vv[i][1] = MK_NTLOAD((const f32x4*)(vp + (size_t)(t0 + i) * 512 + 4)); }
        dec_batch<8>(S, q, kk, vv, lane);
    }
    if ((lane & 15) == 0) { const int h = lane >> 4; LM[wid * 8 + h * 2] = S.m[0]; LM[wid * 8 + h * 2 + 1] = S.m[1]; LL[wid * 8 + h * 2] = S.l[0]; LL[wid * 8 + h * 2 + 1] = S.l[1]; }
#pragma unroll
    for (int j = 0; j < 2; ++j) { *(RW_LAS f32x4*)(LO + (wid * 2 + j) * 512 + lane * 8) = (f32x4){S.o[j][0], S.o[j][1], S.o[j][2], S.o[j][3]}; *(RW_LAS f32x4*)(LO + (wid * 2 + j) * 512 + lane * 8 + 4) = (f32x4){S.o[j][4], S.o[j][5], S.o[j][6], S.o[j][7]}; }
    __syncthreads();
    if (tid < 128) {
        const int j = tid >> 6, ll = tid & 63, h = ll >> 4, hj = h * 2 + j;
        float M = -1e30f;
#pragma unroll
        for (int w = 0; w < 8; ++w) M = fmaxf(M, LM[w * 8 + hj]);
        float l = 0.f, o[8] = {0.f, 0.f, 0.f, 0.f, 0.f, 0.f, 0.f, 0.f};
#pragma unroll
        for (int w = 0; w < 8; ++w) { const float f = exp2f_(LM[w * 8 + hj] - M); l += LL[w * 8 + hj] * f;
#pragma unroll
            for (int e = 0; e < 8; ++e) o[e] += LO[(w * 2 + j) * 512 + ll * 8 + e] * f; }
        float* po = p.PO + ((size_t)(n * 2 + half) * 2 + j) * 512 + ll * 8;
        *(f32x4*)po = (f32x4){o[0], o[1], o[2], o[3]}; *(f32x4*)(po + 4) = (f32x4){o[4], o[5], o[6], o[7]};
        if ((ll & 15) == 0) { p.PM[(n * 2 + half) * 8 + hj] = M; p.PL[(n * 2 + half) * 8 + hj] = l; }
    }
    __syncthreads();
}
DEV void decode_final(const DecP& p, int n, float lam, int lane) {
    const int h = lane >> 4;
    float q[8];
    { const u32x4v w = *(const u32x4v*)(p.QB + (size_t)(MK_MP + n) * 512 + lane * 8); const unsigned ww[4] = {w.x, w.y, w.z, w.w};
#pragma unroll
      for (int i = 0; i < 4; ++i) { q[2 * i] = bf2f(ww[i] & 0xffffu); q[2 * i + 1] = bf2f(ww[i] >> 16); } }
    DecState S;
#pragma unroll
    for (int j = 0; j < 2; ++j) {
        const int hj = h * 2 + j; const float m0 = p.PM[(n * 2 + 0) * 8 + hj], m1 = p.PM[(n * 2 + 1) * 8 + hj]; const float M = fmaxf(m0, m1), f0 = exp2f_(m0 - M), f1 = exp2f_(m1 - M);
        S.m[j] = M; S.l[j] = p.PL[(n * 2 + 0) * 8 + hj] * f0 + p.PL[(n * 2 + 1) * 8 + hj] * f1;
        const float* o0 = p.PO + ((size_t)(n * 2 + 0) * 2 + j) * 512 + lane * 8; const float* o1 = p.PO + ((size_t)(n * 2 + 1) * 2 + j) * 512 + lane * 8;
#pragma unroll
        for (int e = 0; e < 8; ++e) S.o[j][e] = o0[e] * f0 + o1[e] * f1;
    }
    const float* kc = p.k_s + (size_t)n * 512 + lane * 8; const float* vc = p.v_s + (size_t)n * 512 + lane * 8;
    dec_token(S, q, *(const f32x4*)kc, *(const f32x4*)(kc + 4), *(const f32x4*)vc, *(const f32x4*)(vc + 4), lane);
    float y[8]; float ss = 0.f;
#pragma unroll
    for (int e = 0; e < 8; ++e) { y[e] = S.o[0][e] / S.l[0] - lam * (S.o[1][e] / S.l[1]); ss += y[e] * y[e]; }
    ss = rsum16(ss, lane);
    const float rs = 1.f / sqrtf(ss * (1.f / 128.f) + MK_EPS) * (1.f - MK_LAM_INIT);
    const int e0 = (lane & 15) * 8;
    u32x4v w; w.x = pk2bf(y[0] * rs * p.subln[e0], y[1] * rs * p.subln[e0 + 1]); w.y = pk2bf(y[2] * rs * p.subln[e0 + 2], y[3] * rs * p.subln[e0 + 3]);
    w.z = pk2bf(y[4] * rs * p.subln[e0 + 4], y[5] * rs * p.subln[e0 + 5]); w.w = pk2bf(y[6] * rs * p.subln[e0 + 6], y[7] * rs * p.subln[e0 + 7]);
    *(u32x4v*)(p.mixin + (size_t)(MK_MP + n) * 1024 + h * 128 + e0) = w;
}
DEV float compute_lam(const float* q1, const float* k1, const float* q2, const float* k2, int lane) {
    const float a = wsum64(q1[lane] * k1[lane]), b = wsum64(q2[lane] * k2[lane]);
    return __expf(a) - __expf(b) + MK_LAM_INIT;
}

DEV void skinny_item(const bf16_t* A, const bf16_t* Wt, int K, float* FS, int item, int wid, int lane) {
    const int cgp = item >> 2, ks = item & 3, kq = K >> 2;
    const bf16_t* ap = A + (size_t)(16 * wid + (lane & 15)) * K + ks * kq + 8 * (lane >> 4);
    const bf16_t* bp = Wt + (size_t)(16 * cgp + (lane & 15)) * K + ks * kq + 8 * (lane >> 4);
    f32x4 acc = {0.f, 0.f, 0.f, 0.f};
#pragma unroll 8
    for (int k0 = 0; k0 < kq; k0 += 32) { const bf16x8 a = *(const bf16x8*)(ap + k0), b = *(const bf16x8*)(bp + k0); acc = mfma16(b, a, acc); }
    *(f32x4*)(FS + (size_t)(ks * MK_MS + 16 * wid + (lane & 15)) * MK_D + 16 * cgp + 4 * (lane >> 4)) = acc;
}

DEV void transpose_item64(const float* W, int N, int K, bf16_t* WT, int k0, int n0, int dst_row0, RW_LAS float* scr, int lane) {
#pragma unroll 4
    for (int i = 0; i < 16; ++i) { const int kk = 4 * i + (lane >> 4); const f32x4 v = *(const f32x4*)(W + (size_t)(k0 + kk) * N + n0 + 4 * (lane & 15));
        RW_LAS float* d = scr + kk * 65 + 4 * (lane & 15); d[0] = v[0]; d[1] = v[1]; d[2] = v[2]; d[3] = v[3]; }
    wave_sync();
    const int c = lane & 7;
#pragma unroll
    for (int j = 0; j < 8; ++j) { const int n = (lane >> 3) + 8 * j; const RW_LAS float* s = scr + (8 * c) * 65 + n;
        u32x4v o; o.x = pk2bf(s[0 * 65], s[1 * 65]); o.y = pk2bf(s[2 * 65], s[3 * 65]); o.z = pk2bf(s[4 * 65], s[5 * 65]); o.w = pk2bf(s[6 * 65], s[7 * 65]);
        *(u32x4v*)(WT + (size_t)(dst_row0 + n) * K + k0 + 8 * c) = o; }
    wave_sync();
}

#define GAS __attribute__((address_space(1)))
#define LAS __attribute__((address_space(3)))
typedef unsigned short bf16;
typedef unsigned v4u __attribute__((ext_vector_type(4)));
typedef float f32x4 __attribute__((ext_vector_type(4)));
typedef short bf16x8 __attribute__((ext_vector_type(8)));
typedef GAS unsigned gu32;
typedef GAS unsigned long long gu64;
#define RLX_AGENT __ATOMIC_RELAXED, __HIP_MEMORY_SCOPE_AGENT
#define LDS_WAIT() asm volatile("s_waitcnt lgkmcnt(0)" ::: "memory")
#define VM_WAIT() asm volatile("s_waitcnt vmcnt(0)" ::: "memory")
__device__ __forceinline__ unsigned long long rt() { return __builtin_amdgcn_s_memrealtime(); }
__device__ __forceinline__ unsigned pk2(float lo, float hi) { return f2bf(lo) | (f2bf(hi) << 16); }

#define XB_TMO      128
#define XB_XCNT(j)  (256  + 64 * (j))
#define XB_XSUB(j)  (1280 + 64 * (j))
#define XB_XGEN(j)  (2304 + 64 * (j))
#define XB_TOP      3328
#define XB_TOPGEN   3392
#define XCD_BAR_WORDS 3456
#define XB_SPIN_CAP (1u << 18)

__device__ __forceinline__ unsigned xb_ld(unsigned* p)              { return __hip_atomic_load(p, __ATOMIC_RELAXED, __HIP_MEMORY_SCOPE_AGENT); }
__device__ __forceinline__ unsigned xb_add(unsigned* p, unsigned v) { return __hip_atomic_fetch_add(p, v, __ATOMIC_RELAXED, __HIP_MEMORY_SCOPE_AGENT); }
__device__ __forceinline__ unsigned xb_xcc_id() { return (unsigned)__builtin_amdgcn_s_getreg((3 << 11) | 20) & 0xFu; }
#define XB_SPIN(cond, bar) do { unsigned _sp = 0; while (cond) { __builtin_amdgcn_s_sleep(1); \
    if ((++_sp & 255u) == 0u) { if (xb_ld(&(bar)[XB_TMO])) break; if (_sp > XB_SPIN_CAP) { atomicAdd(&(bar)[XB_TMO], 1u); break; } } } } while (0)

struct XcdBarrier {
    unsigned* bar; unsigned x;
    volatile LAS unsigned* st;
};

__device__ __forceinline__ XcdBarrier xcd_barrier_post(unsigned* bar, volatile LAS unsigned* st) {
    XcdBarrier b; b.bar = bar; b.x = xb_xcc_id(); b.st = st;
    if (threadIdx.x == 0) (void)xb_add(&bar[XB_XCNT(b.x)], 1u);
    return b;
}
__device__ __forceinline__ void xcd_barrier_complete(unsigned* bar, unsigned x, unsigned& nloc, unsigned& nx) {
    const unsigned G = gridDim.x * gridDim.y * gridDim.z;
    unsigned sum, cnt, mine, sp = 0u;
    for (;;) {
        sum = 0u; cnt = 0u; mine = 0u;
#pragma unroll
        for (unsigned j = 0; j < 16; ++j) { const unsigned c = xb_ld(&bar[XB_XCNT(j)]); sum += c; cnt += (c > 0u) ? 1u : 0u; mine = (j == x) ? c : mine; }
        if (sum == G) break;
        __builtin_amdgcn_s_sleep(1);
        if ((++sp & 255u) == 0u) { if (xb_ld(&bar[XB_TMO])) break; if (sp > XB_SPIN_CAP) { atomicAdd(&bar[XB_TMO], 1u); break; } }
    }
    nloc = mine > 0u ? mine : 1u; nx = cnt > 0u ? cnt : 1u;
}

__device__ __forceinline__ void xcd_barrier(const XcdBarrier& b) {
    asm volatile("s_waitcnt vmcnt(0)" ::: "memory");
    __syncthreads();
    if (threadIdx.x == 0) {
        unsigned* bar = b.bar;
        __builtin_amdgcn_s_waitcnt(0);
        unsigned nloc = b.st[0], nx = b.st[1];
        if (nloc == 0u) { xcd_barrier_complete(bar, b.x, nloc, nx); b.st[0] = nloc; b.st[1] = nx; }
        const unsigned old = xb_add(&bar[XB_XSUB(b.x)], 1u);
        const unsigned gen = old / nloc;
        if (old + 1u == (gen + 1u) * nloc) {
            __builtin_amdgcn_fence(__ATOMIC_RELEASE, "agent");
            asm volatile("s_waitcnt vmcnt(0)" ::: "memory");
            const unsigned og = xb_add(&bar[XB_TOP], 1u);
            const unsigned tg = og / nx;
            if (og + 1u == (tg + 1u) * nx) xb_add(&bar[XB_TOPGEN], 1u);
            else XB_SPIN(xb_ld(&bar[XB_TOPGEN]) == tg, bar);
            __builtin_amdgcn_fence(__ATOMIC_ACQUIRE, "agent");
            xb_add(&bar[XB_XGEN(b.x)], 1u);
            asm volatile("s_waitcnt vmcnt(0)" ::: "memory");
        } else {
            XB_SPIN(xb_ld(&bar[XB_XGEN(b.x)]) == gen, bar);
            __builtin_amdgcn_fence(__ATOMIC_ACQUIRE, "agent");
            asm volatile("s_waitcnt vmcnt(0)" ::: "memory");
        }
    }
    __syncthreads();
}

constexpr int NWAVES = 8;
#ifndef MK_N_LAUNCHES
#define MK_N_LAUNCHES 1
#endif
constexpr int N_PHASES = 13;
constexpr size_t MiB = 1u << 20;
constexpr size_t WS_CTL = 0, CTL_ZERO_BYTES = 1 * MiB;
constexpr size_t WS_WGU1 = 1 * MiB, WS_WD1 = 13 * MiB, WS_WIN = 19 * MiB, WS_WOUT = 26 * MiB, WS_WGU2 = 28 * MiB, WS_WD2 = 40 * MiB, WS_W2T = 46 * MiB, WS_A2T = WS_W2T + 65536, WS_G2T = WS_A2T + 65536;
constexpr size_t WS_XN = 47 * MiB;
constexpr size_t WS_H = 80 * MiB;
constexpr size_t WS_F = 170 * MiB;
constexpr size_t WS_HRES = 235 * MiB;
constexpr size_t WS_PROJ = 300 * MiB;
constexpr size_t WS_QB = 512 * MiB, WS_KB = 529 * MiB, WS_VB = 546 * MiB;
constexpr size_t WS_O16 = 563 * MiB;
constexpr size_t WS_MIXIN = 595 * MiB;
constexpr size_t WS_MT = 628 * MiB, WS_NN = 644 * MiB, WS_QQ = 676 * MiB, WS_Y0 = 692 * MiB, WS_SC = 724 * MiB, WS_VG = 740 * MiB, WS_GG = 756 * MiB, WS_BON = 772 * MiB;
constexpr size_t WS_PM = 773 * MiB, WS_PL = WS_PM + 65536, WS_PO = 774 * MiB, WS_FS = 776 * MiB  , WS_ROPE = 778 * MiB  , WS_XL = 779 * MiB  , WS_XH = 787 * MiB  , WS_END = 883 * MiB;
constexpr int CW_TMO = 0, CW_CODE = 1, CW_QA = 2048, CW_QD = 2112, CW_BAR = 4096;
constexpr int RING_OFF = 0, RING_BYTES = 147456;
constexpr int LDSCTL_OFF = RING_BYTES, MISC_OFF = LDSCTL_OFF + 320;
constexpr int LDS_BYTES = 151552;

struct Args { const float* in[37]; float* out; unsigned char* ws; int ph_lo, ph_hi, li, pad; };

__device__ __forceinline__ void p0_transpose_item(const float* W, int K, int N, bf16* WT, int k0, int n0, int dst_row0, LAS float* scr, int lane) {
#pragma unroll 8
    for (int i = 0; i < 32; ++i) { const int kk = 2 * i + (lane >> 5); scr[kk * 33 + (lane & 31)] = W[(size_t)(k0 + kk) * N + n0 + (lane & 31)]; }
    LDS_WAIT(); asm volatile("" ::: "memory");
    const int c = lane & 7;
#pragma unroll
    for (int j = 0; j < 4; ++j) { const int n = (lane >> 3) + 8 * j; const LAS float* s = scr + (8 * c) * 33 + n;
        v4u o; o.x = pk2(s[0 * 33], s[1 * 33]); o.y = pk2(s[2 * 33], s[3 * 33]); o.z = pk2(s[4 * 33], s[5 * 33]); o.w = pk2(s[6 * 33], s[7 * 33]);
        *(GAS v4u*)(WT + (size_t)(dst_row0 + n) * K + k0 + 8 * c) = o; }
    LDS_WAIT(); asm volatile("" ::: "memory");
}

__global__ void __launch_bounds__(NWAVES * 64, 2) mk_fwd(Args args) {
    extern __shared__ __attribute__((aligned(16))) unsigned char lds[];
    LAS unsigned char* ldsl = (LAS unsigned char*)lds;
    volatile LAS unsigned* MISC = (volatile LAS unsigned*)(ldsl + MISC_OFF);
    constexpr int G = 256, NGW = G * NWAVES;
#define PH_LOCALS int tid = threadIdx.x; asm volatile("" : "+v"(tid)); const int lane = tid & 63; const int wave = __builtin_amdgcn_readfirstlane(tid >> 6); \
    int bx = blockIdx.x; asm volatile("" : "+s"(bx)); const int vcu = (bx & 7) * 32 + (bx >> 3); const int gw = vcu * NWAVES + wave; (void)lane; (void)gw; (void)vcu;
    gu32* ctl = (gu32*)(args.ws + WS_CTL);
    for (int u = threadIdx.x; u < (LDS_BYTES - LDSCTL_OFF) / 4; u += NWAVES * 64) ((LAS unsigned*)(ldsl + LDSCTL_OFF))[u] = 0u;
    __syncthreads();
    XcdBarrier bar = xcd_barrier_post((unsigned*)(ctl + CW_BAR) + args.li * XCD_BAR_WORDS, MISC + 8);
#if MK_N_LAUNCHES == 1
    constexpr int lo = 0, hi = N_PHASES;
#else
    const int lo = args.ph_lo, hi = args.ph_hi;
#endif
#ifndef PH_MASK
#define PH_MASK 0x1fff
#endif
#define IN(k) (((PH_MASK >> (k)) & 1) && lo <= (k) && (k) < hi)
#if defined(PROBE_A)
#define STAMP(k) do { if (threadIdx.x == 0) *(volatile LAS unsigned long long*)(ldsl + LDSCTL_OFF + 1024 + 8 * (k)) = __builtin_amdgcn_s_memrealtime(); } while (0)
#else
#define STAMP(k) do { } while (0)
#endif
#define SEAM(k) do { if (IN(k) && IN((k) + 1)) xcd_barrier(bar); STAMP((k) + 1); } while (0)
    STAMP(0);
#define INP(i) (args.in[i])
#define WSB(off) ((bf16*)(args.ws + (off)))
#define WSF(off) ((float*)(args.ws + (off)))
#define x_p INP(0)
#define x_s INP(1)
#define subln INP(20)
#define XN WSB(WS_XN)
#define HB WSB(WS_H)
#define Fb WSB(WS_F)
#define HRES WSB(WS_HRES)
#define PROJ WSB(WS_PROJ)
#define QB WSB(WS_QB)
#define KB WSB(WS_KB)
#define VB WSB(WS_VB)
#define O16 WSB(WS_O16)
#define MIXIN WSB(WS_MIXIN)
#define FSb WSF(WS_FS)
#define o_yp (args.out)
#define o_ys (args.out + 16777216)
#define o_kp (args.out + 16908288)
#define o_vp (args.out + 25296896)
#define o_wkvp (args.out + 33685504)
#define o_shp (args.out + 33816576)
#define o_ks (args.out + 33823744)
#define o_vs (args.out + 33889280)
#define o_wkvs (args.out + 33954816)
#define o_shs (args.out + 38149120)
#define MAKE_RP() RwkvP rp; rp.proj = PROJ; rp.mu = INP(21); rp.w0 = INP(22); rp.w2 = INP(23); rp.a0 = INP(24); rp.a2 = INP(25); rp.g2 = INP(26); rp.k_k = INP(27); rp.k_a = INP(28); rp.r_k = INP(29); \
    rp.ln_w = INP(30); rp.ln_b = INP(31); rp.w2t = WSB(WS_W2T); rp.a2t = WSB(WS_A2T); rp.g2t = WSB(WS_G2T); rp.state_wkv = INP(4); rp.state_shift = INP(5); \
    rp.MT = WSB(WS_MT); rp.NN = WSF(WS_NN); rp.QQ = WSB(WS_QQ); rp.Y0 = WSF(WS_Y0); rp.SC = WSB(WS_SC); rp.VG = WSB(WS_VG); rp.GG = WSB(WS_GG); \
    rp.BON = WSF(WS_BON); rp.mixin = MIXIN; rp.wkv_p = o_wkvp; rp.wkv_s = o_wkvs; rp.XL = WSB(WS_XL); rp.XH = WSB(WS_XH);
#define MAKE_DP() DecP dp{INP(2), INP(3), (const int*)INP(6), QB, WSF(WS_PM), WSF(WS_PL), WSF(WS_PO), o_ks, o_vs, subln, MIXIN};
#define CONVERT_ITEM(id_) do { int r = (id_); \
        if (r < 2816) { const int which = r / 704; r -= which * 704; const int kb = r / 44, nb = r % 44, n0 = 64 * nb; \
            const float* W = which == 0 ? INP(9) : (which == 1 ? INP(10) : (which == 2 ? INP(34) : INP(35))); bf16* WT = which < 2 ? WSB(WS_WGU1) : WSB(WS_WGU2); \
            transpose_item64(W, 2816, 1024, WT, 64 * kb, n0, (n0 >> 7) * 256 + (which & 1) * 128 + (n0 & 127), scr, lane); } \
        else if (r < 4224) { r -= 2816; const int which = r / 704; r -= which * 704; const int kb = r / 16, nb = r % 16; \
            transpose_item64(which == 0 ? INP(11) : INP(36), 1024, 2816, which == 0 ? WSB(WS_WD1) : WSB(WS_WD2), 64 * kb, 64 * nb, 64 * nb, scr, lane); } \
        else if (r < 5056) { r -= 4224; const int kb = r / 52, nb = r % 52; transpose_item64(INP(14), 3328, 1024, WSB(WS_WIN), 64 * kb, 64 * nb, 64 * nb, scr, lane); } \
        else if (r < 5312) { r -= 5056; const int kb = r / 16, nb = r % 16; transpose_item64(INP(15), 1024, 1024, WSB(WS_WOUT), 64 * kb, 64 * nb, 64 * nb, scr, lane); } \
        else if (r < 5320) { r -= 5312; transpose_item64(INP(23), 512, 64, WSB(WS_W2T), 0, 64 * r, 64 * r, scr, lane); } \
        else if (r < 5328) { r -= 5320; transpose_item64(INP(25), 512, 64, WSB(WS_A2T), 0, 64 * r, 64 * r, scr, lane); } \
        else { r -= 5328; const int kb = r / 8, nb = r % 8; transpose_item64(INP(26), 512, 128, WSB(WS_G2T), 64 * kb, 64 * nb, 64 * nb, scr, lane); } } while (0)
    if (IN(0)) { PH_LOCALS
        LAS float* scr = (LAS float*)(ldsl + RING_OFF + wave * 16896);
        for (int it = gw; it < 2144; it += NGW) { const int id = it < 1408 ? it : (it < 2112 ? it + 1408 : it + 3200); CONVERT_ITEM(id); }
        { int r = gw; for (; r + NGW < MK_MR; r += 2 * NGW) rowpass_A2(x_p, x_s, INP(7), XN, r, r + NGW, lane);
          for (; r < MK_MPAD; r += NGW) rowpass_A(x_p, x_s, INP(7), XN, r, lane); }
        { const int idx = gw * 64 + lane; if (idx < 4096 * 8) rope_tab_entry(WSF(WS_ROPE), idx); }
    }
    SEAM(0);
    if (IN(1)) { PH_LOCALS pg8::Gemm g{XN, WSB(WS_WGU1), MK_MPAD, 5632, 1024}; pg8::StaticOrder S; S.init(MK_MPAD, 5632, G, bx); pg8::EpiSwiGLU E{HB, MK_FF};
        pg8::gemm_phase<pg8::EpiSwiGLU, pg8::StaticOrder, true, true>(ldsl + RING_OFF, g, S, E);
        if (bx >= 150) { LAS float* scr = (LAS float*)(ldsl + RING_OFF + wave * 16896);
            for (int it = (bx - 150) * NWAVES + wave; it < 1792; it += 106 * NWAVES) { const int id = it < 832 ? it + 4224 : (it < 1536 ? it - 832 + 3520 : it - 1536 + 5056); CONVERT_ITEM(id); } }
    }
    SEAM(1);
    if (IN(2)) { PH_LOCALS skinny_item(HB + (size_t)MK_MP * MK_FF, WSB(WS_WD1), MK_FF, FSb, vcu, wave, lane);
        pg8::Gemm g{HB, WSB(WS_WD1), MK_MP, 1024, MK_FF}; pg8::StaticOrder S; S.init(MK_MP, 1024, G, bx); pg8::EpiBf16P E{Fb, 1024};
        pg8::gemm_phase<pg8::EpiBf16P, pg8::StaticOrder, true, true>(ldsl + RING_OFF, g, S, E); }
    SEAM(2);
    if (IN(3)) { PH_LOCALS int r = gw;
        for (; r + NGW < MK_MR; r += 2 * NGW) rowpass_B2(x_row(x_p, x_s, r), x_row(x_p, x_s, r + NGW), Fb, FSb, INP(8), 0.5f, HRES, INP(12), XN, r, r + NGW, lane);
        for (; r < MK_MR; r += NGW) rowpass_B(x_row(x_p, x_s, r), Fb, FSb, INP(8), 0.5f, HRES, INP(12), XN, r, lane); }
    SEAM(3);
    if (IN(4)) { PH_LOCALS pg8::Gemm g{XN, WSB(WS_WIN), MK_MPAD, MK_NPROJ, 1024}; pg8::StaticOrder S; S.init(MK_MPAD, MK_NPROJ, G, bx); pg8::EpiBf16P E{PROJ, MK_NPROJ};
        pg8::gemm_phase<pg8::EpiBf16P, pg8::StaticOrder, true, true>(ldsl + RING_OFF, g, S, E);
        if (bx >= 77) { LAS float* scr = (LAS float*)(ldsl + RING_OFF + wave * 16896);
            for (int it = (bx - 77) * NWAVES + wave; it < 1408; it += 179 * NWAVES) CONVERT_ITEM(it + 1408); }
    }
    SEAM(4);
    if (IN(5)) { PH_LOCALS
        PostP pp{PROJ, QB, KB, VB, o_kp, o_vp, o_ks, o_vs, o_shp, o_shs, WSF(WS_ROPE), INP(21), WSB(WS_XL), WSB(WS_XH)}; MAKE_RP()
        for (int r = gw; r < MK_MR; r += NGW) post_win_row(pp, r, lane);
        if (wave < 4) { const int su = bx * 4 + wave; if (su < 1024) rwkv_sample(rp, su >> 3, su & 7, ldsl + wave * 4096, lane); }
        STAMP(16);
        xcd_barrier(bar);
        STAMP(17);
        { RwkvGrp gs; for (int i = 0; i < 8; ++i) { const int u = vcu * 8 + i; rwkv_passA(rp, u >> 9, (u >> 6) & 7, u & 63, ldsl, gs, i == 0, i == 7); } }
    }
    SEAM(5);
    if (IN(6)) { PH_LOCALS
        MAKE_RP()
        if ((bx >> 3) < 16 && wave == 0) { const int id = (bx & 7) * 16 + (bx >> 3); rwkv_passB(rp, (id >> 2) >> 3, (id >> 2) & 7, id & 3, ldsl, lane); }
        __syncthreads(); STAMP(14);
        {
            MAKE_DP()
            const attn_body::bf16* aQ = (const attn_body::bf16*)QB; const attn_body::bf16* aK = (const attn_body::bf16*)KB; const attn_body::bf16* aV = (const attn_body::bf16*)VB; attn_body::bf16* aO = (attn_body::bf16*)O16;
            volatile LAS int* qw = (volatile LAS int*)(ldsl + LDSCTL_OFF + 64);
            gu32* qa = ctl + CW_QA; gu32* qd = ctl + CW_QD;
            const bool dec_first = ((bx >> 3) & 1) == 0;
            bool a_done = false, d_done = false;
            for (;;) {
                if (tid == 0) {
                    int code = -1;
                    for (int pass = 0; pass < 2 && code < 0; ++pass) {
                        const bool want_dec = (pass == 0) == dec_first;
                        if (want_dec) { if (!d_done) { const unsigned j = __hip_atomic_fetch_add(qd, 1u, RLX_AGENT); if (j < 256u) code = 0x10000 | (int)j; else d_done = true; } }
                        else { if (!a_done) { const unsigned i = __hip_atomic_fetch_add(qa, 1u, RLX_AGENT); if (i < 1024u) code = (int)i; else a_done = true; } }
                    }
                    *qw = code;
                }
                __syncthreads();
                const int code = __builtin_amdgcn_readfirstlane(*qw);
                __syncthreads();
                if (code < 0) break;
                if (code & 0x10000) decode_unit(dp, (code & 0xffff) >> 1, code & 1, ldsl);
                else attn_body::attn_unit<8>((code & 63) >> 4, code & 15, 15 - (code >> 6), aQ, aK, aV, aO, (char*)lds + RING_OFF);
            }
        }
        STAMP(15);
    }
    SEAM(6);
    if (IN(7)) { PH_LOCALS
        MAKE_RP()
        const float lam = compute_lam(INP(16), INP(17), INP(18), INP(19), lane);
        { const int u = vcu * 8 + wave; if (u < 2048) rwkv_passC(rp, u >> 9, (u >> 6) & 7, u & 63, lane); }
        attn_combine_rows<4>(O16, subln, lam, MIXIN, gw, NGW, lane); attn_combine_rows<4>(O16, subln, lam, MIXIN, gw + 4 * NGW, NGW, lane);
        MAKE_DP()
        if (gw < 128) decode_final(dp, gw, lam, lane);
        else if (gw < 256) { bf16* z = MIXIN + (size_t)(MK_MR + gw - 128) * 1024 + lane * 16; *(v4u*)z = (v4u){0u, 0u, 0u, 0u}; *(v4u*)(z + 8) = (v4u){0u, 0u, 0u, 0u}; }
    }
    SEAM(7);
    if (IN(8)) { PH_LOCALS skinny_item(MIXIN + (size_t)MK_MP * 1024, WSB(WS_WOUT), 1024, FSb, vcu, wave, lane);
        pg8::Gemm g{MIXIN, WSB(WS_WOUT), MK_MP, 1024, 1024}; pg8::StaticOrder S; S.init(MK_MP, 1024, G, bx); pg8::EpiBf16P E{Fb, 1024};
        pg8::gemm_phase<pg8::EpiBf16P, pg8::StaticOrder, true, true>(ldsl + RING_OFF, g, S, E); }
    SEAM(8);
    if (IN(9)) { PH_LOCALS int r = gw;
        for (; r + NGW < MK_MR; r += 2 * NGW) rowpass_B2(HRES + (size_t)r * MK_D, HRES + (size_t)(r + NGW) * MK_D, Fb, FSb, INP(13), 1.0f, HRES, INP(32), XN, r, r + NGW, lane);
        for (; r < MK_MR; r += NGW) rowpass_B(HRES + (size_t)r * MK_D, Fb, FSb, INP(13), 1.0f, HRES, INP(32), XN, r, lane); }
    SEAM(9);
    if (IN(10)) { PH_LOCALS pg8::Gemm g{XN, WSB(WS_WGU2), MK_MPAD, 5632, 1024}; pg8::StaticOrder S; S.init(MK_MPAD, 5632, G, bx); pg8::EpiSwiGLU E{HB, MK_FF};
        pg8::gemm_phase<pg8::EpiSwiGLU, pg8::StaticOrder, true, true>(ldsl + RING_OFF, g, S, E); }
    SEAM(10);
    if (IN(11)) { PH_LOCALS skinny_item(HB + (size_t)MK_MP * MK_FF, WSB(WS_WD2), MK_FF, FSb, vcu, wave, lane);
        pg8::Gemm g{HB, WSB(WS_WD2), MK_MP, 1024, MK_FF}; pg8::StaticOrder S; S.init(MK_MP, 1024, G, bx); pg8::EpiBf16P E{Fb, 1024};
        pg8::gemm_phase<pg8::EpiBf16P, pg8::StaticOrder, true, true>(ldsl + RING_OFF, g, S, E); }
    SEAM(11);
    if (IN(12)) { PH_LOCALS int r = gw;
#define YROW(rr) ((rr) < MK_MP ? o_yp + (size_t)(rr) * MK_D : o_ys + (size_t)((rr) - MK_MP) * MK_D)
        for (; r + NGW < MK_MR; r += 2 * NGW) rowpass_D2(HRES, Fb, FSb, INP(33), YROW(r), YROW(r + NGW), r, r + NGW, lane);
        for (; r < MK_MR; r += NGW) rowpass_D(HRES, Fb, FSb, INP(33), YROW(r), r, lane);
#undef YROW
    }
    STAMP(13);
#if defined(PROBE_A)
    if (blockIdx.x == 0 && threadIdx.x == 0) {
        volatile LAS unsigned long long* T = (volatile LAS unsigned long long*)(ldsl + LDSCTL_OFF + 1024);
#if defined(PROBE_ACC)
        volatile LAS unsigned long long* AC = (volatile LAS unsigned long long*)(ldsl + LDSCTL_OFF + 2048);
        const unsigned long long ta = AC[PROBE_A], tb = AC[PROBE_B];
#else
        const unsigned long long ta = T[PROBE_A1] - T[PROBE_A], tb = T[PROBE_B1] - T[PROBE_B];
#endif
        const unsigned long long delay = 10000ull * (ta / 1000ull) + 500000ull * (tb / 1000ull);
        const unsigned long long t0 = __builtin_amdgcn_s_memrealtime();
        while (__builtin_amdgcn_s_memrealtime() - t0 < delay) __builtin_amdgcn_s_sleep(32);
    }
#endif
#undef IN
#undef SEAM
}

extern "C" void kernel_launch(void* const* d_in, const int* in_sizes, int n_in, void* d_out, int out_size, void* d_ws, size_t ws_size, hipStream_t stream) {
    static int grid = 0;
    if (grid == 0) {
        if (n_in != 37 || ws_size < WS_END) { fprintf(stderr, "kernel_launch: unexpected inputs (n_in %d, ws %zu)\n", n_in, ws_size); grid = -1; return; }
        int dev = 0, cus = 0, per_cu = 0;
        if (hipGetDevice(&dev) != hipSuccess || hipDeviceGetAttribute(&cus, hipDeviceAttributeMultiprocessorCount, dev) != hipSuccess) { grid = -1; return; }
        if (hipFuncSetAttribute((const void*)mk_fwd, hipFuncAttributeMaxDynamicSharedMemorySize, LDS_BYTES) != hipSuccess) { fprintf(stderr, "kernel_launch: hipFuncSetAttribute failed\n"); grid = -1; return; }
        if (hipOccupancyMaxActiveBlocksPerMultiprocessor(&per_cu, (const void*)mk_fwd, NWAVES * 64, LDS_BYTES) != hipSuccess || per_cu < 1) fprintf(stderr, "kernel_launch: occupancy query says %d\n", per_cu);
        (void)hipGetLastError();
        if (cus < 256) { fprintf(stderr, "kernel_launch: needs a 256-CU device (got %d)\n", cus); grid = -1; return; }
        grid = 256;
    }
    if (grid < 0) return;
    if (hipMemsetAsync((char*)d_ws + WS_CTL, 0, CTL_ZERO_BYTES, stream) != hipSuccess) return;
    Args a{};
    for (int i = 0; i < 37; ++i) a.in[i] = (const float*)d_in[i];
    a.out = (float*)d_out; a.ws = (unsigned char*)d_ws;
    constexpr int NL = MK_N_LAUNCHES;
    for (int li = 0; li < NL; ++li) {
        a.ph_lo = li * N_PHASES / NL; a.ph_hi = (li + 1) * N_PHASES / NL; a.li = li;
        hipLaunchKernelGGL(mk_fwd, dim3(grid), dim3(NWAVES * 64), LDS_BYTES, stream, a);
    }
}
```
